# Optimizing an MI355X kernel written in HIP

```python
import jax, jax.numpy as jnp
from jax import lax
import numpy as np

D_MODEL = 2048
BATCH = 4
SEQ = 4096
DEPTH = 2

RET_HEADS = 8
RET_DK = 64
RET_DV = 128
RET_CHUNK = 128
MLA_HEADS = 8
MLA_Q_RANK = 512
MLA_KV_RANK = 256
MLA_NOPE = 128
MLA_ROPE = 64
MLA_DV = 128
ATTN_BLOCK = 128
RET_WIDTH = RET_HEADS * RET_DV
MLA_WIDTH = MLA_HEADS * MLA_DV
MIX_WIDTH = RET_WIDTH + MLA_WIDTH
IN_SIZES = (RET_HEADS * RET_DK, RET_HEADS * RET_DK, RET_WIDTH, RET_WIDTH, MLA_Q_RANK, MLA_KV_RANK, MLA_ROPE)
IN_COLS = 2 * RET_HEADS * RET_DK + 2 * RET_WIDTH + MLA_Q_RANK + MLA_KV_RANK + MLA_ROPE
D_FF = 256 * ((8 * D_MODEL // 3 + 255) // 256)
ROPE_DIM = 64
ROPE_BASE = 10000.0
EPS = 1e-6
N_MOD = 9

kernel_name = "hybrid_retention_mla_macaron_adaln"


def rmsnorm(x, gain):
    xf = x.astype(jnp.float32)
    y = xf * lax.rsqrt(jnp.mean(xf * xf, axis=-1, keepdims=True) + EPS)
    return (y * gain.astype(jnp.float32)).astype(x.dtype)


def rope_tables(positions):
    inv = ROPE_BASE ** (-jnp.arange(0, ROPE_DIM, 2, dtype=jnp.float32) / ROPE_DIM)
    ang = positions.astype(jnp.float32)[..., None] * inv
    return jnp.cos(ang), jnp.sin(ang)


def apply_rope(x, cos, sin):
    x1, x2 = jnp.split(x, 2, axis=-1)
    c = cos[:, :, None, :].astype(x.dtype)
    s = sin[:, :, None, :].astype(x.dtype)
    return jnp.concatenate([x1 * c - x2 * s, x1 * s + x2 * c], axis=-1)


def modulate(h, shift, scale):
    return h * (1 + scale[:, None, :]) + shift[:, None, :]


def swiglu(h, w_gu, w_down):
    g, u = jnp.split(h @ w_gu, 2, axis=-1)
    return (jax.nn.silu(g) * u) @ w_down


def chunkwise_retention(q, k, v):
    B, S, H, dk = q.shape
    dv = v.shape[-1]
    C = RET_CHUNK
    N = S // C
    dt = q.dtype
    log_g = jnp.log1p(-(2.0 ** (-5.0 - jnp.arange(H, dtype=jnp.float32))))
    idx = jnp.arange(C, dtype=jnp.float32)
    rel = idx[:, None] - idx[None, :]
    intra_decay = jnp.where(rel >= 0, jnp.exp(log_g[:, None, None] * jnp.maximum(rel, 0.0)), 0.0)
    q_decay = jnp.exp(log_g[:, None] * (idx + 1.0))
    k_decay = jnp.exp(log_g[:, None] * (C - 1.0 - idx))
    chunk_decay = jnp.exp(log_g * C)

    qc = q.reshape(B, N, C, H, dk)
    kc = k.reshape(B, N, C, H, dk)
    vc = v.reshape(B, N, C, H, dv)
    s = jnp.einsum('bnihd,bnjhd->bnhij', qc, kc) * intra_decay.astype(dt)
    intra = jnp.einsum('bnhij,bnjhe->bnihe', s, vc)
    inc = jnp.einsum('bnjhd,hj,bnjhe->nbhde', kc, k_decay.astype(dt), vc)
    cd = chunk_decay.astype(dt)[None, :, None, None]

    def step(state, inc_n):
        return state * cd + inc_n, state

    _, prev = lax.scan(step, jnp.zeros((B, H, dk, dv), dt), inc)
    cross = jnp.einsum('bnihd,hi,nbhde->bnihe', qc, q_decay.astype(dt), prev)
    return (intra + cross).reshape(B, S, H, dv)


def causal_block_attention(q, k, v):
    B, S, H, dqk = q.shape
    dv = v.shape[-1]
    NB = S // ATTN_BLOCK
    scale = dqk ** -0.5
    qb = q.reshape(B, NB, ATTN_BLOCK, H, dqk).transpose(1, 0, 2, 3, 4)
    key_pos = jnp.arange(S)

    def one_block(args):
        q_blk, start = args
        sc = jnp.einsum('bqhd,bkhd->bhqk', q_blk, k, preferred_element_type=jnp.float32) * scale
        qpos = start + jnp.arange(ATTN_BLOCK)
        sc = jnp.where(key_pos[None, :] <= qpos[:, None], sc, -jnp.inf)
        p = jax.nn.softmax(sc, axis=-1).astype(v.dtype)
        return jnp.einsum('bhqk,bkhe->bqhe', p, v)

    out = lax.map(one_block, (qb, jnp.arange(NB) * ATTN_BLOCK))
    return out.transpose(1, 0, 2, 3, 4).reshape(B, S, H, dv)


def hybrid_mixer(h, cos, sin, w_in, ret_norm_g, q_norm_g, w_uq, kv_norm_g, w_ukv, w_out):
    B, S, _ = h.shape
    proj = h @ w_in
    cuts = [int(v) for v in np.cumsum(IN_SIZES)[:-1]]
    q_r, k_r, v_r, g_r, c_q, c_kv, k_pe = jnp.split(proj, cuts, axis=-1)

    q_r = apply_rope(q_r.reshape(B, S, RET_HEADS, RET_DK), cos, sin)
    k_r = apply_rope(k_r.reshape(B, S, RET_HEADS, RET_DK), cos, sin) * (RET_DK ** -0.5)
    v_r = v_r.reshape(B, S, RET_HEADS, RET_DV)
    y_r = chunkwise_retention(q_r, k_r, v_r)
    y_r = rmsnorm(y_r, ret_norm_g.reshape(RET_HEADS, RET_DV)).reshape(B, S, RET_WIDTH)
    y_r = jax.nn.silu(g_r) * y_r

    q = (rmsnorm(c_q, q_norm_g) @ w_uq).reshape(B, S, MLA_HEADS, MLA_NOPE + MLA_ROPE)
    q_nope, q_pe = jnp.split(q, [MLA_NOPE], axis=-1)
    q_pe = apply_rope(q_pe, cos, sin)
    kv = (rmsnorm(c_kv, kv_norm_g) @ w_ukv).reshape(B, S, MLA_HEADS, MLA_NOPE + MLA_DV)
    k_nope, v_m = jnp.split(kv, [MLA_NOPE], axis=-1)
    k_pe = apply_rope(k_pe[:, :, None, :], cos, sin)
    q_m = jnp.concatenate([q_nope, q_pe], axis=-1)
    k_m = jnp.concatenate([k_nope, jnp.broadcast_to(k_pe, (B, S, MLA_HEADS, MLA_ROPE))], axis=-1)
    y_m = causal_block_attention(q_m, k_m, v_m).reshape(B, S, MLA_WIDTH)

    return jnp.concatenate([y_r, y_m], axis=-1) @ w_out


def setup_inputs(seed: int = 0) -> dict:
    key = jax.random.key(seed)
    ks = jax.random.split(key, 24)
    f32 = jnp.float32

    def nrm(k, shape, scale):
        return jax.random.normal(k, shape, f32) * scale

    def gain(k, shape):
        return 1.0 + 0.02 * jax.random.normal(k, shape, f32)

    offsets = jax.random.randint(ks[2], (BATCH, 1), 0, 1024, dtype=jnp.int32)
    positions = offsets + jnp.arange(SEQ, dtype=jnp.int32)[None, :]
    return {
        "x": nrm(ks[0], (BATCH, SEQ, D_MODEL), 1.0),
        "c": nrm(ks[1], (BATCH, D_MODEL), 1.0),
        "positions": positions,
        "w_ada": nrm(ks[3], (DEPTH, D_MODEL, N_MOD * D_MODEL), 0.5 * D_MODEL ** -0.5),
        "b_ada": nrm(ks[4], (DEPTH, N_MOD * D_MODEL), 0.02),
        "norm_ffn1": gain(ks[5], (DEPTH, D_MODEL)),
        "ffn1_w_gu": nrm(ks[6], (DEPTH, D_MODEL, 2 * D_FF), D_MODEL ** -0.5),
        "ffn1_w_down": nrm(ks[7], (DEPTH, D_FF, D_MODEL), D_FF ** -0.5),
        "norm_mix": gain(ks[8], (DEPTH, D_MODEL)),
        "w_in": nrm(ks[9], (DEPTH, D_MODEL, IN_COLS), D_MODEL ** -0.5),
        "ret_norm_g": gain(ks[10], (DEPTH, RET_WIDTH)),
        "q_norm_g": gain(ks[11], (DEPTH, MLA_Q_RANK)),
        "w_uq": nrm(ks[12], (DEPTH, MLA_Q_RANK, MLA_HEADS * (MLA_NOPE + MLA_ROPE)), MLA_Q_RANK ** -0.5),
        "kv_norm_g": gain(ks[13], (DEPTH, MLA_KV_RANK)),
        "w_ukv": nrm(ks[14], (DEPTH, MLA_KV_RANK, MLA_HEADS * (MLA_NOPE + MLA_DV)), MLA_KV_RANK ** -0.5),
        "w_out": nrm(ks[15], (DEPTH, MIX_WIDTH, D_MODEL), MIX_WIDTH ** -0.5),
        "norm_ffn2": gain(ks[16], (DEPTH, D_MODEL)),
        "ffn2_w_gu": nrm(ks[17], (DEPTH, D_MODEL, 2 * D_FF), D_MODEL ** -0.5),
        "ffn2_w_down": nrm(ks[18], (DEPTH, D_FF, D_MODEL), D_FF ** -0.5),
        "final_norm": gain(ks[19], (D_MODEL,)),
    }


def reference(x, c, positions, w_ada, b_ada, norm_ffn1, ffn1_w_gu, ffn1_w_down, norm_mix, w_in,
              ret_norm_g, q_norm_g, w_uq, kv_norm_g, w_ukv, w_out, norm_ffn2, ffn2_w_gu,
              ffn2_w_down, final_norm):
    cos, sin = rope_tables(positions)
    c_act = jax.nn.silu(c)
    for l in range(DEPTH):
        mod = c_act @ w_ada[l] + b_ada[l]
        sh1, sc1, g1, sh2, sc2, g2, sh3, sc3, g3 = jnp.split(mod, N_MOD, axis=-1)
        h = modulate(rmsnorm(x, norm_ffn1[l]), sh1, sc1)
        x = x + 0.5 * g1[:, None, :] * swiglu(h, ffn1_w_gu[l], ffn1_w_down[l])
        h = modulate(rmsnorm(x, norm_mix[l]), sh2, sc2)
        x = x + g2[:, None, :] * hybrid_mixer(h, cos, sin, w_in[l], ret_norm_g[l], q_norm_g[l], w_uq[l],
                                              kv_norm_g[l], w_ukv[l], w_out[l])
        h = modulate(rmsnorm(x, norm_ffn2[l]), sh3, sc3)
        x = x + 0.5 * g3[:, None, :] * swiglu(h, ffn2_w_gu[l], ffn2_w_down[l])
    return rmsnorm(x, final_norm)
```

```cpp
#include <hip/hip_runtime.h>
#include <cstdio>
#include <cstdint>
#include <cmath>

constexpr int D = 2048, NB = 4, SEQ = 4096, DEPTH = 2, M = NB * SEQ;
constexpr int RH = 8, RDK = 64, RDV = 128, RCH = 128;
constexpr int MH = 8, QRANK = 512, KVRANK = 256, NOPE = 128, ROPE = 64, MDV = 128, DQK = NOPE + ROPE;
constexpr int RETW = RH * RDV, MLAW = MH * MDV, MIXW = RETW + MLAW;
constexpr int INCOLS = 2 * RH * RDK + 2 * RETW + QRANK + KVRANK + ROPE;
constexpr int FF = 5632, NGU = 2 * FF;
constexpr int NMOD = 9;
constexpr float EPS = 1e-6f;
constexpr int C_QR = 0, C_KR = 512, C_VR = 1024, C_GR = 2048, C_CQ = 3072, C_CKV = 3584, C_KPE = 3840;

typedef unsigned short bf16_t;
typedef short bf16x8 __attribute__((ext_vector_type(8)));
typedef float f32x4 __attribute__((ext_vector_type(4)));

constexpr size_t MiB = 1u << 20;
constexpr size_t WS_CTL = 0, CTL_BYTES = 4 * MiB;
constexpr size_t CT_SS = 64 * 1024;
constexpr size_t CT_SSQ = CT_SS + 7 * (size_t)M * 4;
constexpr size_t CT_SSKV = CT_SSQ + 2 * (size_t)M * 4;
constexpr size_t CT_MOD = CT_SSKV + 2 * (size_t)M * 4;
constexpr size_t CT_END = CT_MOD + (size_t)DEPTH * NB * NMOD * D * 4;
static_assert(CT_END <= CTL_BYTES, "ctl");
constexpr size_t WS_COS = 4 * MiB, WS_SIN = 6 * MiB;
constexpr size_t WS_XRES = 8 * MiB;
constexpr size_t WS_XG = WS_XRES + (size_t)M * D * 4;
constexpr size_t WS_Y = WS_XG + (size_t)M * D * 2;
constexpr size_t WS_H = WS_Y;
constexpr size_t WS_INC = WS_Y + (size_t)M * MIXW * 2;
constexpr size_t WS_PREVT = WS_INC + (size_t)NB * RH * 32 * 64 * 128 * 4;
constexpr size_t WS_CQF = WS_INC;
constexpr size_t WS_CKVF = WS_PREVT;
constexpr size_t WS_MIX = WS_PREVT + (size_t)NB * RH * 32 * 64 * 128 * 2;
constexpr size_t WS_QR = WS_MIX;
constexpr size_t WS_KR = WS_QR + (size_t)M * 512 * 2;
constexpr size_t WS_VR = WS_KR + (size_t)M * 512 * 2;
constexpr size_t WS_GR = WS_VR + (size_t)M * 1024 * 2;
constexpr size_t WS_CQ = WS_GR + (size_t)M * 1024 * 2;
constexpr size_t WS_CKV = WS_CQ + (size_t)M * 512 * 2;
constexpr size_t WS_Q = WS_CKV + (size_t)M * 256 * 2;
constexpr size_t WS_K = WS_Q + (size_t)M * MH * DQK * 2;
constexpr size_t WS_V = WS_K + (size_t)M * MH * DQK * 2;
constexpr size_t WS_MIX_END = WS_V + (size_t)M * MH * MDV * 2;
constexpr size_t WS_ACT = WS_MIX;
static_assert(WS_ACT + (size_t)M * FF * 2 <= WS_MIX_END, "act overlay");
constexpr size_t WS_WT = WS_MIX_END;
constexpr size_t WS_END = WS_WT + 340 * MiB;

__device__ __forceinline__ bf16_t f2bf(float f) { unsigned u = __float_as_uint(f); u += 0x7fffu + ((u >> 16) & 1u); return (bf16_t)(u >> 16); }
__device__ __forceinline__ float bf2f(bf16_t b) { return __uint_as_float(((unsigned)b) << 16); }
__device__ __forceinline__ float siluf(float x) { return x / (1.f + __expf(-x)); }
__device__ __forceinline__ float wave_sum(float v) {
#pragma unroll
    for (int o = 1; o < 64; o <<= 1) v += __shfl_xor(v, o);
    return v;
}

struct Ptrs {
    const float *x, *c; const int* pos; const float *w_ada, *b_ada, *norm_ffn1, *ffn1_w_gu, *ffn1_w_down, *norm_mix, *w_in, *ret_norm_g, *q_norm_g, *w_uq,
        *kv_norm_g, *w_ukv, *w_out, *norm_ffn2, *ffn2_w_gu, *ffn2_w_down, *final_norm;
    float* out; unsigned char* ws;
};

namespace pg8 {
#define PG8_LAS __attribute__((address_space(3)))
typedef unsigned short bf16_t;
typedef short bf16x8 __attribute__((ext_vector_type(8)));
typedef float f32x4 __attribute__((ext_vector_type(4)));
typedef unsigned u32x4 __attribute__((ext_vector_type(4)));
constexpr int BM = 256, BK = 64, HALF = 128, HTB = HALF * BK * 2  , STAGE_BYTES = 8 * HTB, NXCD = 8, WGM = 8;

__host__ __device__ __forceinline__ int lds_byte(int r, int c) { const int st = (r >> 4) * 2 + (c >> 5), rr = r & 15, cc = c & 31, ob = rr * 64 + cc * 2; return st * 1024 + (ob ^ (((ob >> 9) & 1) << 5)); }
__host__ __device__ __forceinline__ void stage_rc(int b, int& R, int& C) { const int st = b / 1024, sb = b % 1024, swz = sb ^ (((sb >> 9) & 1) << 5); R = (st >> 1) * 16 + swz / 64; C = (st & 1) * 32 + (swz % 64) / 2; }
__host__ __device__ __forceinline__ int perm32(int rho) { const int n = rho >> 4, i = rho & 15; return 8 * (i >> 2) + 4 * n + (i & 3); }

struct Unit { int pm, pn; };
struct Gemm { const bf16_t* A; const bf16_t* Bt; int M, N, K; };

struct StaticOrder {
    int nM, nN, nwg, G, c;
    __host__ __device__ void init(int M, int N, int G_, int c_) { nM = M / BM; nN = N / BM; nwg = nM * nN; G = G_; c = c_; }
    __host__ __device__ bool next(int i, Unit& u) const {
        const long L = (long)i * G + c; if (L >= nwg) return false;
        int wgid = (int)L; { const int q = nwg / NXCD, r = nwg % NXCD, xcd = wgid % NXCD, off = wgid / NXCD; wgid = (xcd < r ? xcd * (q + 1) : r * (q + 1) + (xcd - r) * q) + off; }
        const int nig = WGM * nN, gid = wgid / nig, fm = gid * WGM, gsz = (nM - fm) < WGM ? (nM - fm) : WGM;
        u.pm = fm + ((wgid % nig) % gsz); u.pn = (wgid % nig) / gsz; return true;
    }
    __device__ __forceinline__ void a_ready(const Unit&) const {}
    __device__ __forceinline__ void done(const Unit&) const {}
};

template <class Epi, class Sched, bool ALIGN_EPI = false, bool SP2 = false>
__device__ __forceinline__ void gemm_phase(PG8_LAS unsigned char* lds, const Gemm g, const Sched& S, const Epi& E) {
    int tid_ = threadIdx.x; asm volatile("" : "+v"(tid_));
    const int tid = tid_, wid = __builtin_amdgcn_readfirstlane(tid >> 6), lane = tid & 63, wr = wid >> 2, wc = wid & 3, fr = lane & 15, fq = lane >> 4;
    const int K = g.K, nt = K / BK;
    unsigned voffA[2], voffB[2];
#pragma unroll
    for (int i = 0; i < 2; ++i) { int R, C; stage_rc(tid * 16 + i * 8192, R, C); const int Rb = Epi::PERM ? ((R & ~31) + perm32(R & 31)) : R;
        voffA[i] = (unsigned)(R * K + C) * 2u; voffB[i] = (unsigned)(Rb * K + C) * 2u; }
    const unsigned kstep = (unsigned)(BK * 2);
    const unsigned hstep = (unsigned)HALF * K * 2;
    const unsigned tstep = 2 * hstep;
    const __amdgpu_buffer_rsrc_t rsA = __builtin_amdgcn_make_buffer_rsrc((void*)g.A, (short)0, (int)((size_t)g.M * K * 2), 0x00020000), rsB = __builtin_amdgcn_make_buffer_rsrc((void*)g.Bt, (short)0, (int)((size_t)g.N * K * 2), 0x00020000);
    const unsigned ldsw = (unsigned)wid * 1024u;
    const int aoff = lds_byte(wr * 64 + fr, fq * 8), boff = lds_byte(wc * 32 + fr, fq * 8);
#define PG8_SA(b, h) (((b) * 2 + (h)) * HTB)
#define PG8_SB(b, h) ((4 + (b) * 2 + (h)) * HTB)
#define PG8_STAGE_(rs, bufoff, gbase, voff) do { _Pragma("unroll") for (int _i = 0; _i < 2; ++_i) \
        __builtin_amdgcn_raw_ptr_buffer_load_lds(rs, (PG8_LAS void*)(lds + (bufoff) + ldsw + _i * 8192), 16, (int)(voff)[_i], (int)(gbase), 0, 0); } while (0)
#define PG8_STAGE(bufoff, gbase, voff) PG8_STAGE_##voff(bufoff, gbase)
#define PG8_STAGE_voffA(bufoff, gbase) PG8_STAGE_(rsA, bufoff, gbase, voffA)
#define PG8_STAGE_voffB(bufoff, gbase) PG8_STAGE_(rsB, bufoff, gbase, voffB)
#define PG8_LDA(dst, b, h) do { _Pragma("unroll") for (int m = 0; m < 4; ++m) _Pragma("unroll") for (int k = 0; k < 2; ++k) dst[m][k] = *(const PG8_LAS bf16x8*)(lds + PG8_SA(b, h) + aoff + m * 2048 + k * 1024); } while (0)
#define PG8_LDB(dst, b, h) do { _Pragma("unroll") for (int n = 0; n < 2; ++n) _Pragma("unroll") for (int k = 0; k < 2; ++k) dst[n][k] = *(const PG8_LAS bf16x8*)(lds + PG8_SB(b, h) + boff + n * 2048 + k * 1024); } while (0)
#define PG8_MMA(ai, bj, At, Bt) do { __builtin_amdgcn_s_setprio(1); _Pragma("unroll") for (int m = 0; m < 4; ++m) _Pragma("unroll") for (int n = 0; n < 2; ++n) _Pragma("unroll") for (int k = 0; k < 2; ++k) \
        acc[ai][bj][m][n] = __builtin_amdgcn_mfma_f32_16x16x32_bf16(Bt[n][k], At[m][k], acc[ai][bj][m][n], 0, 0, 0); __builtin_amdgcn_s_setprio(0); } while (0)
#define PG8_WAIT_V(n) asm volatile("s_waitcnt vmcnt(" #n ")" ::: "memory")
#define PG8_WAIT_L(n) asm volatile("s_waitcnt lgkmcnt(" #n ")" ::: "memory")
#define PG8_BAR __builtin_amdgcn_s_barrier()
#define PG8_SCHED __builtin_amdgcn_sched_barrier(0)
    Unit cur, nxt; int ui = 0;
    if (!S.next(0, cur)) return;
    f32x4 acc[2][2][4][2];
#pragma unroll
    for (int a = 0; a < 2; ++a)
#pragma unroll
        for (int b = 0; b < 2; ++b)
#pragma unroll
            for (int m = 0; m < 4; ++m)
#pragma unroll
                for (int n = 0; n < 2; ++n) acc[a][b][m][n] = (f32x4){0.f, 0.f, 0.f, 0.f};
    bf16x8 At[4][2], B0[2][2], B1[2][2];
    unsigned cA = (unsigned)cur.pm * tstep, cB = (unsigned)cur.pn * tstep;
    S.a_ready(cur);
    if constexpr (SP2) {
        PG8_STAGE(PG8_SB(0, 0), cB, voffB); PG8_STAGE(PG8_SB(0, 1), cB + hstep, voffB); PG8_STAGE(PG8_SA(0, 0), cA, voffA); PG8_STAGE(PG8_SA(0, 1), cA + hstep, voffA);
        if (wr == 1) PG8_BAR;
        PG8_WAIT_V(2); PG8_BAR;
        PG8_STAGE(PG8_SB(1, 0), cB + kstep, voffB); PG8_STAGE(PG8_SA(1, 0), cA + kstep, voffA); PG8_STAGE(PG8_SB(1, 1), cB + hstep + kstep, voffB);
        PG8_WAIT_V(6); PG8_BAR;
    } else {
        PG8_STAGE(PG8_SB(0, 0), cB, voffB); PG8_STAGE(PG8_SA(0, 0), cA, voffA); PG8_STAGE(PG8_SB(0, 1), cB + hstep, voffB); PG8_STAGE(PG8_SA(0, 1), cA + hstep, voffA);
        if (wr == 1) PG8_BAR;
        PG8_WAIT_V(4); PG8_BAR;
        PG8_STAGE(PG8_SB(1, 0), cB + kstep, voffB); PG8_STAGE(PG8_SA(1, 0), cA + kstep, voffA); PG8_STAGE(PG8_SB(1, 1), cB + hstep + kstep, voffB);
        PG8_WAIT_V(6); PG8_BAR;
    }
    for (;;) {
        const bool has_next = S.next(ui + 1, nxt);
        const unsigned nA = has_next ? (unsigned)nxt.pm * tstep : cA, nB = has_next ? (unsigned)nxt.pn * tstep : cB;
        for (int t = 0; t < nt; t += 2) {
            const bool last = (t == nt - 2);
            const unsigned a1 = cA + (unsigned)(t + 1) * kstep;
            const unsigned a2 = last ? nA : cA + (unsigned)(t + 2) * kstep, b2 = last ? nB : cB + (unsigned)(t + 2) * kstep;
            const unsigned a3 = a2 + kstep, b3 = b2 + kstep;
            if (last && has_next) S.a_ready(nxt);
            if constexpr (SP2) {
            PG8_LDB(B0, 0, 0); PG8_LDB(B1, 0, 1); PG8_SCHED; PG8_LDA(At, 0, 0); PG8_STAGE(PG8_SA(1, 1), a1 + hstep, voffA);
            PG8_WAIT_V(8); PG8_WAIT_L(0); PG8_BAR; PG8_MMA(0, 0, At, B0); PG8_MMA(0, 1, At, B1); PG8_BAR; PG8_SCHED;
            PG8_LDA(At, 0, 1); PG8_STAGE(PG8_SB(0, 0), b2, voffB); PG8_STAGE(PG8_SB(0, 1), b2 + hstep, voffB); PG8_STAGE(PG8_SA(0, 0), a2, voffA);
            PG8_WAIT_V(8); PG8_WAIT_L(0); PG8_BAR; PG8_MMA(1, 0, At, B0); PG8_MMA(1, 1, At, B1); PG8_BAR; PG8_SCHED;
            PG8_LDB(B0, 1, 0); PG8_LDB(B1, 1, 1); PG8_SCHED; PG8_LDA(At, 1, 0); PG8_STAGE(PG8_SA(0, 1), a2 + hstep, voffA);
            PG8_WAIT_V(8); PG8_WAIT_L(0); PG8_BAR; PG8_MMA(0, 0, At, B0); PG8_MMA(0, 1, At, B1); PG8_BAR; PG8_SCHED;
            PG8_LDA(At, 1, 1); PG8_STAGE(PG8_SB(1, 0), b3, voffB); PG8_STAGE(PG8_SB(1, 1), b3 + hstep, voffB); PG8_STAGE(PG8_SA(1, 0), a3, voffA);
            PG8_WAIT_V(8); PG8_WAIT_L(0); PG8_BAR; PG8_MMA(1, 0, At, B0); PG8_MMA(1, 1, At, B1); PG8_BAR; PG8_SCHED;
            } else {
            PG8_LDB(B0, 0, 0); PG8_SCHED; PG8_LDA(At, 0, 0); PG8_STAGE(PG8_SA(1, 1), a1 + hstep, voffA);
            PG8_WAIT_L(8); PG8_BAR; PG8_WAIT_L(0); PG8_MMA(0, 0, At, B0); PG8_BAR; PG8_SCHED;
            PG8_LDB(B1, 0, 1); PG8_STAGE(PG8_SB(0, 0), b2, voffB);
            PG8_BAR; PG8_WAIT_L(0); PG8_MMA(0, 1, At, B1); PG8_BAR;
            PG8_LDA(At, 0, 1); PG8_STAGE(PG8_SA(0, 0), a2, voffA);
            PG8_BAR; PG8_WAIT_L(0); PG8_MMA(1, 0, At, B0); PG8_BAR; PG8_SCHED;
            PG8_STAGE(PG8_SB(0, 1), b2 + hstep, voffB);
            PG8_WAIT_V(6); PG8_BAR; PG8_MMA(1, 1, At, B1); PG8_BAR;
            PG8_LDB(B0, 1, 0); PG8_SCHED; PG8_LDA(At, 1, 0); PG8_STAGE(PG8_SA(0, 1), a2 + hstep, voffA);
            PG8_WAIT_L(8); PG8_BAR; PG8_WAIT_L(0); PG8_MMA(0, 0, At, B0); PG8_BAR; PG8_SCHED;
            PG8_LDB(B1, 1, 1); PG8_STAGE(PG8_SB(1, 0), b3, voffB);
            PG8_BAR; PG8_WAIT_L(0); PG8_MMA(0, 1, At, B1); PG8_BAR;
            PG8_LDA(At, 1, 1); PG8_STAGE(PG8_SA(1, 0), a3, voffA);
            PG8_BAR; PG8_WAIT_L(0); PG8_MMA(1, 0, At, B0); PG8_BAR; PG8_SCHED;
            PG8_STAGE(PG8_SB(1, 1), b3 + hstep, voffB);
            PG8_WAIT_V(6); PG8_BAR; PG8_MMA(1, 1, At, B1); PG8_BAR;
            }
        }
        if constexpr (ALIGN_EPI) { if (wr == 0) PG8_BAR; }
        if constexpr (!Epi::AFTER_DRAIN) { E(acc, cur, wr, wc, fr, fq); S.done(cur); }
        if (!has_next) break;
#pragma unroll
        for (int a = 0; a < 2; ++a)
#pragma unroll
            for (int b = 0; b < 2; ++b)
#pragma unroll
                for (int m = 0; m < 4; ++m)
#pragma unroll
                    for (int n = 0; n < 2; ++n) acc[a][b][m][n] = (f32x4){0.f, 0.f, 0.f, 0.f};
        cur = nxt; cA = nA; cB = nB; ++ui;
        if constexpr (ALIGN_EPI) { if (wr == 1) PG8_BAR; }
    }
    PG8_WAIT_V(0);
    if constexpr (!ALIGN_EPI) { if (wr == 0) PG8_BAR; }
    PG8_BAR;
    if constexpr (Epi::AFTER_DRAIN) { E.fused(acc, cur, wr, wc, fr, fq, lds, wid, lane); S.done(cur); }
#undef PG8_SA
#undef PG8_SB
#undef PG8_STAGE
#undef PG8_STAGE_
#undef PG8_STAGE_voffA
#undef PG8_STAGE_voffB
#undef PG8_LDA
#undef PG8_LDB
#undef PG8_MMA
#undef PG8_WAIT_V
#undef PG8_WAIT_L
#undef PG8_BAR
#undef PG8_SCHED
}
}

#define GAS __attribute__((address_space(1)))
#define LAS __attribute__((address_space(3)))
#define XB_TMO      128
#define XB_XCNT(j)  (256  + 64 * (j))
#define XB_XSUB(j)  (1280 + 64 * (j))
#define XB_XGEN(j)  (2304 + 64 * (j))
#define XB_TOP      3328
#define XB_TOPGEN   3392
#define XCD_BAR_WORDS 3456
#define XB_SPIN_CAP (1u << 18)

__device__ __forceinline__ unsigned xb_ld(unsigned* p)              { return __hip_atomic_load(p, __ATOMIC_RELAXED, __HIP_MEMORY_SCOPE_AGENT); }
__device__ __forceinline__ unsigned xb_add(unsigned* p, unsigned v) { return __hip_atomic_fetch_add(p, v, __ATOMIC_RELAXED, __HIP_MEMORY_SCOPE_AGENT); }
__device__ __forceinline__ unsigned xb_xcc_id() { return (unsigned)__builtin_amdgcn_s_getreg((3 << 11) | 20) & 0xFu; }
#define XB_SPIN(cond, bar) do { unsigned _sp = 0; while (cond) { __builtin_amdgcn_s_sleep(1); \
    if ((++_sp & 255u) == 0u) { if (xb_ld(&(bar)[XB_TMO])) break; if (_sp > XB_SPIN_CAP) { atomicAdd(&(bar)[XB_TMO], 1u); break; } } } } while (0)

struct XcdBarrier {
    unsigned* bar; unsigned x;
    volatile LAS unsigned* st;
};

__device__ __forceinline__ XcdBarrier xcd_barrier_post(unsigned* bar, volatile LAS unsigned* st) {
    XcdBarrier b; b.bar = bar; b.x = xb_xcc_id(); b.st = st;
    if (threadIdx.x == 0) (void)xb_add(&bar[XB_XCNT(b.x)], 1u);
    return b;
}
__device__ __forceinline__ void xcd_barrier_complete(unsigned* bar, unsigned x, unsigned& nloc, unsigned& nx) {
    const unsigned G = gridDim.x * gridDim.y * gridDim.z;
    unsigned sum, cnt, mine, sp = 0u;
    for (;;) {
        sum = 0u; cnt = 0u; mine = 0u;
#pragma unroll
        for (unsigned j = 0; j < 16; ++j) { const unsigned c = xb_ld(&bar[XB_XCNT(j)]); sum += c; cnt += (c > 0u) ? 1u : 0u; mine = (j == x) ? c : mine; }
        if (sum == G) break;
        __builtin_amdgcn_s_sleep(1);
        if ((++sp & 255u) == 0u) { if (xb_ld(&bar[XB_TMO])) break; if (sp > XB_SPIN_CAP) { atomicAdd(&bar[XB_TMO], 1u); break; } }
    }
    nloc = mine > 0u ? mine : 1u; nx = cnt > 0u ? cnt : 1u;
}

__device__ __forceinline__ void xcd_barrier(const XcdBarrier& b) {
    asm volatile("s_waitcnt vmcnt(0)" ::: "memory");
    __syncthreads();
    if (threadIdx.x == 0) {
        unsigned* bar = b.bar;
        __builtin_amdgcn_s_waitcnt(0);
        unsigned nloc = b.st[0], nx = b.st[1];
        if (nloc == 0u) { xcd_barrier_complete(bar, b.x, nloc, nx); b.st[0] = nloc; b.st[1] = nx; }
        const unsigned old = xb_add(&bar[XB_XSUB(b.x)], 1u);
        const unsigned gen = old / nloc;
        if (old + 1u == (gen + 1u) * nloc) {
            __builtin_amdgcn_fence(__ATOMIC_RELEASE, "agent");
            asm volatile("s_waitcnt vmcnt(0)" ::: "memory");
            const unsigned og = xb_add(&bar[XB_TOP], 1u);
            const unsigned tg = og / nx;
            if (og + 1u == (tg + 1u) * nx) xb_add(&bar[XB_TOPGEN], 1u);
            else XB_SPIN(xb_ld(&bar[XB_TOPGEN]) == tg, bar);
            __builtin_amdgcn_fence(__ATOMIC_ACQUIRE, "agent");
            xb_add(&bar[XB_XGEN(b.x)], 1u);
            asm volatile("s_waitcnt vmcnt(0)" ::: "memory");
        } else {
            XB_SPIN(xb_ld(&bar[XB_XGEN(b.x)]) == gen, bar);
            __builtin_amdgcn_fence(__ATOMIC_ACQUIRE, "agent");
            asm volatile("s_waitcnt vmcnt(0)" ::: "memory");
        }
    }
    __syncthreads();
}

#define LDS_WAIT() asm volatile("s_waitcnt lgkmcnt(0)" ::: "memory")
#define VM_WAIT() asm volatile("s_waitcnt vmcnt(0)" ::: "memory")
typedef unsigned v4u __attribute__((ext_vector_type(4)));
typedef unsigned v2u __attribute__((ext_vector_type(2)));
constexpr int NWAVES = 8;
constexpr int RING_BYTES = 131072, LDSCTL_OFF = RING_BYTES, MISC_OFF = LDSCTL_OFF + 320, LDS_BYTES = 147456;
constexpr int CW_TMO = 0, CW_BAR = 1024;
constexpr size_t CT_BIAS = 1572864;
constexpr size_t CT_GATE = CT_BIAS + (size_t)DEPTH * 3 * NB * NGU * 4;
constexpr size_t CT_GM = CT_GATE + (size_t)DEPTH * 3 * NB * D * 4;
static_assert(CT_END <= CT_BIAS && CT_GM + (size_t)DEPTH * 3 * NB * D * 4 <= CTL_BYTES, "ctl bias");
constexpr size_t WT_GU1 = 0, WT_DN1 = WT_GU1 + (size_t)NGU * D * 2, WT_IN = WT_DN1 + (size_t)D * FF * 2, WT_UQ = WT_IN + (size_t)4096 * D * 2,
                 WT_UKV = WT_UQ + (size_t)1536 * 512 * 2, WT_OUT = WT_UKV + (size_t)2048 * 256 * 2, WT_GU2 = WT_OUT + (size_t)D * D * 2, WT_DN2 = WT_GU2 + (size_t)NGU * D * 2,
                 WT_LAYER = WT_DN2 + (size_t)D * FF * 2;
static_assert(2 * WT_LAYER <= 340 * MiB, "wt");
constexpr int NPIN = 4096;

__device__ __forceinline__ unsigned pk2(float lo, float hi) { return (unsigned)f2bf(lo) | ((unsigned)f2bf(hi) << 16); }
__device__ __forceinline__ unsigned cvtpk(float lo, float hi) { unsigned r; asm volatile("v_cvt_pk_bf16_f32 %0, %1, %2" : "=v"(r) : "v"(lo), "v"(hi)); return r; }
__device__ __forceinline__ float fsilu(float x) { return x * __builtin_amdgcn_rcpf(1.f + __expf(-x)); }

__device__ __forceinline__ int src_block(int kind, int nb) {
    const int pn = nb >> 3, jb = nb & 7;
    if (kind == 0) return 32 * nb;
    if (kind == 1) return (jb < 4) ? 128 * pn + 32 * jb : FF + 128 * pn + 32 * (jb - 4);
    if (kind == 2) {
        if (pn < 4) { const int rb = pn < 2 ? C_QR : C_KR; return rb + (4 * (pn & 1) + (jb & 3)) * 64 + 32 * (jb >> 2); }
        if (pn < 15) return 256 * pn + 32 * jb;
        return jb == 0 ? C_KPE : (jb == 4 ? C_KPE + 32 : -1);
    }
    if (pn < 4) return (2 * pn + (jb >> 2)) * DQK + 32 * (jb & 3);
    return (4 * (pn - 4) + (jb & 3)) * DQK + NOPE + 32 * (jb >> 2);
}
struct CvtDesc { const float* W; const float* scale; bf16_t* WT; const float* sh; float* bias; int ldw, K, k0, src0, dst0; };
__device__ __forceinline__ void cvt_load(const CvtDesc& d, f32x4 (&v)[8], int lane) {
    if (d.src0 >= 0) {
#pragma unroll
        for (int i = 0; i < 8; ++i) { const int row = i * 8 + (lane >> 3); v[i] = *(const f32x4*)(d.W + (size_t)(d.k0 + row) * d.ldw + d.src0 + 4 * (lane & 7)); }
    } else {
#pragma unroll
        for (int i = 0; i < 8; ++i) v[i] = (f32x4){0.f, 0.f, 0.f, 0.f};
    }
}
__device__ __forceinline__ void cvt_process(const CvtDesc& d, f32x4 (&v)[8], LAS float* scr, LAS float* shs, int lane) {
    if (d.scale) {
#pragma unroll
        for (int i = 0; i < 8; ++i) v[i] *= d.scale[d.k0 + i * 8 + (lane >> 3)]; }
#pragma unroll
    for (int i = 0; i < 8; ++i) { LAS float* q = scr + (i * 8 + (lane >> 3)) * 33 + 4 * (lane & 7); q[0] = v[i][0]; q[1] = v[i][1]; q[2] = v[i][2]; q[3] = v[i][3]; }
    const bool wb = d.sh && d.src0 >= 0;
    if (wb) {
#pragma unroll
        for (int j = 0; j < 4; ++j) shs[lane * 4 + j] = d.sh[(size_t)j * NMOD * D + d.k0 + lane];
    }
    LDS_WAIT(); asm volatile("" ::: "memory");
    const int c = lane & 7;
#pragma unroll
    for (int j = 0; j < 4; ++j) { const int n = (lane >> 3) + 8 * j; const LAS float* s = scr + (8 * c) * 33 + n;
        v4u o; o.x = pk2(s[0 * 33], s[1 * 33]); o.y = pk2(s[2 * 33], s[3 * 33]); o.z = pk2(s[4 * 33], s[5 * 33]); o.w = pk2(s[6 * 33], s[7 * 33]);
        *(v4u*)(d.WT + (size_t)(d.dst0 + n) * d.K + d.k0 + 8 * c) = o; }
    if (wb) {
        const int n = lane & 31, kh = lane >> 5; f32x4 a = {0.f, 0.f, 0.f, 0.f};
#pragma unroll 8
        for (int kk = 0; kk < 32; ++kk) { const int kq = kh * 32 + kk; a += *(const LAS f32x4*)(shs + kq * 4) * scr[kq * 33 + n]; }
#pragma unroll
        for (int j = 0; j < 4; ++j) { float t = a[j]; t += __shfl_xor(t, 32); if (lane < 32) __hip_atomic_fetch_add(d.bias + (size_t)j * NGU + d.dst0 + n, t, __ATOMIC_RELAXED, __HIP_MEMORY_SCOPE_AGENT); }
    }
    LDS_WAIT(); asm volatile("" ::: "memory");
}

struct EpiGU {
    static constexpr bool PERM = true, AFTER_DRAIN = false;
    bf16_t* act; const float* ss; const float* bias;
    __device__ __forceinline__ void operator()(const f32x4 (&acc)[2][2][4][2], const pg8::Unit& u, int wr, int wc, int fr, int fq) const {
        const int row0 = u.pm * 256 + wr * 64 + fr, b = u.pm >> 4, cb = u.pn * 256 + wc * 32 + 8 * fq, oc = u.pn * 128 + wc * 32 + 8 * fq;
        const float* bp = bias + (size_t)b * NGU + cb;
        const f32x4 bg0 = *(const f32x4*)bp, bg1 = *(const f32x4*)(bp + 4), bu0 = *(const f32x4*)(bp + 128), bu1 = *(const f32x4*)(bp + 132);
        float rsv[2][4];
#pragma unroll
        for (int ai = 0; ai < 2; ++ai)
#pragma unroll
            for (int m = 0; m < 4; ++m) rsv[ai][m] = ss[row0 + ai * 128 + m * 16];
#pragma unroll
        for (int ai = 0; ai < 2; ++ai)
#pragma unroll
            for (int m = 0; m < 4; ++m) { const int row = row0 + ai * 128 + m * 16; const float rs = rsqrtf(rsv[ai][m] * (1.f / D) + EPS);
                const f32x4 g0 = acc[ai][0][m][0] * rs + bg0, g1 = acc[ai][0][m][1] * rs + bg1, u0 = acc[ai][1][m][0] * rs + bu0, u1 = acc[ai][1][m][1] * rs + bu1;
                v4u w; w.x = cvtpk(fsilu(g0[0]) * u0[0], fsilu(g0[1]) * u0[1]); w.y = cvtpk(fsilu(g0[2]) * u0[2], fsilu(g0[3]) * u0[3]);
                w.z = cvtpk(fsilu(g1[0]) * u1[0], fsilu(g1[1]) * u1[1]); w.w = cvtpk(fsilu(g1[2]) * u1[2], fsilu(g1[3]) * u1[3]);
                *(v4u*)(act + (size_t)row * FF + oc) = w; }
    }
};
typedef _Float16 f16_t;
typedef _Float16 f16x8 __attribute__((ext_vector_type(8)));
template <bool XF32> struct EpiRes {
    static constexpr bool PERM = true, AFTER_DRAIN = false;
    const float* xin32; const f16_t* xin16; f16_t* xout; bf16_t* xg; float* ssn; const float* gatef; const float* gmn; int has_next, mode;
    __device__ __forceinline__ void operator()(const f32x4 (&acc)[2][2][4][2], const pg8::Unit& u, int wr, int wc, int fr, int fq) const {
        const int row0 = u.pm * 256 + wr * 64 + fr, b = u.pm >> 4, c0 = u.pn * 256 + wc * 32 + 8 * fq;
        const float* gp = gatef + (size_t)b * D + c0; const float* mp = gmn + (size_t)b * D + c0;
        f32x4 gt[2][2], gm[2][2];
#pragma unroll
        for (int bj = 0; bj < 2; ++bj)
#pragma unroll
            for (int n = 0; n < 2; ++n) { gt[bj][n] = *(const f32x4*)(gp + bj * 128 + 4 * n); gm[bj][n] = has_next ? *(const f32x4*)(mp + bj * 128 + 4 * n) : (f32x4){0.f, 0.f, 0.f, 0.f}; }
        f32x4 xv[2][2][2][2]; f16x8 xh[2][2][2];
#define ER_LOAD(q) do { _Pragma("unroll") for (int mm = 0; mm < 2; ++mm) _Pragma("unroll") for (int bj = 0; bj < 2; ++bj) { \
            const size_t off_ = (size_t)(row0 + ((q) >> 1) * 128 + (2 * ((q) & 1) + mm) * 16) * D + c0 + bj * 128; \
            if constexpr (XF32) { xv[(q) & 1][mm][bj][0] = *(const f32x4*)(xin32 + off_); xv[(q) & 1][mm][bj][1] = *(const f32x4*)(xin32 + off_ + 4); } \
            else { xh[(q) & 1][mm][bj] = *(const f16x8*)(xin16 + off_); } } } while (0)
        if constexpr (!XF32) ER_LOAD(0);
        float sqa[4];
#pragma unroll
        for (int q = 0; q < 4; ++q) { const int ai = q >> 1;
            if constexpr (XF32) ER_LOAD(q); else if (q + 1 < 4) ER_LOAD(q + 1);
#pragma unroll
            for (int mm = 0; mm < 2; ++mm) { const int m = 2 * (q & 1) + mm, row = row0 + ai * 128 + m * 16; float sq = 0.f;
#pragma unroll
                for (int bj = 0; bj < 2; ++bj) { const size_t off = (size_t)row * D + c0 + bj * 128;
                    f32x4 x0, x1;
                    if constexpr (XF32) { x0 = xv[q & 1][mm][bj][0]; x1 = xv[q & 1][mm][bj][1]; }
                    else { const f16x8 h = xh[q & 1][mm][bj]; x0 = (f32x4){(float)h[0], (float)h[1], (float)h[2], (float)h[3]}; x1 = (f32x4){(float)h[4], (float)h[5], (float)h[6], (float)h[7]}; }
                    const f32x4 n0 = x0 + gt[bj][0] * acc[ai][bj][m][0], n1 = x1 + gt[bj][1] * acc[ai][bj][m][1];
                    { f16x8 o; o[0] = (f16_t)n0[0]; o[1] = (f16_t)n0[1]; o[2] = (f16_t)n0[2]; o[3] = (f16_t)n0[3]; o[4] = (f16_t)n1[0]; o[5] = (f16_t)n1[1]; o[6] = (f16_t)n1[2]; o[7] = (f16_t)n1[3];
                      *(f16x8*)(xout + off) = o; }
                    sq += (n0[0] * n0[0] + n0[1] * n0[1]) + (n0[2] * n0[2] + n0[3] * n0[3]) + (n1[0] * n1[0] + n1[1] * n1[1]) + (n1[2] * n1[2] + n1[3] * n1[3]);
                    if (has_next) { const f32x4 a = n0 * gm[bj][0], c2 = n1 * gm[bj][1];
                        v4u w; w.x = cvtpk(a[0], a[1]); w.y = cvtpk(a[2], a[3]); w.z = cvtpk(c2[0], c2[1]); w.w = cvtpk(c2[2], c2[3]);
                        *(v4u*)(xg + off) = w; } }
                sq += __shfl_xor(sq, 16); sq += __shfl_xor(sq, 32); sqa[m] = sq; }
            if (q & 1) { const float sv = fq == 0 ? sqa[0] : fq == 1 ? sqa[1] : fq == 2 ? sqa[2] : sqa[3];
                __hip_atomic_fetch_add(ssn + (u.pm * 256 + wr * 64 + ai * 128 + fq * 16 + fr), sv, __ATOMIC_RELAXED, __HIP_MEMORY_SCOPE_AGENT); }
            asm volatile("" ::: "memory"); }
#undef ER_LOAD
    }
};
struct EpiIn {
    static constexpr bool PERM = true, AFTER_DRAIN = false;
    const float* ss; const float* bias; const float* cosT; const float* sinT;
    bf16_t *qr, *kr, *vr, *gr, *cq, *ckv, *Kb; float *ssq, *sskv;
    __device__ __forceinline__ void operator()(const f32x4 (&acc)[2][2][4][2], const pg8::Unit& u, int wr, int wc, int fr, int fq) const {
        const int row0 = u.pm * 256 + wr * 64 + fr, b = u.pm >> 4, pn = u.pn, cb = pn * 256 + wc * 32 + 8 * fq;
        const float* bp = bias + (size_t)b * NGU + cb;
        const f32x4 b00 = *(const f32x4*)bp, b01 = *(const f32x4*)(bp + 4), b10 = *(const f32x4*)(bp + 128), b11 = *(const f32x4*)(bp + 132);
        float rsv[2][4];
#pragma unroll
        for (int ai = 0; ai < 2; ++ai)
#pragma unroll
            for (int m = 0; m < 4; ++m) rsv[ai][m] = ss[row0 + ai * 128 + m * 16];
        asm volatile("" :: "v"(b00), "v"(b01), "v"(b10), "v"(b11), "v"(rsv[0][0]), "v"(rsv[0][1]), "v"(rsv[0][2]), "v"(rsv[0][3]), "v"(rsv[1][0]), "v"(rsv[1][1]), "v"(rsv[1][2]), "v"(rsv[1][3]));
        if (pn == 15 && wc != 0) return;
        if (pn < 4 || pn == 15) {
            const float scale = (pn == 2 || pn == 3) ? 0.125f : 1.0f;
#pragma unroll
            for (int ai = 0; ai < 2; ++ai)
#pragma unroll
                for (int m = 0; m < 4; ++m) { const int row = row0 + ai * 128 + m * 16; const float rs = rsqrtf(rsv[ai][m] * (1.f / D) + EPS);
                    const f32x4 x10 = acc[ai][0][m][0] * rs + b00, x11 = acc[ai][0][m][1] * rs + b01, x20 = acc[ai][1][m][0] * rs + b10, x21 = acc[ai][1][m][1] * rs + b11;
                    const f32x4 c0 = *(const f32x4*)(cosT + (size_t)row * 32 + 8 * fq), c1 = *(const f32x4*)(cosT + (size_t)row * 32 + 8 * fq + 4);
                    const f32x4 s0 = *(const f32x4*)(sinT + (size_t)row * 32 + 8 * fq), s1 = *(const f32x4*)(sinT + (size_t)row * 32 + 8 * fq + 4);
                    const f32x4 o10 = (x10 * c0 - x20 * s0) * scale, o11 = (x11 * c1 - x21 * s1) * scale, o20 = (x10 * s0 + x20 * c0) * scale, o21 = (x11 * s1 + x21 * c1) * scale;
                    v4u w1, w2; w1.x = cvtpk(o10[0], o10[1]); w1.y = cvtpk(o10[2], o10[3]); w1.z = cvtpk(o11[0], o11[1]); w1.w = cvtpk(o11[2], o11[3]);
                    w2.x = cvtpk(o20[0], o20[1]); w2.y = cvtpk(o20[2], o20[3]); w2.z = cvtpk(o21[0], o21[1]); w2.w = cvtpk(o21[2], o21[3]);
                    if (pn < 4) { bf16_t* dst = (pn < 2 ? qr : kr) + (size_t)row * 512 + (4 * (pn & 1) + wc) * 64 + 8 * fq; *(v4u*)dst = w1; *(v4u*)(dst + 32) = w2; }
                    else {
#pragma unroll
                        for (int h = 0; h < MH; ++h) { bf16_t* dst = Kb + (size_t)row * MH * DQK + h * DQK + NOPE + 8 * fq; *(v4u*)dst = w1; *(v4u*)(dst + 32) = w2; } }
                    asm volatile("" ::: "memory"); }
        } else {
            bf16_t* dbase; int ld; float* ssp = nullptr;
            if (pn < 8) { dbase = vr + (pn - 4) * 256; ld = 1024; } else if (pn < 12) { dbase = gr + (pn - 8) * 256; ld = 1024; }
            else if (pn < 14) { dbase = cq + (pn - 12) * 256; ld = 512; ssp = ssq; } else { dbase = ckv; ld = 256; ssp = sskv; }
            const bool gate = (pn >= 8 && pn < 12);
#pragma unroll
            for (int ai = 0; ai < 2; ++ai)
#pragma unroll
                for (int m = 0; m < 4; ++m) { const int row = row0 + ai * 128 + m * 16; const float rs = rsqrtf(rsv[ai][m] * (1.f / D) + EPS); float q = 0.f;
#pragma unroll
                    for (int bj = 0; bj < 2; ++bj) { f32x4 v0 = acc[ai][bj][m][0] * rs + (bj ? b10 : b00), v1 = acc[ai][bj][m][1] * rs + (bj ? b11 : b01);
                        q += (v0[0] * v0[0] + v0[1] * v0[1]) + (v0[2] * v0[2] + v0[3] * v0[3]) + (v1[0] * v1[0] + v1[1] * v1[1]) + (v1[2] * v1[2] + v1[3] * v1[3]);
                        if (gate) {
#pragma unroll
                            for (int i = 0; i < 4; ++i) { v0[i] = fsilu(v0[i]); v1[i] = fsilu(v1[i]); } }
                        v4u w; w.x = cvtpk(v0[0], v0[1]); w.y = cvtpk(v0[2], v0[3]); w.z = cvtpk(v1[0], v1[1]); w.w = cvtpk(v1[2], v1[3]);
                        *(v4u*)(dbase + (size_t)row * ld + bj * 128 + wc * 32 + 8 * fq) = w; }
                    if (ssp) { q += __shfl_xor(q, 16); q += __shfl_xor(q, 32); if (fq == 0) __hip_atomic_fetch_add(ssp + row, q, __ATOMIC_RELAXED, __HIP_MEMORY_SCOPE_AGENT); }
                    asm volatile("" ::: "memory"); }
        }
    }
};
struct EpiUq {
    static constexpr bool PERM = true, AFTER_DRAIN = false;
    const float* ssq; const float* cosT; const float* sinT; bf16_t* Qb;
    __device__ __forceinline__ void operator()(const f32x4 (&acc)[2][2][4][2], const pg8::Unit& u, int wr, int wc, int fr, int fq) const {
        const int row0 = u.pm * 256 + wr * 64 + fr, pn = u.pn;
        float rsv[2][4];
#pragma unroll
        for (int ai = 0; ai < 2; ++ai)
#pragma unroll
            for (int m = 0; m < 4; ++m) rsv[ai][m] = ssq[row0 + ai * 128 + m * 16];
#pragma unroll
        for (int ai = 0; ai < 2; ++ai)
#pragma unroll
            for (int m = 0; m < 4; ++m) { const int row = row0 + ai * 128 + m * 16; const float rs = rsqrtf(rsv[ai][m] * (1.f / QRANK) + EPS);
                if (pn < 4) {
#pragma unroll
                    for (int bj = 0; bj < 2; ++bj) { const f32x4 v0 = acc[ai][bj][m][0] * rs, v1 = acc[ai][bj][m][1] * rs;
                        v4u w; w.x = cvtpk(v0[0], v0[1]); w.y = cvtpk(v0[2], v0[3]); w.z = cvtpk(v1[0], v1[1]); w.w = cvtpk(v1[2], v1[3]);
                        *(v4u*)(Qb + (size_t)row * MH * DQK + (2 * pn + bj) * DQK + wc * 32 + 8 * fq) = w; }
                } else {
                    const f32x4 x10 = acc[ai][0][m][0] * rs, x11 = acc[ai][0][m][1] * rs, x20 = acc[ai][1][m][0] * rs, x21 = acc[ai][1][m][1] * rs;
                    const f32x4 c0 = *(const f32x4*)(cosT + (size_t)row * 32 + 8 * fq), c1 = *(const f32x4*)(cosT + (size_t)row * 32 + 8 * fq + 4);
                    const f32x4 s0 = *(const f32x4*)(sinT + (size_t)row * 32 + 8 * fq), s1 = *(const f32x4*)(sinT + (size_t)row * 32 + 8 * fq + 4);
                    const f32x4 o10 = x10 * c0 - x20 * s0, o11 = x11 * c1 - x21 * s1, o20 = x10 * s0 + x20 * c0, o21 = x11 * s1 + x21 * c1;
                    v4u w1, w2; w1.x = cvtpk(o10[0], o10[1]); w1.y = cvtpk(o10[2], o10[3]); w1.z = cvtpk(o11[0], o11[1]); w1.w = cvtpk(o11[2], o11[3]);
                    w2.x = cvtpk(o20[0], o20[1]); w2.y = cvtpk(o20[2], o20[3]); w2.z = cvtpk(o21[0], o21[1]); w2.w = cvtpk(o21[2], o21[3]);
                    bf16_t* dst = Qb + (size_t)row * MH * DQK + (4 * (pn - 4) + wc) * DQK + NOPE + 8 * fq; *(v4u*)dst = w1; *(v4u*)(dst + 32) = w2;
                }
                asm volatile("" ::: "memory"); }
    }
};
struct EpiUkv {
    static constexpr bool PERM = true, AFTER_DRAIN = false;
    const float* sskv; bf16_t* Kb; bf16_t* Vb;
    __device__ __forceinline__ void operator()(const f32x4 (&acc)[2][2][4][2], const pg8::Unit& u, int wr, int wc, int fr, int fq) const {
        const int row0 = u.pm * 256 + wr * 64 + fr, pn = u.pn;
        float rsv[2][4];
#pragma unroll
        for (int ai = 0; ai < 2; ++ai)
#pragma unroll
            for (int m = 0; m < 4; ++m) rsv[ai][m] = sskv[row0 + ai * 128 + m * 16];
#pragma unroll
        for (int ai = 0; ai < 2; ++ai)
#pragma unroll
            for (int m = 0; m < 4; ++m) { const int row = row0 + ai * 128 + m * 16; const float rs = rsqrtf(rsv[ai][m] * (1.f / KVRANK) + EPS);
#pragma unroll
                for (int bj = 0; bj < 2; ++bj) { const f32x4 v0 = acc[ai][bj][m][0] * rs, v1 = acc[ai][bj][m][1] * rs;
                    v4u w; w.x = cvtpk(v0[0], v0[1]); w.y = cvtpk(v0[2], v0[3]); w.z = cvtpk(v1[0], v1[1]); w.w = cvtpk(v1[2], v1[3]);
                    bf16_t* dst = bj ? Vb + (size_t)row * MH * MDV + pn * MDV + wc * 32 + 8 * fq : Kb + (size_t)row * MH * DQK + pn * DQK + wc * 32 + 8 * fq;
                    *(v4u*)dst = w; }
                asm volatile("" ::: "memory"); }
    }
};

namespace att {
typedef short s16x4 __attribute__((ext_vector_type(4)));
typedef float f32x16 __attribute__((ext_vector_type(16)));
constexpr int SHM_V = 64 * 128 * 2, SHM_K = 64 * DQK * 2;
constexpr int V_OFF = 0, K_OFF = 2 * SHM_V, WS_OFF = K_OFF + 2 * SHM_K;
constexpr float SCALE = 0.07216878364870323f;
constexpr float THR = 8.f;
#define ATT_SBAR() __builtin_amdgcn_sched_barrier(0)
__device__ __forceinline__ int v_st(int k, int c) { const int kk = (k & ~0xC) | ((k & 4) << 1) | ((k & 8) >> 1); return ((kk >> 3) * 4 + (c >> 5)) * 512 + ((kk & 7) * 32 + (c & 31)) * 2; }
__device__ __forceinline__ int v_rd_base(int lane) { return ((lane & 3) << 3) | (((lane >> 2) & 3) << 6) | (((lane >> 4) & 1) << 5) | (((lane >> 5) & 1) << 8); }
constexpr int v_rd_off(int d0, int ks, int half) { return d0 * 512 + ks * 4096 + half * 2048; }
__device__ __forceinline__ int crow(int r, int hi) { return (r & 3) + 8 * (r >> 2) + 4 * hi; }
__device__ __forceinline__ int k_off(int r, int ch) { return r * 384 + (((ch & ~7) | ((ch ^ (r >> 1)) & 7)) << 4); }
__device__ __forceinline__ void mask_tile(f32x16& p0, f32x16& p1, int dq) {
    const float NEG = -__builtin_inff();
#pragma unroll
    for (int r = 0; r < 16; ++r) { const int c = (r & 3) + 8 * (r >> 2); if (dq - c < 0) p0[r] = NEG; if (dq - c - 32 < 0) p1[r] = NEG; }
}
__device__ __forceinline__ void partialSM(f32x16& p0, f32x16& p1, float& m_reg, float& mn, float& alpha) {
    float pmax = p0[0];
#pragma unroll
    for (int r = 1; r < 16; ++r) pmax = fmaxf(pmax, p0[r]);
#pragma unroll
    for (int r = 0; r < 16; ++r) pmax = fmaxf(pmax, p1[r]);
    { auto rr = __builtin_amdgcn_permlane32_swap(__float_as_uint(pmax), __float_as_uint(pmax), false, false);
      pmax = fmaxf(__uint_as_float(rr[0]), __uint_as_float(rr[1])); }
    constexpr float C2 = 1.4426950408889634f * SCALE;
    if (__builtin_expect(__all((pmax - m_reg) * SCALE <= THR), 1)) { mn = m_reg; alpha = 1.f; }
    else { mn = fmaxf(m_reg, pmax); alpha = __builtin_amdgcn_exp2f((m_reg - mn) * C2); m_reg = mn; }
    const float mnL = -mn * C2;
#pragma unroll
    for (int r = 0; r < 16; ++r) p0[r] = fmaf(p0[r], C2, mnL);
#pragma unroll
    for (int r = 0; r < 16; ++r) p1[r] = fmaf(p1[r], C2, mnL);
#pragma unroll
    for (int r = 0; r < 16; ++r) p0[r] = __builtin_amdgcn_exp2f(p0[r]);
}
#define ATT_PK4(P, B_, OUT) do { unsigned a0 = cvtpk(P[B_+0], P[B_+1]), a1 = cvtpk(P[B_+2], P[B_+3]); unsigned b0 = cvtpk(P[B_+4], P[B_+5]), b1 = cvtpk(P[B_+6], P[B_+7]); \
        auto r0 = __builtin_amdgcn_permlane32_swap(a0, b0, false, false); auto r1 = __builtin_amdgcn_permlane32_swap(a1, b1, false, false); \
        v4u w = {r0[0], r1[0], r0[1], r1[1]}; OUT = *reinterpret_cast<bf16x8*>(&w); } while (0)
__device__ __forceinline__ void pack_p(const f32x16& p0, const f32x16& p1, bf16x8& pa0, bf16x8& pa1, bf16x8& pa2, bf16x8& pa3) {
    ATT_PK4(p0, 0, pa0); ATT_PK4(p0, 8, pa1); ATT_PK4(p1, 0, pa2); ATT_PK4(p1, 8, pa3);
}
__device__ __forceinline__ void finishSM(f32x16& p0, f32x16& p1, float alpha, float& l_reg, bf16x8& pa0, bf16x8& pa1, bf16x8& pa2, bf16x8& pa3) {
#pragma unroll
    for (int r = 0; r < 16; ++r) p1[r] = __builtin_amdgcn_exp2f(p1[r]);
    float ps = 0;
#pragma unroll
    for (int r = 0; r < 16; ++r) ps += p0[r];
#pragma unroll
    for (int r = 0; r < 16; ++r) ps += p1[r];
    { auto rr = __builtin_amdgcn_permlane32_swap(__float_as_uint(ps), __float_as_uint(ps), false, false);
      ps = __uint_as_float(rr[0]) + __uint_as_float(rr[1]); }
    l_reg = l_reg * alpha + ps;
    pack_p(p0, p1, pa0, pa1, pa2, pa3);
}
template <int ND, int KROW>
__device__ __forceinline__ void qkt(f32x16& p0, f32x16& p1, const LAS unsigned char* kbuf, int r32, int hi, const bf16x8* qf) {
    p0 = f32x16{}; p1 = f32x16{};
    int ka[4];
#pragma unroll
    for (int dd = 0; dd < 4; ++dd) ka[dd] = (int)(uintptr_t)kbuf + r32 * KROW + ((((2 * dd + hi) ^ (r32 >> 1)) & 7) << 4);
    bf16x8 f0[2], f1[2];
#define ATT_KRD(dst, addr, off) asm volatile("ds_read_b128 %0, %1 offset:%2" : "=&v"(dst) : "v"(addr), "i"(off) : "memory")
    __builtin_amdgcn_sched_barrier(0);
    ATT_KRD(f0[0], ka[0], 0); ATT_KRD(f1[0], ka[0], 32 * KROW);
#pragma unroll
    for (int d0 = 0; d0 < ND; ++d0) {
        if (d0 + 1 < ND) { ATT_KRD(f0[(d0 + 1) & 1], ka[(d0 + 1) & 3], ((d0 + 1) >> 2) * 128); ATT_KRD(f1[(d0 + 1) & 1], ka[(d0 + 1) & 3], ((d0 + 1) >> 2) * 128 + 32 * KROW); }
        if (d0 + 1 < ND) asm volatile("s_waitcnt lgkmcnt(2)" ::: "memory"); else asm volatile("s_waitcnt lgkmcnt(0)" ::: "memory");
        __builtin_amdgcn_sched_barrier(0);
        p0 = __builtin_amdgcn_mfma_f32_32x32x16_bf16(f0[d0 & 1], qf[d0], p0, 0, 0, 0);
        p1 = __builtin_amdgcn_mfma_f32_32x32x16_bf16(f1[d0 & 1], qf[d0], p1, 0, 0, 0);
        __builtin_amdgcn_sched_barrier(0);
    }
#undef ATT_KRD
}
template <int VB>
__device__ __forceinline__ void pv_tile(f32x16* o, int vb0, bf16x8 pa0, bf16x8 pa1, bf16x8 pa2, bf16x8 pa3) {
#define ATT_TRRD(dst, off) asm volatile("ds_read_b64_tr_b16 %0, %1 offset:%2" : "=&v"(dst) : "v"(vb0), "i"(off) : "memory")
#define ATT_PV_D0(d0) do { s16x4 l0, l1, l2, l3, h0, h1, h2, h3; constexpr int b_ = VB * SHM_V + v_rd_off(d0, 0, 0); \
        ATT_TRRD(l0, b_); ATT_TRRD(h0, b_ + 2048); ATT_TRRD(l1, b_ + 4096); ATT_TRRD(h1, b_ + 6144); ATT_TRRD(l2, b_ + 8192); ATT_TRRD(h2, b_ + 10240); ATT_TRRD(l3, b_ + 12288); ATT_TRRD(h3, b_ + 14336); \
        asm volatile("s_waitcnt lgkmcnt(0)" ::: "memory"); ATT_SBAR(); \
        o[d0] = __builtin_amdgcn_mfma_f32_32x32x16_bf16(pa0, (bf16x8){l0[0], l0[1], l0[2], l0[3], h0[0], h0[1], h0[2], h0[3]}, o[d0], 0, 0, 0); \
        o[d0] = __builtin_amdgcn_mfma_f32_32x32x16_bf16(pa1, (bf16x8){l1[0], l1[1], l1[2], l1[3], h1[0], h1[1], h1[2], h1[3]}, o[d0], 0, 0, 0); \
        o[d0] = __builtin_amdgcn_mfma_f32_32x32x16_bf16(pa2, (bf16x8){l2[0], l2[1], l2[2], l2[3], h2[0], h2[1], h2[2], h2[3]}, o[d0], 0, 0, 0); \
        o[d0] = __builtin_amdgcn_mfma_f32_32x32x16_bf16(pa3, (bf16x8){l3[0], l3[1], l3[2], l3[3], h3[0], h3[1], h3[2], h3[3]}, o[d0], 0, 0, 0); } while (0)
    ATT_PV_D0(0); ATT_PV_D0(1); ATT_PV_D0(2); ATT_PV_D0(3);
#undef ATT_PV_D0
#undef ATT_TRRD
}
__device__ __forceinline__ void store_o_bf16(const f32x16* o, const float* rsc, bf16_t* dst, int ld, int r32, int hi) {
#pragma unroll
    for (int r = 0; r < 16; ++r) { const int orow = crow(r, hi);
#pragma unroll
        for (int d0 = 0; d0 < 4; ++d0) { const float v = o[d0][r] * rsc[r]; const float vn = __shfl_xor(v, 1);
            if ((r32 & 1) == 0) *(unsigned*)(dst + (size_t)orow * ld + d0 * 32 + r32) = cvtpk(v, vn); } }
}

__device__ __forceinline__ bf16x8 bload8(__amdgpu_buffer_rsrc_t rs, int voff, int soff) { const v4u w = __builtin_amdgcn_raw_buffer_load_b128(rs, voff, soff, 0); return *reinterpret_cast<const bf16x8*>(&w); }
__device__ __forceinline__ void attn_phase(LAS unsigned char* lds, const bf16_t* Qb, const bf16_t* Kb, const bf16_t* Vb, bf16_t* y, int G, int bx, int mode = 0) {
    int tid_ = threadIdx.x; asm volatile("" : "+v"(tid_));
    const int tid = tid_, wid = __builtin_amdgcn_readfirstlane(tid >> 6), lane = tid & 63, r32 = lane & 31, hi = lane >> 5;
    const int late = wid >> 2;
    LAS unsigned char* V_lds = lds + V_OFF; LAS unsigned char* K_lds = lds + K_OFF;
    LAS float* wsr = (LAS float*)(lds + WS_OFF) + wid * 64; LAS float* li_l = wsr; LAS float* al_l = wsr + 32;
    const __amdgpu_buffer_rsrc_t rsQ = __builtin_amdgcn_make_buffer_rsrc((void*)Qb, (short)0, (int)((size_t)M * MH * DQK * 2), 0x00020000),
        rsK = __builtin_amdgcn_make_buffer_rsrc((void*)Kb, (short)0, (int)((size_t)M * MH * DQK * 2), 0x00020000), rsV = __builtin_amdgcn_make_buffer_rsrc((void*)Vb, (short)0, (int)((size_t)M * MH * MDV * 2), 0x00020000);
    int kgo[3], kld[3];
#pragma unroll
    for (int i = 0; i < 3; ++i) { const int id = tid + 512 * i, row = id / 24, ch = id % 24; kgo[i] = (row * MH * DQK + ch * 8) * 2; kld[i] = k_off(row, ch); }
    const int sr = tid >> 4, sc = (tid & 15) * 8, vst0 = v_st(sr, sc), vst1 = v_st(32 + sr, sc), vgo0 = (sr * MH * MDV + sc) * 2, vgo1 = ((32 + sr) * MH * MDV + sc) * 2;
    const int vb0 = (int)(uintptr_t)V_lds + v_rd_base(lane);
    const int qgo = ((wid * 32 + r32) * MH * DQK + hi * 8) * 2;
    for (int item = bx; item < NB * MH * 8; item += G) {
        const int h = item & 7, slot = item >> 3, b = slot >> 3, x = slot & 7;
        const int ksb = (b * SEQ * MH + h) * DQK * 2, vsb = (b * SEQ * MH + h) * MDV * 2;
        for (int pass = 0; pass < 2; ++pass) {
            const int qb = pass ? 15 - x : x, q0 = qb * 256, NT = 4 * qb + 4;
            bf16x8 qf[12];
#pragma unroll
            for (int d0 = 0; d0 < 12; ++d0) qf[d0] = bload8(rsQ, qgo + d0 * 32, ksb + q0 * MH * DQK * 2);
            const int qm = q0 + wid * 32 + r32 - 4 * hi;
            float m_reg = -1e30f, l_reg = 0.f; f32x16 o[4] = {};
            f32x16 p0, p1; bf16x8 pa0, pa1, pa2, pa3;
            bf16x8 sk0, sk1, sk2, sv0, sv1;
#define ATT_LOADK(kb_) do { const int ks_ = ksb + (kb_) * MH * DQK * 2; sk0 = bload8(rsK, kgo[0], ks_); sk1 = bload8(rsK, kgo[1], ks_); sk2 = bload8(rsK, kgo[2], ks_); } while (0)
#define ATT_LOADV(kb_) do { const int vs_ = vsb + (kb_) * MH * MDV * 2; sv0 = bload8(rsV, vgo0, vs_); sv1 = bload8(rsV, vgo1, vs_); } while (0)
#define ATT_WRITEK(bf) do { *(LAS bf16x8*)(K_lds + (bf) * SHM_K + kld[0]) = sk0; *(LAS bf16x8*)(K_lds + (bf) * SHM_K + kld[1]) = sk1; *(LAS bf16x8*)(K_lds + (bf) * SHM_K + kld[2]) = sk2; } while (0)
#define ATT_WRITEV(bf) do { *(LAS bf16x8*)(V_lds + (bf) * SHM_V + vst0) = sv0; *(LAS bf16x8*)(V_lds + (bf) * SHM_V + vst1) = sv1; } while (0)
#define ATT_RESC(a) do { if (__any((a) < 1.f)) { if (hi == 0) al_l[r32] = (a); asm volatile("s_waitcnt lgkmcnt(0)" ::: "memory"); \
        _Pragma("unroll") for (int d_ = 0; d_ < 4; ++d_) _Pragma("unroll") for (int r = 0; r < 16; ++r) o[d_][r] *= al_l[crow(r, hi)]; } } while (0)
#define ATT_BAR() do { asm volatile("s_waitcnt lgkmcnt(0)" ::: "memory"); __builtin_amdgcn_s_barrier(); asm volatile("" ::: "memory"); } while (0)
            ATT_LOADK(0); ATT_WRITEK(0); ATT_LOADK(64); ATT_LOADV(0);
            ATT_BAR();
#define ATT_QK(t) do { if (!(mode & 1)) qkt<12, 384>(p0, p1, K_lds + ((t) & 1) * SHM_K, r32, hi, qf); } while (0)
#define ATT_PV(t) do { if (!(mode & 2)) pv_tile<0>(o, vb0 + ((t) & 1) * SHM_V, pa0, pa1, pa2, pa3); } while (0)
#define ATT_SM(t) do { if (!(mode & 4)) { float mn, alpha; if ((t) >= NT - 4) mask_tile(p0, p1, qm - (t) * 64); \
        partialSM(p0, p1, m_reg, mn, alpha); ATT_RESC(alpha); finishSM(p0, p1, alpha, l_reg, pa0, pa1, pa2, pa3); } } while (0)
#define ATT_STAGE(t) do { if (!(mode & 8)) { if ((t) + 1 < NT) ATT_WRITEK(((t) + 1) & 1); ATT_WRITEV((t) & 1); if ((t) + 2 < NT) ATT_LOADK(((t) + 2) * 64); if ((t) + 1 < NT) ATT_LOADV(((t) + 1) * 64); } } while (0)
            if (late == 0) {
                ATT_QK(0); ATT_BAR();
                ATT_SM(0); ATT_STAGE(0); ATT_BAR();
                for (int t = 1; t < NT; ++t) {
                    ATT_PV(t - 1); ATT_QK(t); ATT_BAR();
                    ATT_SM(t); ATT_STAGE(t); ATT_BAR();
                }
                ATT_PV(NT - 1); ATT_BAR();
                ATT_BAR();
            } else {
                ATT_BAR();
                ATT_QK(0); ATT_STAGE(0); ATT_BAR();
                for (int t = 1; t < NT; ++t) {
                    ATT_SM(t - 1); ATT_BAR();
                    ATT_PV(t - 1); ATT_QK(t); ATT_STAGE(t); ATT_BAR();
                }
                ATT_SM(NT - 1); ATT_BAR();
                ATT_PV(NT - 1); ATT_BAR();
            }
#undef ATT_BAR
#undef ATT_QK
#undef ATT_PV
#undef ATT_SM
#undef ATT_STAGE
            if (hi == 0) li_l[r32] = l_reg; asm volatile("s_waitcnt lgkmcnt(0)" ::: "memory");
            float rli[16];
#pragma unroll
            for (int r = 0; r < 16; ++r) rli[r] = __builtin_amdgcn_rcpf(li_l[crow(r, hi)]);
            store_o_bf16(o, rli, y + ((size_t)b * SEQ + q0 + wid * 32) * MIXW + RETW + h * MDV, MIXW, r32, hi);
        }
    }
    __syncthreads();
#undef ATT_LOADK
#undef ATT_LOADV
#undef ATT_WRITEK
#undef ATT_WRITEV
#undef ATT_RESC
}
}

namespace ret {
using att::f32x16; using att::s16x4; using att::crow; using att::v_st; using att::v_rd_base; using att::bload8;
constexpr int TILE_V = 16384, TILE_K = 8192;
__device__ __forceinline__ float log2_gamma(int h) {
    return h == 0 ? -4.580368847e-02f : h == 1 ? -2.272007614e-02f : h == 2 ? -1.131531317e-02f : h == 3 ? -5.646563135e-03f : h == 4 ? -2.820519032e-03f : h == 5 ? -1.409570221e-03f : h == 6 ? -7.046129904e-04f : -3.522634797e-04f; }
#define RET_TRRD(dst, vb, off) asm volatile("ds_read_b64_tr_b16 %0, %1 offset:%2" : "=&v"(dst) : "v"(vb), "i"(off) : "memory")
__device__ __forceinline__ void inc_phase(LAS unsigned char* lds, const bf16_t* kr, const bf16_t* vr, float* incT, int G, int bx) {
    const __amdgpu_buffer_rsrc_t rsK = __builtin_amdgcn_make_buffer_rsrc((void*)kr, (short)0, (int)((size_t)M * 512 * 2), 0x00020000), rsV = __builtin_amdgcn_make_buffer_rsrc((void*)vr, (short)0, (int)((size_t)M * 1024 * 2), 0x00020000);
    LAS unsigned char* V_lds = lds; LAS unsigned char* K_lds = lds + 2 * TILE_V;
    const bool bal = (G == 256); const int ucnt = bal ? (bx < 128 ? 2 : 6) : 0, ubase = bal ? (bx < 128 ? 2 * bx : 256 + 6 * (bx - 128)) : 0;
    for (int ui = 0;; ++ui) {
        const int unit = bal ? ubase + ui : bx + ui * G;
        if (bal ? ui >= ucnt : unit >= NB * RH * 32) break;
        int tid_ = threadIdx.x; asm volatile("" : "+v"(tid_));
        const int tid = tid_, wid = __builtin_amdgcn_readfirstlane(tid >> 6), lane = tid & 63, r32 = lane & 31, hi = lane >> 5;
        const int eblk = wid & 3, dblk = wid >> 2;
        const int vbV = (int)(uintptr_t)V_lds + v_rd_base(lane) + eblk * 512, vbK = (int)(uintptr_t)K_lds + v_rd_base(lane) + dblk * 512;
        const int h = unit & 7, b = (unit >> 3) & 3, n = unit >> 5;
        const float l2g = log2_gamma(h);
        const int tok0 = b * SEQ + n * RCH;
        { bf16x8 kv[2], vv[4];
#pragma unroll
          for (int i = 0; i < 2; ++i) { const int id = tid + 512 * i, tok = id >> 3, ch = id & 7; kv[i] = bload8(rsK, (tok * 512 + ch * 8) * 2, (tok0 * 512 + h * 64) * 2); }
#pragma unroll
          for (int i = 0; i < 4; ++i) { const int id = tid + 512 * i, tok = id >> 4, c16 = id & 15; vv[i] = bload8(rsV, (tok * 1024 + c16 * 8) * 2, (tok0 * 1024 + h * 128) * 2); }
#pragma unroll
          for (int i = 0; i < 2; ++i) { const int id = tid + 512 * i, tok = id >> 3, ch = id & 7; const float dec = __builtin_amdgcn_exp2f(l2g * (float)(RCH - 1 - tok));
            v4u w; w.x = cvtpk(bf2f((bf16_t)kv[i][0]) * dec, bf2f((bf16_t)kv[i][1]) * dec); w.y = cvtpk(bf2f((bf16_t)kv[i][2]) * dec, bf2f((bf16_t)kv[i][3]) * dec);
            w.z = cvtpk(bf2f((bf16_t)kv[i][4]) * dec, bf2f((bf16_t)kv[i][5]) * dec); w.w = cvtpk(bf2f((bf16_t)kv[i][6]) * dec, bf2f((bf16_t)kv[i][7]) * dec);
            *(LAS v4u*)(K_lds + (tok >> 6) * TILE_V + v_st(tok & 63, ch * 8)) = w; }
#pragma unroll
          for (int i = 0; i < 4; ++i) { const int id = tid + 512 * i, tok = id >> 4, c16 = id & 15; *(LAS bf16x8*)(V_lds + (tok >> 6) * TILE_V + v_st(tok & 63, c16 * 8)) = vv[i]; } }
        __syncthreads();
        f32x16 acc = {};
#define RET_INC_STEP(KT, KS) do { s16x4 al, ah, bl, bh_; constexpr int o_ = (KT) * TILE_V + (KS) * 4096; \
        RET_TRRD(al, vbV, o_); RET_TRRD(ah, vbV, o_ + 2048); RET_TRRD(bl, vbK, o_); RET_TRRD(bh_, vbK, o_ + 2048); \
        asm volatile("s_waitcnt lgkmcnt(0)" ::: "memory"); __builtin_amdgcn_sched_barrier(0); \
        acc = __builtin_amdgcn_mfma_f32_32x32x16_bf16((bf16x8){al[0], al[1], al[2], al[3], ah[0], ah[1], ah[2], ah[3]}, (bf16x8){bl[0], bl[1], bl[2], bl[3], bh_[0], bh_[1], bh_[2], bh_[3]}, acc, 0, 0, 0); } while (0)
        RET_INC_STEP(0, 0); RET_INC_STEP(0, 1); RET_INC_STEP(0, 2); RET_INC_STEP(0, 3); RET_INC_STEP(1, 0); RET_INC_STEP(1, 1); RET_INC_STEP(1, 2); RET_INC_STEP(1, 3);
#undef RET_INC_STEP
        float* op = incT + ((size_t)((b * RH + h) * 32 + n)) * (RDV * RDK) + (size_t)(32 * eblk) * RDK + 32 * dblk + r32;
#pragma unroll
        for (int r = 0; r < 16; ++r) op[(size_t)crow(r, hi) * RDK] = acc[r];
        __syncthreads();
    }
}
__device__ __forceinline__ void scan_phase(const float* incT, bf16_t* prevT, int G, int vcu) {
    typedef float f32x2 __attribute__((ext_vector_type(2)));
    int tid_ = threadIdx.x; asm volatile("" : "+v"(tid_));
    for (int p = vcu * NWAVES * 64 + tid_; p < NB * RH * RDV * RDK / 2; p += G * NWAVES * 64) {
        const int bh = p >> 12, off = (p & 4095) * 2; const float cd = exp2f(log2_gamma(bh & 7) * (float)RCH);
        const float* ip = incT + (size_t)bh * 32 * (RDV * RDK) + off; bf16_t* pp = prevT + (size_t)bh * 32 * (RDV * RDK) + off;
        f32x2 st = {0.f, 0.f};
#pragma unroll
        for (int n0 = 0; n0 < 32; n0 += 16) { f32x2 iv[16];
#pragma unroll
            for (int j = 0; j < 16; ++j) iv[j] = *(const f32x2*)(ip + (size_t)(n0 + j) * (RDV * RDK));
#pragma unroll
            for (int j = 0; j < 16; ++j) { *(unsigned*)(pp + (size_t)(n0 + j) * (RDV * RDK)) = cvtpk(st[0], st[1]); st = st * cd + iv[j]; } }
    }
}
constexpr int OST_ROW = 272;
__device__ __forceinline__ void out_phase(LAS unsigned char* lds, const bf16_t* qr, const bf16_t* kr, const bf16_t* vr, const bf16_t* gr, const bf16_t* prevT, const float* rgain, bf16_t* y, int G, int bx) {
    const __amdgpu_buffer_rsrc_t rsQ = __builtin_amdgcn_make_buffer_rsrc((void*)qr, (short)0, (int)((size_t)M * 512 * 2), 0x00020000), rsK = __builtin_amdgcn_make_buffer_rsrc((void*)kr, (short)0, (int)((size_t)M * 512 * 2), 0x00020000),
        rsV = __builtin_amdgcn_make_buffer_rsrc((void*)vr, (short)0, (int)((size_t)M * 1024 * 2), 0x00020000), rsP = __builtin_amdgcn_make_buffer_rsrc((void*)prevT, (short)0, (int)((size_t)NB * RH * 32 * RDV * RDK * 2), 0x00020000),
        rsG = __builtin_amdgcn_make_buffer_rsrc((void*)gr, (short)0, (int)((size_t)M * 1024 * 2), 0x00020000);
    LAS unsigned char* V_lds = lds; LAS unsigned char* K_lds = lds + 4 * TILE_V;
    for (int unit = bx; unit < NB * RH * 16; unit += G) {
        int tid_ = threadIdx.x; asm volatile("" : "+v"(tid_));
        const int tid = tid_, wid = __builtin_amdgcn_readfirstlane(tid >> 6), lane = tid & 63, r32 = lane & 31, hi = lane >> 5;
        const int c = wid >> 2, s = wid & 3;
        const int vb0 = (int)(uintptr_t)V_lds + v_rd_base(lane) + c * 2 * TILE_V;
        const int h = unit & 7, b = (unit >> 3) & 3, cb = unit >> 5;
        const float l2g = log2_gamma(h);
        const int tok0 = b * SEQ + cb * 256;
        bf16x8 qf[4];
        { bf16x8 kv[4], vv[8];
#pragma unroll
          for (int i = 0; i < 4; ++i) { const int id = tid + 512 * i, tok = id >> 3, ch = id & 7; kv[i] = bload8(rsK, (tok * 512 + ch * 8) * 2, (tok0 * 512 + h * 64) * 2); }
#pragma unroll
          for (int i = 0; i < 8; ++i) { const int id = tid + 512 * i, tok = id >> 4, c16 = id & 15; vv[i] = bload8(rsV, (tok * 1024 + c16 * 8) * 2, (tok0 * 1024 + h * 128) * 2); }
#pragma unroll
          for (int d0 = 0; d0 < 4; ++d0) qf[d0] = bload8(rsQ, ((c * 128 + s * 32 + r32) * 512 + hi * 8) * 2 + d0 * 32, (tok0 * 512 + h * 64) * 2);
#pragma unroll
          for (int i = 0; i < 4; ++i) { const int id = tid + 512 * i, tok = id >> 3, ch = id & 7, row = tok & 63; *(LAS bf16x8*)(K_lds + (tok >> 6) * TILE_K + row * 128 + (((ch ^ (row >> 1)) & 7) << 4)) = kv[i]; }
#pragma unroll
          for (int i = 0; i < 8; ++i) { const int id = tid + 512 * i, tok = id >> 4, c16 = id & 15; *(LAS bf16x8*)(V_lds + (tok >> 6) * TILE_V + v_st(tok & 63, c16 * 8)) = vv[i]; } }
        f32x16 o[4] = {};
        const int psb = (((b * RH + h) * 32 + 2 * cb + c) * (RDV * RDK)) * 2;
#pragma unroll
        for (int hp = 0; hp < 2; ++hp) { bf16x8 pf[2][4];
#pragma unroll
            for (int dd = 0; dd < 2; ++dd)
#pragma unroll
                for (int ks = 0; ks < 4; ++ks) pf[dd][ks] = bload8(rsP, (((2 * hp + dd) * 32 + r32) * RDK + hi * 8) * 2 + ks * 32, psb);
#pragma unroll
            for (int dd = 0; dd < 2; ++dd)
#pragma unroll
                for (int ks = 0; ks < 4; ++ks) o[2 * hp + dd] = __builtin_amdgcn_mfma_f32_32x32x16_bf16(qf[ks], pf[dd][ks], o[2 * hp + dd], 0, 0, 0);
            asm volatile("" ::: "memory"); }
#pragma unroll
        for (int r = 0; r < 16; ++r) { const float qd = __builtin_amdgcn_exp2f(l2g * (float)(s * 32 + crow(r, hi) + 1));
#pragma unroll
            for (int d0e = 0; d0e < 4; ++d0e) o[d0e][r] *= qd; }
        __syncthreads();
#define RET_INTRA(KT) do { if ((KT) * 64 <= s * 32 + 31) { f32x16 p0, p1; bf16x8 pa0, pa1, pa2, pa3; \
        att::qkt<4, 128>(p0, p1, K_lds + (2 * c + (KT)) * TILE_K, r32, hi, qf); \
        const int di = s * 32 + r32 - (KT) * 64 - 4 * hi;            \
        _Pragma("unroll") for (int r = 0; r < 16; ++r) { const int d0_ = di - ((r & 3) + 8 * (r >> 2)), d1_ = d0_ - 32; \
            p0[r] = d0_ >= 0 ? p0[r] * __builtin_amdgcn_exp2f(l2g * (float)d0_) : 0.f; p1[r] = d1_ >= 0 ? p1[r] * __builtin_amdgcn_exp2f(l2g * (float)d1_) : 0.f; } \
        att::pack_p(p0, p1, pa0, pa1, pa2, pa3); __builtin_amdgcn_sched_barrier(0); \
        att::pv_tile<(KT)>(o, vb0, pa0, pa1, pa2, pa3); } } while (0)
        RET_INTRA(0); RET_INTRA(1);
#undef RET_INTRA
#pragma unroll
        for (int r = 0; r < 16; ++r) { float q = (o[0][r] * o[0][r] + o[1][r] * o[1][r]) + (o[2][r] * o[2][r] + o[3][r] * o[3][r]);
            q += __shfl_xor(q, 1); q += __shfl_xor(q, 2); q += __shfl_xor(q, 4); q += __shfl_xor(q, 8); q += __shfl_xor(q, 16);
            const float rs = rsqrtf(q * (1.f / RDV) + EPS);
#pragma unroll
            for (int d0e = 0; d0e < 4; ++d0e) o[d0e][r] *= rs; }
        __syncthreads();
        LAS unsigned char* OST = lds;
#pragma unroll
        for (int r = 0; r < 16; ++r) { const int lrow = c * 128 + s * 32 + crow(r, hi);
#pragma unroll
            for (int d0e = 0; d0e < 4; ++d0e) { const float v = o[d0e][r]; const float vn = __shfl_xor(v, 1);
                if ((r32 & 1) == 0) *(LAS unsigned*)(OST + lrow * OST_ROW + (d0e * 32 + r32) * 2) = cvtpk(v, vn); } }
        __syncthreads();
        { const int c16 = tid & 15; const f32x4 g0 = *(const f32x4*)(rgain + h * RDV + c16 * 8), g1 = *(const f32x4*)(rgain + h * RDV + c16 * 8 + 4);
          bf16x8 gv[8];
#pragma unroll
          for (int i = 0; i < 8; ++i) gv[i] = bload8(rsG, (((tid >> 4) + 32 * i) * 1024 + c16 * 8) * 2, (tok0 * 1024 + h * 128) * 2);
#pragma unroll
          for (int i = 0; i < 8; ++i) { const int row = (tid >> 4) + 32 * i;
              const bf16x8 ov = *(const LAS bf16x8*)(OST + row * OST_ROW + c16 * 16);
              v4u w; w.x = cvtpk(bf2f((bf16_t)ov[0]) * g0[0] * bf2f((bf16_t)gv[i][0]), bf2f((bf16_t)ov[1]) * g0[1] * bf2f((bf16_t)gv[i][1]));
              w.y = cvtpk(bf2f((bf16_t)ov[2]) * g0[2] * bf2f((bf16_t)gv[i][2]), bf2f((bf16_t)ov[3]) * g0[3] * bf2f((bf16_t)gv[i][3]));
              w.z = cvtpk(bf2f((bf16_t)ov[4]) * g1[0] * bf2f((bf16_t)gv[i][4]), bf2f((bf16_t)ov[5]) * g1[1] * bf2f((bf16_t)gv[i][5]));
              w.w = cvtpk(bf2f((bf16_t)ov[6]) * g1[2] * bf2f((bf16_t)gv[i][6]), bf2f((bf16_t)ov[7]) * g1[3] * bf2f((bf16_t)gv[i][7]));
              *(v4u*)(y + ((size_t)tok0 + row) * MIXW + h * RDV + c16 * 8) = w; } }
        __syncthreads();
    }
}
#undef RET_TRRD
}

struct MkArgs { Ptrs P; int ph_lo, ph_hi; };
constexpr int PH_P0A = 0, PH_P0B = 1, PH_L0 = 2, PH_PER_LAYER = 9, PH_FINAL = PH_L0 + DEPTH * PH_PER_LAYER, PH_COUNT = PH_FINAL + 1;
constexpr int PO_GU1 = 0, PO_DN1 = 1, PO_IN = 2, PO_UP = 3, PO_SCAN = 4, PO_ATT = 5, PO_OUT = 6, PO_GU2 = 7, PO_DN2 = 8;

typedef const __attribute__((address_space(4))) MkArgs* KArgP;
typedef const __attribute__((address_space(4))) Ptrs& PtrsRef;
__global__ void __launch_bounds__(NWAVES * 64, 2) mk_fwd(MkArgs args) {
    extern __shared__ __attribute__((aligned(16))) unsigned char lds_raw[];
    LAS unsigned char* lds = (LAS unsigned char*)lds_raw;
    const int G = gridDim.x, bx = blockIdx.x;
    const int vcu = (G % 8 == 0) ? (bx % 8) * (G / 8) + bx / 8 : bx;
    const int NGW = G * NWAVES;
    const KArgP kargs = (KArgP)__builtin_amdgcn_kernarg_segment_ptr();
    const int lo = args.ph_lo, hi = args.ph_hi;
    for (int u = threadIdx.x; u < (LDS_BYTES - LDSCTL_OFF) / 4; u += NWAVES * 64) ((LAS unsigned*)(lds + LDSCTL_OFF))[u] = 0u;
    __syncthreads();
    (void)xcd_barrier_post((unsigned*)(kargs->P.ws + WS_CTL) + CW_BAR, (volatile LAS unsigned*)(lds + MISC_OFF) + 8);
#define IN(k) (lo <= (k) && (k) < hi)
#define SEAM(k) do { if (IN(k) && IN((k) + 1)) { KArgP ap_ = kargs; asm volatile("" : "+s"(ap_)); XcdBarrier bar_; bar_.bar = (unsigned*)(ap_->P.ws + WS_CTL) + CW_BAR; bar_.x = xb_xcc_id(); \
        bar_.st = (volatile LAS unsigned*)(lds + MISC_OFF) + 8; xcd_barrier(bar_); } } while (0)
#define PH_LOCALS \
    int tid = threadIdx.x; asm volatile("" : "+v"(tid)); \
    const int lane = tid & 63, wave = __builtin_amdgcn_readfirstlane(tid >> 6), gw = vcu * NWAVES + wave; (void)lane; (void)gw; \
    KArgP ap = kargs; asm volatile("" : "+s"(ap)); int Gp = G, bxp = bx; asm volatile("" : "+s"(Gp), "+s"(bxp)); (void)Gp; (void)bxp; \
    PtrsRef P = ap->P; unsigned char* ws = P.ws; \
    float* mod = (float*)(ws + CT_MOD); float* ssx = (float*)(ws + CT_SS); float* biasb = (float*)(ws + CT_BIAS); \
    float* gatef = (float*)(ws + CT_GATE); float* gmt = (float*)(ws + CT_GM); \
    float* cosT = (float*)(ws + WS_COS); float* sinT = (float*)(ws + WS_SIN); \
    f16_t* xres = (f16_t*)(ws + WS_XRES); bf16_t* xg = (bf16_t*)(ws + WS_XG); bf16_t* act = (bf16_t*)(ws + WS_ACT); \
    (void)mod; (void)ssx; (void)biasb; (void)gatef; (void)gmt; (void)cosT; (void)sinT; (void)xres; (void)xg; (void)act
#define MIX_LOCALS \
    bf16_t *qr = (bf16_t*)(ws + WS_QR), *kr = (bf16_t*)(ws + WS_KR), *vr = (bf16_t*)(ws + WS_VR), *gr = (bf16_t*)(ws + WS_GR), *cq = (bf16_t*)(ws + WS_CQ), *ckv = (bf16_t*)(ws + WS_CKV); \
    bf16_t *Qb = (bf16_t*)(ws + WS_Q), *Kb = (bf16_t*)(ws + WS_K), *Vb = (bf16_t*)(ws + WS_V), *yb = (bf16_t*)(ws + WS_Y); \
    float* ssq = (float*)(ws + CT_SSQ) + (size_t)l * M; float* sskv = (float*)(ws + CT_SSKV) + (size_t)l * M; \
    (void)qr; (void)kr; (void)vr; (void)gr; (void)cq; (void)ckv; (void)Qb; (void)Kb; (void)Vb; (void)yb; (void)ssq; (void)sskv
#define LAYER_LOCALS \
    const float* mod_l = mod + (size_t)l * NB * NMOD * D; unsigned char* wt = ws + WS_WT + (size_t)l * WT_LAYER; (void)mod_l; (void)wt

    if (IN(PH_P0A)) {
        PH_LOCALS;
        LAS float* CA = (LAS float*)lds;
        LAS float* RED = (LAS float*)(lds + 32768);
        for (int i = tid; i < NB * D; i += NWAVES * 64) CA[i] = siluf(P.c[i]);
        __syncthreads();
        for (int u = vcu; u < 2 * 72 * 8; u += G) {
            const int l = u / 576, r = u % 576, strip = r >> 3, kc = r & 7;
            f32x4 a0 = {0, 0, 0, 0}, a1 = a0, a2 = a0, a3 = a0;
            const float* wp = P.w_ada + ((size_t)l * D + kc * 256 + wave * 32) * (NMOD * D) + strip * 256 + 4 * lane;
            const LAS float* cp = CA + kc * 256 + wave * 32;
#pragma unroll 16
            for (int i = 0; i < 32; ++i) { const f32x4 wv = *(const f32x4*)(wp + (size_t)i * (NMOD * D));
                a0 += wv * cp[i]; a1 += wv * cp[D + i]; a2 += wv * cp[2 * D + i]; a3 += wv * cp[3 * D + i]; }
            *(LAS f32x4*)(RED + (wave * 4 + 0) * 256 + 4 * lane) = a0; *(LAS f32x4*)(RED + (wave * 4 + 1) * 256 + 4 * lane) = a1;
            *(LAS f32x4*)(RED + (wave * 4 + 2) * 256 + 4 * lane) = a2; *(LAS f32x4*)(RED + (wave * 4 + 3) * 256 + 4 * lane) = a3;
            __syncthreads();
            for (int o = tid; o < 1024; o += NWAVES * 64) { const int b = o >> 8, j = o & 255; float s = 0.f;
#pragma unroll
                for (int w = 0; w < 8; ++w) s += RED[(w * 4 + b) * 256 + j];
                const int col = strip * 256 + j; if (kc == 0) s += P.b_ada[l * NMOD * D + col];
                __hip_atomic_fetch_add(mod + ((size_t)l * NB + b) * NMOD * D + col, s, __ATOMIC_RELAXED, __HIP_MEMORY_SCOPE_AGENT); }
            __syncthreads();
        }
        for (int i = vcu * NWAVES * 64 + tid; i < M * 32; i += G * NWAVES * 64) { const int m = i >> 5, f = i & 31;
            const float inv = (float)pow(10000.0, -(double)f / 32.0); const float ang = (float)P.pos[m] * inv;
            cosT[i] = (float)cos((double)ang); sinT[i] = (float)sin((double)ang); }
    }
    SEAM(PH_P0A);
    if (IN(PH_P0B)) {
        PH_LOCALS;
        for (int row = gw; row < M; row += NGW) { const int b = row / SEQ;
            const float* xr = P.x + (size_t)row * D; const float* gn = P.norm_ffn1; const float* scp = mod + (size_t)b * NMOD * D + D;
            float s = 0.f; f32x4 xv[8], gv[8];
#pragma unroll
            for (int j = 0; j < 8; ++j) { const int c = 4 * (lane + 64 * j); xv[j] = *(const f32x4*)(xr + c); gv[j] = *(const f32x4*)(gn + c) * (*(const f32x4*)(scp + c) + 1.f); }
#pragma unroll
            for (int j = 0; j < 8; ++j) { const int c = 4 * (lane + 64 * j); const f32x4 v = xv[j], o = v * gv[j];
                s += (v[0] * v[0] + v[1] * v[1]) + (v[2] * v[2] + v[3] * v[3]);
                v2u w; w.x = cvtpk(o[0], o[1]); w.y = cvtpk(o[2], o[3]); *(v2u*)(xg + (size_t)row * D + c) = w; }
            s = wave_sum(s); if (lane == 0) ssx[row] = s; }
        for (int i = vcu * NWAVES * 64 + tid; i < DEPTH * 3 * NB * D; i += G * NWAVES * 64) { const int c = i & 2047, b = (i >> 11) & 3, q = i >> 13, l = q / 3, s = q % 3;
            const float* ml = mod + ((size_t)l * NB + b) * NMOD * D; const float* gn = (s == 0 ? P.norm_ffn1 : s == 1 ? P.norm_mix : P.norm_ffn2) + (size_t)l * D;
            gatef[i] = (s == 1 ? 1.0f : 0.5f) * ml[(3 * s + 2) * D + c]; gmt[i] = gn[c] * (1.f + ml[(3 * s + 1) * D + c]); }
        LAS float* scr = (LAS float*)(lds + wave * 8448); LAS float* shs = (LAS float*)(lds + 8 * 8448 + wave * 1024);
        constexpr int IT_GU = (D / 64) * (NGU / 32), IT_DN = (FF / 64) * (D / 32), IT_IN = (D / 64) * (NPIN / 32), IT_UQ = (QRANK / 64) * (1536 / 32),
                      IT_UKV = (KVRANK / 64) * (2048 / 32), IT_OUT = (D / 64) * (D / 32), IT_LAYER = 2 * IT_GU + 2 * IT_DN + IT_IN + IT_UQ + IT_UKV + IT_OUT;
        auto decode = [&](int it) -> CvtDesc {
            const int l = it / IT_LAYER; int r = it % IT_LAYER;
            unsigned char* wt = ws + WS_WT + (size_t)l * WT_LAYER;
            const float* W; const float* sc = nullptr; bf16_t* WT; int K, ldw, NP, kind, sb = -1;
            if (r < IT_GU) { W = P.ffn1_w_gu + (size_t)l * D * NGU; WT = (bf16_t*)(wt + WT_GU1); K = D; ldw = NGU; NP = NGU; kind = 1; sb = 0; }
            else if ((r -= IT_GU) < IT_DN) { W = P.ffn1_w_down + (size_t)l * FF * D; WT = (bf16_t*)(wt + WT_DN1); K = FF; ldw = D; NP = D; kind = 0; }
            else if ((r -= IT_DN) < IT_IN) { W = P.w_in + (size_t)l * D * INCOLS; WT = (bf16_t*)(wt + WT_IN); K = D; ldw = INCOLS; NP = NPIN; kind = 2; sb = 1; }
            else if ((r -= IT_IN) < IT_UQ) { W = P.w_uq + (size_t)l * QRANK * MH * DQK; sc = P.q_norm_g + (size_t)l * QRANK; WT = (bf16_t*)(wt + WT_UQ); K = QRANK; ldw = MH * DQK; NP = 1536; kind = 3; }
            else if ((r -= IT_UQ) < IT_UKV) { W = P.w_ukv + (size_t)l * KVRANK * 2048; sc = P.kv_norm_g + (size_t)l * KVRANK; WT = (bf16_t*)(wt + WT_UKV); K = KVRANK; ldw = 2048; NP = 2048; kind = 0; }
            else if ((r -= IT_UKV) < IT_OUT) { W = P.w_out + (size_t)l * MIXW * D; WT = (bf16_t*)(wt + WT_OUT); K = MIXW; ldw = D; NP = D; kind = 0; }
            else if ((r -= IT_OUT) < IT_GU) { W = P.ffn2_w_gu + (size_t)l * D * NGU; WT = (bf16_t*)(wt + WT_GU2); K = D; ldw = NGU; NP = NGU; kind = 1; sb = 2; }
            else { r -= IT_GU; W = P.ffn2_w_down + (size_t)l * FF * D; WT = (bf16_t*)(wt + WT_DN2); K = FF; ldw = D; NP = D; kind = 0; }
            const int nblk = NP / 32, kb = r / nblk, nb = r % nblk;
            CvtDesc d; d.W = W; d.scale = sc; d.WT = WT; d.sh = sb >= 0 ? mod + (size_t)l * NB * NMOD * D + (size_t)(3 * sb) * D : nullptr;
            d.bias = biasb + (size_t)(3 * l + (sb < 0 ? 0 : sb)) * NB * NGU; d.ldw = ldw; d.K = K; d.k0 = 64 * kb; d.src0 = src_block(kind, nb); d.dst0 = 32 * nb; return d; };
        {
            int it = gw;
            if (it < DEPTH * IT_LAYER) {
                CvtDesc cur = decode(it); f32x4 v[8]; cvt_load(cur, v, lane);
                for (;;) {
                    const int itn = it + NGW; const bool more = itn < DEPTH * IT_LAYER;
                    CvtDesc nxt = cur; f32x4 vn[8];
                    if (more) { nxt = decode(itn); cvt_load(nxt, vn, lane); }
                    cvt_process(cur, v, scr, shs, lane);
                    if (!more) break;
                    cur = nxt; it = itn;
#pragma unroll
                    for (int i = 0; i < 8; ++i) v[i] = vn[i];
                }
            }
        }
    }
    SEAM(PH_P0B);
    for (int l = 0; l < DEPTH; ++l) {
        const int pb = PH_L0 + l * PH_PER_LAYER;
        for (int s = 0; s < 3; s += 2) {
            const int p_gu = pb + (s == 0 ? PO_GU1 : PO_GU2), p_dn = p_gu + 1;
            if (IN(p_gu)) {
                PH_LOCALS; LAYER_LOCALS;
                pg8::Gemm g{xg, (const bf16_t*)(wt + (s == 0 ? WT_GU1 : WT_GU2)), M, NGU, D}; pg8::StaticOrder S; S.init(M, NGU, Gp, bxp);
                EpiGU E{act, ssx + (size_t)(3 * l + s) * M, biasb + (size_t)(3 * l + s) * NB * NGU};
                pg8::gemm_phase<EpiGU, pg8::StaticOrder, true, true>(lds, g, S, E);
            }
            SEAM(p_gu);
            if (IN(p_dn)) {
                PH_LOCALS; LAYER_LOCALS;
                pg8::Gemm g{act, (const bf16_t*)(wt + (s == 0 ? WT_DN1 : WT_DN2)), M, D, FF}; pg8::StaticOrder S; S.init(M, D, Gp, bxp);
                const int last = (l == DEPTH - 1 && s == 2);
                const int qn = 3 * l + s + 1;
                if (l == 0 && s == 0) { EpiRes<true> E{P.x, nullptr, xres, xg, ssx + (size_t)qn * M, gatef + (size_t)(3 * l + s) * NB * D, gmt + (size_t)qn * NB * D, 1, 0};
                    pg8::gemm_phase<EpiRes<true>, pg8::StaticOrder, true, true>(lds, g, S, E); }
                else { EpiRes<false> E{nullptr, xres, xres, xg, ssx + (size_t)qn * M, gatef + (size_t)(3 * l + s) * NB * D, gmt + (size_t)(last ? 0 : qn) * NB * D, last ? 0 : 1, 0};
                    pg8::gemm_phase<EpiRes<false>, pg8::StaticOrder, true, true>(lds, g, S, E); }
            }
            SEAM(p_dn);
            if (s == 0) {
                if (IN(pb + PO_IN)) {
                    PH_LOCALS; LAYER_LOCALS; MIX_LOCALS;
                    pg8::Gemm g{xg, (const bf16_t*)(wt + WT_IN), M, NPIN, D}; pg8::StaticOrder S; S.init(M, NPIN, Gp, bxp);
                    EpiIn E{ssx + (size_t)(3 * l + 1) * M, biasb + (size_t)(3 * l + 1) * NB * NGU, cosT, sinT, qr, kr, vr, gr, cq, ckv, Kb, ssq, sskv};
                    pg8::gemm_phase<EpiIn, pg8::StaticOrder, true, true>(lds, g, S, E);
                }
                SEAM(pb + PO_IN);
                if (IN(pb + PO_UP)) {
                    PH_LOCALS; LAYER_LOCALS; MIX_LOCALS;
                    {
                    { pg8::Gemm g{cq, (const bf16_t*)(wt + WT_UQ), M, 1536, QRANK}; pg8::StaticOrder S; S.init(M, 1536, Gp, bxp);
                      EpiUq E{ssq, cosT, sinT, Qb};
                      pg8::gemm_phase<EpiUq, pg8::StaticOrder, true, true>(lds, g, S, E); }
                    { pg8::Gemm g{ckv, (const bf16_t*)(wt + WT_UKV), M, 2048, KVRANK}; pg8::StaticOrder S; S.init(M, 2048, Gp, bxp);
                      EpiUkv E{sskv, Kb, Vb};
                      pg8::gemm_phase<EpiUkv, pg8::StaticOrder, true, true>(lds, g, S, E); }
                    ret::inc_phase(lds, kr, vr, (float*)(ws + WS_INC), Gp, bxp);
                    }
                }
                SEAM(pb + PO_UP);
                if (IN(pb + PO_SCAN)) {
                    PH_LOCALS; LAYER_LOCALS; MIX_LOCALS;
                    ret::scan_phase((const float*)(ws + WS_INC), (bf16_t*)(ws + WS_PREVT), G, vcu);
                }
                SEAM(pb + PO_SCAN);
                if (IN(pb + PO_ATT)) {
                    PH_LOCALS; LAYER_LOCALS; MIX_LOCALS;
                    att::attn_phase(lds, Qb, Kb, Vb, yb, Gp, bxp, 0);
                    ret::out_phase(lds, qr, kr, vr, gr, (const bf16_t*)(ws + WS_PREVT), P.ret_norm_g + (size_t)l * RETW, yb, Gp, bxp);
                }
                SEAM(pb + PO_ATT);
                if (IN(pb + PO_OUT)) {
                    PH_LOCALS; LAYER_LOCALS; MIX_LOCALS;
                    pg8::Gemm g{yb, (const bf16_t*)(wt + WT_OUT), M, D, MIXW}; pg8::StaticOrder S; S.init(M, D, Gp, bxp);
                    EpiRes<false> E{nullptr, xres, xres, xg, ssx + (size_t)(3 * l + 2) * M, gatef + (size_t)(3 * l + 1) * NB * D, gmt + (size_t)(3 * l + 2) * NB * D, 1, 0};
                    pg8::gemm_phase<EpiRes<false>, pg8::StaticOrder, true, true>(lds, g, S, E);
                }
                SEAM(pb + PO_OUT);
            }
        }
    }
    if (IN(PH_FINAL)) {
        PH_LOCALS;
        const float* ssf = ssx + (size_t)6 * M;
        for (int row = gw; row < M; row += NGW) { const float rs = rsqrtf(ssf[row] * (1.f / D) + EPS);
            f16x8 hv[4];
#pragma unroll
            for (int j = 0; j < 4; ++j) hv[j] = *(const f16x8*)(xres + (size_t)row * D + 8 * (lane + 64 * j));
#pragma unroll
            for (int j = 0; j < 4; ++j) { const int c = 8 * (lane + 64 * j); const f16x8 h = hv[j];
                const f32x4 g0 = *(const f32x4*)(P.final_norm + c), g1 = *(const f32x4*)(P.final_norm + c + 4);
                *(f32x4*)(P.out + (size_t)row * D + c) = (f32x4){(float)h[0], (float)h[1], (float)h[2], (float)h[3]} * rs * g0;
                *(f32x4*)(P.out + (size_t)row * D + c + 4) = (f32x4){(float)h[4], (float)h[5], (float)h[6], (float)h[7]} * rs * g1; } }
    }
#undef IN
#undef SEAM
#undef PH_LOCALS
#undef LAYER_LOCALS
#undef MIX_LOCALS
}

static int g_grid = 0;
static void mk(hipStream_t st, const Ptrs& P, int lo, int hi) {
    MkArgs a{}; a.P = P; a.ph_lo = lo; a.ph_hi = hi;
    hipLaunchKernelGGL(mk_fwd, dim3(g_grid), dim3(NWAVES * 64), LDS_BYTES, st, a);
}

extern "C" void kernel_launch(void* const* d_in, const int* in_sizes, int n_in, void* d_out, int out_size, void* d_ws, size_t ws_size, hipStream_t stream) {
    if (n_in != 20 || ws_size < WS_END) { fprintf(stderr, "kernel_launch: bad args n_in %d ws %zu need %zu\n", n_in, ws_size, (size_t)WS_END); return; }
    if (g_grid == 0) {
        int dev = 0, cus = 0;
        if (hipGetDevice(&dev) != hipSuccess || hipDeviceGetAttribute(&cus, hipDeviceAttributeMultiprocessorCount, dev) != hipSuccess || cus <= 0) { g_grid = -1; return; }
        if (hipFuncSetAttribute((const void*)mk_fwd, hipFuncAttributeMaxDynamicSharedMemorySize, LDS_BYTES) != hipSuccess) { fprintf(stderr, "hipFuncSetAttribute failed\n"); g_grid = -1; return; }
        g_grid = cus;
    }
    if (g_grid < 0) return;
    Ptrs P{};
    P.x = (const float*)d_in[0]; P.c = (const float*)d_in[1]; P.pos = (const int*)d_in[2]; P.w_ada = (const float*)d_in[3]; P.b_ada = (const float*)d_in[4];
    P.norm_ffn1 = (const float*)d_in[5]; P.ffn1_w_gu = (const float*)d_in[6]; P.ffn1_w_down = (const float*)d_in[7]; P.norm_mix = (const float*)d_in[8];
    P.w_in = (const float*)d_in[9]; P.ret_norm_g = (const float*)d_in[10]; P.q_norm_g = (const float*)d_in[11]; P.w_uq = (const float*)d_in[12];
    P.kv_norm_g = (const float*)d_in[13]; P.w_ukv = (const float*)d_in[14]; P.w_out = (const float*)d_in[15]; P.norm_ffn2 = (const float*)d_in[16];
    P.ffn2_w_gu = (const float*)d_in[17]; P.ffn2_w_down = (const float*)d_in[18]; P.final_norm = (const float*)d_in[19];
    P.out = (float*)d_out; P.ws = (unsigned char*)d_ws;
    unsigned char* ws = P.ws;
    (void)hipMemsetAsync(ws + WS_CTL, 0, CTL_BYTES, stream);
    mk(stream, P, 0, PH_COUNT);
}
```

```cpp
#include <hip/hip_runtime.h>
#include <cstdio>
#include <cstdint>
#include <cmath>

constexpr int D = 2048, NB = 4, SEQ = 4096, DEPTH = 2, M = NB * SEQ;
constexpr int RH = 8, RDK = 64, RDV = 128, RCH = 128;
constexpr int MH = 8, QRANK = 512, KVRANK = 256, NOPE = 128, ROPE = 64, MDV = 128, DQK = NOPE + ROPE;
constexpr int RETW = RH * RDV, MLAW = MH * MDV, MIXW = RETW + MLAW;
constexpr int INCOLS = 2 * RH * RDK + 2 * RETW + QRANK + KVRANK + ROPE;
constexpr int FF = 5632, NGU = 2 * FF;
constexpr int NMOD = 9;
constexpr float EPS = 1e-6f;
constexpr int C_QR = 0, C_KR = 512, C_VR = 1024, C_GR = 2048, C_CQ = 3072, C_CKV = 3584, C_KPE = 3840;

typedef unsigned short bf16_t;
typedef short bf16x8 __attribute__((ext_vector_type(8)));
typedef float f32x4 __attribute__((ext_vector_type(4)));

constexpr size_t MiB = 1u << 20;
constexpr size_t WS_CTL = 0, CTL_BYTES = 4 * MiB;
constexpr size_t CT_SS = 64 * 1024;
constexpr size_t CT_SSQ = CT_SS + 7 * (size_t)M * 4;
constexpr size_t CT_SSKV = CT_SSQ + 2 * (size_t)M * 4;
constexpr size_t CT_MOD = CT_SSKV + 2 * (size_t)M * 4;
constexpr size_t CT_END = CT_MOD + (size_t)DEPTH * NB * NMOD * D * 4;
static_assert(CT_END <= CTL_BYTES, "ctl");
constexpr size_t WS_COS = 4 * MiB, WS_SIN = 6 * MiB;
constexpr size_t WS_XRES = 8 * MiB;
constexpr size_t WS_XG = WS_XRES + (size_t)M * D * 4;
constexpr size_t WS_Y = WS_XG + (size_t)M * D * 2;
constexpr size_t WS_H = WS_Y;
constexpr size_t WS_INC = WS_Y + (size_t)M * MIXW * 2;
constexpr size_t WS_PREVT = WS_INC + (size_t)NB * RH * 32 * 64 * 128 * 4;
constexpr size_t WS_CQF = WS_INC;
constexpr size_t WS_CKVF = WS_PREVT;
constexpr size_t WS_MIX = WS_PREVT + (size_t)NB * RH * 32 * 64 * 128 * 2;
constexpr size_t WS_QR = WS_MIX;
constexpr size_t WS_KR = WS_QR + (size_t)M * 512 * 2;
constexpr size_t WS_VR = WS_KR + (size_t)M * 512 * 2;
constexpr size_t WS_GR = WS_VR + (size_t)M * 1024 * 2;
constexpr size_t WS_CQ = WS_GR + (size_t)M * 1024 * 2;
constexpr size_t WS_CKV = WS_CQ + (size_t)M * 512 * 2;
constexpr size_t WS_Q = WS_CKV + (size_t)M * 256 * 2;
constexpr size_t WS_K = WS_Q + (size_t)M * MH * DQK * 2;
constexpr size_t WS_V = WS_K + (size_t)M * MH * DQK * 2;
constexpr size_t WS_MIX_END = WS_V + (size_t)M * MH * MDV * 2;
constexpr size_t WS_ACT = WS_MIX;
static_assert(WS_ACT + (size_t)M * FF * 2 <= WS_MIX_END, "act overlay");
constexpr size_t WS_WT = WS_MIX_END;
constexpr size_t WS_END = WS_WT + 340 * MiB;

__device__ __forceinline__ bf16_t f2bf(float f) { unsigned u = __float_as_uint(f); u += 0x7fffu + ((u >> 16) & 1u); return (bf16_t)(u >> 16); }
__device__ __forceinline__ float bf2f(bf16_t b) { return __uint_as_float(((unsigned)b) << 16); }
__device__ __forceinline__ float siluf(float x) { return x / (1.f + __expf(-x)); }
__device__ __forceinline__ float wave_sum(float v) {
#pragma unroll
    for (int o = 1; o < 64; o <<= 1) v += __shfl_xor(v, o);
    return v;
}

struct Ptrs {
    const float *x, *c; const int* pos; const float *w_ada, *b_ada, *norm_ffn1, *ffn1_w_gu, *ffn1_w_down, *norm_mix, *w_in, *ret_norm_g, *q_norm_g, *w_uq,
        *kv_norm_g, *w_ukv, *w_out, *norm_ffn2, *ffn2_w_gu, *ffn2_w_down, *final_norm;
    float* out; unsigned char* ws;
};

namespace pg8 {
#define PG8_LAS __attribute__((address_space(3)))
typedef unsigned short bf16_t;
typedef short bf16x8 __attribute__((ext_vector_type(8)));
typedef float f32x4 __attribute__((ext_vector_type(4)));
typedef unsigned u32x4 __attribute__((ext_vector_type(4)));
constexpr int BM = 256, BK = 64, HALF = 128, HTB = HALF * BK * 2  , STAGE_BYTES = 8 * HTB, NXCD = 8, WGM = 8;

__host__ __device__ __forceinline__ int lds_byte(int r, int c) { const int st = (r >> 4) * 2 + (c >> 5), rr = r & 15, cc = c & 31, ob = rr * 64 + cc * 2; return st * 1024 + (ob ^ (((ob >> 9) & 1) << 5)); }
__host__ __device__ __forceinline__ void stage_rc(int b, int& R, int& C) { const int st = b / 1024, sb = b % 1024, swz = sb ^ (((sb >> 9) & 1) << 5); R = (st >> 1) * 16 + swz / 64; C = (st & 1) * 32 + (swz % 64) / 2; }
__host__ __device__ __forceinline__ int perm32(int rho) { const int n = rho >> 4, i = rho & 15; return 8 * (i >> 2) + 4 * n + (i & 3); }

struct Unit { int pm, pn; };
struct Gemm { const bf16_t* A; const bf16_t* Bt; int M, N, K; };

struct StaticOrder {
    int nM, nN, nwg, G, c;
    __host__ __device__ void init(int M, int N, int G_, int c_) { nM = M / BM; nN = N / BM; nwg = nM * nN; G = G_; c = c_; }
    __host__ __device__ bool next(int i, Unit& u) const {
        const long L = (long)i * G + c; if (L >= nwg) return false;
        int wgid = (int)L; { const int q = nwg / NXCD, r = nwg % NXCD, xcd = wgid % NXCD, off = wgid / NXCD; wgid = (xcd < r ? xcd * (q + 1) : r * (q + 1) + (xcd - r) * q) + off; }
        const int nig = WGM * nN, gid = wgid / nig, fm = gid * WGM, gsz = (nM - fm) < WGM ? (nM - fm) : WGM;
        u.pm = fm + ((wgid % nig) % gsz); u.pn = (wgid % nig) / gsz; return true;
    }
    __device__ __forceinline__ void a_ready(const Unit&) const {}
    __device__ __forceinline__ void done(const Unit&) const {}
};

template <class Epi, class Sched, bool ALIGN_EPI = false, bool SP2 = false>
__device__ __forceinline__ void gemm_phase(PG8_LAS unsigned char* lds, const Gemm g, const Sched& S, const Epi& E) {
    int tid_ = threadIdx.x; asm volatile("" : "+v"(tid_));
    const int tid = tid_, wid = __builtin_amdgcn_readfirstlane(tid >> 6), lane = tid & 63, wr = wid >> 2, wc = wid & 3, fr = lane & 15, fq = lane >> 4;
    const int K = g.K, nt = K / BK;
    unsigned voffA[2], voffB[2];
#pragma unroll
    for (int i = 0; i < 2; ++i) { int R, C; stage_rc(tid * 16 + i * 8192, R, C); const int Rb = Epi::PERM ? ((R & ~31) + perm32(R & 31)) : R;
        voffA[i] = (unsigned)(R * K + C) * 2u; voffB[i] = (unsigned)(Rb * K + C) * 2u; }
    const unsigned kstep = (unsigned)(BK * 2);
    const unsigned hstep = (unsigned)HALF * K * 2;
    const unsigned tstep = 2 * hstep;
    const __amdgpu_buffer_rsrc_t rsA = __builtin_amdgcn_make_buffer_rsrc((void*)g.A, (short)0, (int)((size_t)g.M * K * 2), 0x00020000), rsB = __builtin_amdgcn_make_buffer_rsrc((void*)g.Bt, (short)0, (int)((size_t)g.N * K * 2), 0x00020000);
    const unsigned ldsw = (unsigned)wid * 1024u;
    const int aoff = lds_byte(wr * 64 + fr, fq * 8), boff = lds_byte(wc * 32 + fr, fq * 8);
#define PG8_SA(b, h) (((b) * 2 + (h)) * HTB)
#define PG8_SB(b, h) ((4 + (b) * 2 + (h)) * HTB)
#define PG8_STAGE_(rs, bufoff, gbase, voff) do { _Pragma("unroll") for (int _i = 0; _i < 2; ++_i) \
        __builtin_amdgcn_raw_ptr_buffer_load_lds(rs, (PG8_LAS void*)(lds + (bufoff) + ldsw + _i * 8192), 16, (int)(voff)[_i], (int)(gbase), 0, 0); } while (0)
#define PG8_STAGE(bufoff, gbase, voff) PG8_STAGE_##voff(bufoff, gbase)
#define PG8_STAGE_voffA(bufoff, gbase) PG8_STAGE_(rsA, bufoff, gbase, voffA)
#define PG8_STAGE_voffB(bufoff, gbase) PG8_STAGE_(rsB, bufoff, gbase, voffB)
#define PG8_LDA(dst, b, h) do { _Pragma("unroll") for (int m = 0; m < 4; ++m) _Pragma("unroll") for (int k = 0; k < 2; ++k) dst[m][k] = *(const PG8_LAS bf16x8*)(lds + PG8_SA(b, h) + aoff + m * 2048 + k * 1024); } while (0)
#define PG8_LDB(dst, b, h) do { _Pragma("unroll") for (int n = 0; n < 2; ++n) _Pragma("unroll") for (int k = 0; k < 2; ++k) dst[n][k] = *(const PG8_LAS bf16x8*)(lds + PG8_SB(b, h) + boff + n * 2048 + k * 1024); } while (0)
#define PG8_MMA(ai, bj, At, Bt) do { __builtin_amdgcn_s_setprio(1); _Pragma("unroll") for (int m = 0; m < 4; ++m) _Pragma("unroll") for (int n = 0; n < 2; ++n) _Pragma("unroll") for (int k = 0; k < 2; ++k) \
        acc[ai][bj][m][n] = __builtin_amdgcn_mfma_f32_16x16x32_bf16(Bt[n][k], At[m][k], acc[ai][bj][m][n], 0, 0, 0); __builtin_amdgcn_s_setprio(0); } while (0)
#define PG8_WAIT_V(n) asm volatile("s_waitcnt vmcnt(" #n ")" ::: "memory")
#define PG8_WAIT_L(n) asm volatile("s_waitcnt lgkmcnt(" #n ")" ::: "memory")
#define PG8_BAR __builtin_amdgcn_s_barrier()
#define PG8_SCHED __builtin_amdgcn_sched_barrier(0)
    Unit cur, nxt; int ui = 0;
    if (!S.next(0, cur)) return;
    f32x4 acc[2][2][4][2];
#pragma unroll
    for (int a = 0; a < 2; ++a)
#pragma unroll
        for (int b = 0; b < 2; ++b)
#pragma unroll
            for (int m = 0; m < 4; ++m)
#pragma unroll
                for (int n = 0; n < 2; ++n) acc[a][b][m][n] = (f32x4){0.f, 0.f, 0.f, 0.f};
    bf16x8 At[4][2], B0[2][2], B1[2][2];
    unsigned cA = (unsigned)cur.pm * tstep, cB = (unsigned)cur.pn * tstep;
    S.a_ready(cur);
    if constexpr (SP2) {
        PG8_STAGE(PG8_SB(0, 0), cB, voffB); PG8_STAGE(PG8_SB(0, 1), cB + hstep, voffB); PG8_STAGE(PG8_SA(0, 0), cA, voffA); PG8_STAGE(PG8_SA(0, 1), cA + hstep, voffA);
        if (wr == 1) PG8_BAR;
        PG8_WAIT_V(2); PG8_BAR;
        PG8_STAGE(PG8_SB(1, 0), cB + kstep, voffB); PG8_STAGE(PG8_SA(1, 0), cA + kstep, voffA); PG8_STAGE(PG8_SB(1, 1), cB + hstep + kstep, voffB);
        PG8_WAIT_V(6); PG8_BAR;
    } else {
        PG8_STAGE(PG8_SB(0, 0), cB, voffB); PG8_STAGE(PG8_SA(0, 0), cA, voffA); PG8_STAGE(PG8_SB(0, 1), cB + hstep, voffB); PG8_STAGE(PG8_SA(0, 1), cA + hstep, voffA);
        if (wr == 1) PG8_BAR;
        PG8_WAIT_V(4); PG8_BAR;
        PG8_STAGE(PG8_SB(1, 0), cB + kstep, voffB); PG8_STAGE(PG8_SA(1, 0), cA + kstep, voffA); PG8_STAGE(PG8_SB(1, 1), cB + hstep + kstep, voffB);
        PG8_WAIT_V(6); PG8_BAR;
    }
    for (;;) {
        const bool has_next = S.next(ui + 1, nxt);
        const unsigned nA = has_next ? (unsigned)nxt.pm * tstep : cA, nB = has_next ? (unsigned)nxt.pn * tstep : cB;
        for (int t = 0; t < nt; t += 2) {
            const bool last = (t == nt - 2);
            const unsigned a1 = cA + (unsigned)(t + 1) * kstep;
            const unsigned a2 = last ? nA : cA + (unsigned)(t + 2) * kstep, b2 = last ? nB : cB + (unsigned)(t + 2) * kstep;
            const unsigned a3 = a2 + kstep, b3 = b2 + kstep;
            if (last && has_next) S.a_ready(nxt);
            if constexpr (SP2) {
            PG8_LDB(B0, 0, 0); PG8_LDB(B1, 0, 1); PG8_SCHED; PG8_LDA(At, 0, 0); PG8_STAGE(PG8_SA(1, 1), a1 + hstep, voffA);
            PG8_WAIT_V(8); PG8_WAIT_L(0); PG8_BAR; PG8_MMA(0, 0, At, B0); PG8_MMA(0, 1, At, B1); PG8_BAR; PG8_SCHED;
            PG8_LDA(At, 0, 1); PG8_STAGE(PG8_SB(0, 0), b2, voffB); PG8_STAGE(PG8_SB(0, 1), b2 + hstep, voffB); PG8_STAGE(PG8_SA(0, 0), a2, voffA);
            PG8_WAIT_V(8); PG8_WAIT_L(0); PG8_BAR; PG8_MMA(1, 0, At, B0); PG8_MMA(1, 1, At, B1); PG8_BAR; PG8_SCHED;
            PG8_LDB(B0, 1, 0); PG8_LDB(B1, 1, 1); PG8_SCHED; PG8_LDA(At, 1, 0); PG8_STAGE(PG8_SA(0, 1), a2 + hstep, voffA);
            PG8_WAIT_V(8); PG8_WAIT_L(0); PG8_BAR; PG8_MMA(0, 0, At, B0); PG8_MMA(0, 1, At, B1); PG8_BAR; PG8_SCHED;
            PG8_LDA(At, 1, 1); PG8_STAGE(PG8_SB(1, 0), b3, voffB); PG8_STAGE(PG8_SB(1, 1), b3 + hstep, voffB); PG8_STAGE(PG8_SA(1, 0), a3, voffA);
            PG8_WAIT_V(8); PG8_WAIT_L(0); PG8_BAR; PG8_MMA(1, 0, At, B0); PG8_MMA(1, 1, At, B1); PG8_BAR; PG8_SCHED;
            } else {
            PG8_LDB(B0, 0, 0); PG8_SCHED; PG8_LDA(At, 0, 0); PG8_STAGE(PG8_SA(1, 1), a1 + hstep, voffA);
            PG8_WAIT_L(8); PG8_BAR; PG8_WAIT_L(0); PG8_MMA(0, 0, At, B0); PG8_BAR; PG8_SCHED;
            PG8_LDB(B1, 0, 1); PG8_STAGE(PG8_SB(0, 0), b2, voffB);
            PG8_BAR; PG8_WAIT_L(0); PG8_MMA(0, 1, At, B1); PG8_BAR;
            PG8_LDA(At, 0, 1); PG8_STAGE(PG8_SA(0, 0), a2, voffA);
            PG8_BAR; PG8_WAIT_L(0); PG8_MMA(1, 0, At, B0); PG8_BAR; PG8_SCHED;
            PG8_STAGE(PG8_SB(0, 1), b2 + hstep, voffB);
            PG8_WAIT_V(6); PG8_BAR; PG8_MMA(1, 1, At, B1); PG8_BAR;
            PG8_LDB(B0, 1, 0); PG8_SCHED; PG8_LDA(At, 1, 0); PG8_STAGE(PG8_SA(0, 1), a2 + hstep, voffA);
            PG8_WAIT_L(8); PG8_BAR; PG8_WAIT_L(0); PG8_MMA(0, 0, At, B0); PG8_BAR; PG8_SCHED;
            PG8_LDB(B1, 1, 1); PG8_STAGE(PG8_SB(1, 0), b3, voffB);
            PG8_BAR; PG8_WAIT_L(0); PG8_MMA(0, 1, At, B1); PG8_BAR;
            PG8_LDA(At, 1, 1); PG8_STAGE(PG8_SA(1, 0), a3, voffA);
            PG8_BAR; PG8_WAIT_L(0); PG8_MMA(1, 0, At, B0); PG8_BAR; PG8_SCHED;
            PG8_STAGE(PG8_SB(1, 1), b3 + hstep, voffB);
            PG8_WAIT_V(6); PG8_BAR; PG8_MMA(1, 1, At, B1); PG8_BAR;
            }
        }
        if constexpr (ALIGN_EPI) { if (wr == 0) PG8_BAR; }
        if constexpr (!Epi::AFTER_DRAIN) { E(acc, cur, wr, wc, fr, fq); S.done(cur); }
        if (!has_next) break;
#pragma unroll
        for (int a = 0; a < 2; ++a)
#pragma unroll
            for (int b = 0; b < 2; ++b)
#pragma unroll
                for (int m = 0; m < 4; ++m)
#pragma unroll
                    for (int n = 0; n < 2; ++n) acc[a][b][m][n] = (f32x4){0.f, 0.f, 0.f, 0.f};
        cur = nxt; cA = nA; cB = nB; ++ui;
        if constexpr (ALIGN_EPI) { if (wr == 1) PG8_BAR; }
    }
    PG8_WAIT_V(0);
    if constexpr (!ALIGN_EPI) { if (wr == 0) PG8_BAR; }
    PG8_BAR;
    if constexpr (Epi::AFTER_DRAIN) { E.fused(acc, cur, wr, wc, fr, fq, lds, wid, lane); S.done(cur); }
#undef PG8_SA
#undef PG8_SB
#undef PG8_STAGE
#undef PG8_STAGE_
#undef PG8_STAGE_voffA
#undef PG8_STAGE_voffB
#undef PG8_LDA
#undef PG8_LDB
#undef PG8_MMA
#undef PG8_WAIT_V
#undef PG8_WAIT_L
#undef PG8_BAR
#undef PG8_SCHED
}
}

#define GAS __attribute__((address_space(1)))
#define LAS __attribute__((address_space(3)))
#define XB_TMO      128
#define XB_XCNT(j)  (256  + 64 * (j))
#define XB_XSUB(j)  (1280 + 64 * (j))
#define XB_XGEN(j)  (2304 + 64 * (j))
#define XB_TOP      3328
#define XB_TOPGEN   3392
#define XCD_BAR_WORDS 3456
#define XB_SPIN_CAP (1u << 18)

__device__ __forceinline__ unsigned xb_ld(unsigned* p)              { return __hip_atomic_load(p, __ATOMIC_RELAXED, __HIP_MEMORY_SCOPE_AGENT); }
__device__ __forceinline__ unsigned xb_add(unsigned* p, unsigned v) { return __hip_atomic_fetch_add(p, v, __ATOMIC_RELAXED, __HIP_MEMORY_SCOPE_AGENT); }
__device__ __forceinline__ unsigned xb_xcc_id() { return (unsigned)__builtin_amdgcn_s_getreg((3 << 11) | 20) & 0xFu; }
#define XB_SPIN(cond, bar) do { unsigned _sp = 0; while (cond) { __builtin_amdgcn_s_sleep(1); \
    if ((++_sp & 255u) == 0u) { if (xb_ld(&(bar)[XB_TMO])) break; if (_sp > XB_SPIN_CAP) { atomicAdd(&(bar)[XB_TMO], 1u); break; } } } } while (0)

struct XcdBarrier {
    unsigned* bar; unsigned x;
    volatile LAS unsigned* st;
};

__device__ __forceinline__ XcdBarrier xcd_barrier_post(unsigned* bar, volatile LAS unsigned* st) {
    XcdBarrier b; b.bar = bar; b.x = xb_xcc_id(); b.st = st;
    if (threadIdx.x == 0) (void)xb_add(&bar[XB_XCNT(b.x)], 1u);
    return b;
}
__device__ __forceinline__ void xcd_barrier_complete(unsigned* bar, unsigned x, unsigned& nloc, unsigned& nx) {
    const unsigned G = gridDim.x * gridDim.y * gridDim.z;
    unsigned sum, cnt, mine, sp = 0u;
    for (;;) {
        sum = 0u; cnt = 0u; mine = 0u;
#pragma unroll
        for (unsigned j = 0; j < 16; ++j) { const unsigned c = xb_ld(&bar[XB_XCNT(j)]); sum += c; cnt += (c > 0u) ? 1u : 0u; mine = (j == x) ? c : mine; }
        if (sum == G) break;
        __builtin_amdgcn_s_sleep(1);
        if ((++sp & 255u) == 0u) { if (xb_ld(&bar[XB_TMO])) break; if (sp > XB_SPIN_CAP) { atomicAdd(&bar[XB_TMO], 1u); break; } }
    }
    nloc = mine > 0u ? mine : 1u; nx = cnt > 0u ? cnt : 1u;
}

__device__ __forceinline__ void xcd_barrier(const XcdBarrier& b) {
    asm volatile("s_waitcnt vmcnt(0)" ::: "memory");
    __syncthreads();
    if (threadIdx.x == 0) {
        unsigned* bar = b.bar;
        __builtin_amdgcn_s_waitcnt(0);
        unsigned nloc = b.st[0], nx = b.st[1];
        if (nloc == 0u) { xcd_barrier_complete(bar, b.x, nloc, nx); b.st[0] = nloc; b.st[1] = nx; }
        const unsigned old = xb_add(&bar[XB_XSUB(b.x)], 1u);
        const unsigned gen = old / nloc;
        if (old + 1u == (gen + 1u) * nloc) {
            __builtin_amdgcn_fence(__ATOMIC_RELEASE, "agent");
            asm volatile("s_waitcnt vmcnt(0)" ::: "memory");
            const unsigned og = xb_add(&bar[XB_TOP], 1u);
            const unsigned tg = og / nx;
            if (og + 1u == (tg + 1u) * nx) xb_add(&bar[XB_TOPGEN], 1u);
            else XB_SPIN(xb_ld(&bar[XB_TOPGEN]) == tg, bar);
            __builtin_amdgcn_fence(__ATOMIC_ACQUIRE, "agent");
            xb_add(&bar[XB_XGEN(b.x)], 1u);
            asm volatile("s_waitcnt vmcnt(0)" ::: "memory");
        } else {
            XB_SPIN(xb_ld(&bar[XB_XGEN(b.x)]) == gen, bar);
            __builtin_amdgcn_fence(__ATOMIC_ACQUIRE, "agent");
            asm volatile("s_waitcnt vmcnt(0)" ::: "memory");
        }
    }
    __syncthreads();
}

#define LDS_WAIT() asm volatile("s_waitcnt lgkmcnt(0)" ::: "memory")
#define VM_WAIT() asm volatile("s_waitcnt vmcnt(0)" ::: "memory")
typedef unsigned v4u __attribute__((ext_vector_type(4)));
typedef unsigned v2u __attribute__((ext_vector_type(2)));
constexpr int NWAVES = 8;
constexpr int RING_BYTES = 131072, LDSCTL_OFF = RING_BYTES, MISC_OFF = LDSCTL_OFF + 320, LDS_BYTES = 147456;
constexpr int CW_TMO = 0, CW_BAR = 1024;
constexpr size_t CT_BIAS = 1572864;
constexpr size_t CT_GATE = CT_BIAS + (size_t)DEPTH * 3 * NB * NGU * 4;
constexpr size_t CT_GM = CT_GATE + (size_t)DEPTH * 3 * NB * D * 4;
static_assert(CT_END <= CT_BIAS && CT_GM + (size_t)DEPTH * 3 * NB * D * 4 <= CTL_BYTES, "ctl bias");
constexpr size_t WT_GU1 = 0, WT_DN1 = WT_GU1 + (size_t)NGU * D * 2, WT_IN = WT_DN1 + (size_t)D * FF * 2, WT_UQ = WT_IN + (size_t)4096 * D * 2,
                 WT_UKV = WT_UQ + (size_t)1536 * 512 * 2, WT_OUT = WT_UKV + (size_t)2048 * 256 * 2, WT_GU2 = WT_OUT + (size_t)D * D * 2, WT_DN2 = WT_GU2 + (size_t)NGU * D * 2,
                 WT_LAYER = WT_DN2 + (size_t)D * FF * 2;
static_assert(2 * WT_LAYER <= 340 * MiB, "wt");
constexpr int NPIN = 4096;

__device__ __forceinline__ unsigned pk2(float lo, float hi) { return (unsigned)f2bf(lo) | ((unsigned)f2bf(hi) << 16); }
__device__ __forceinline__ unsigned cvtpk(float lo, float hi) { unsigned r; asm volatile("v_cvt_pk_bf16_f32 %0, %1, %2" : "=v"(r) : "v"(lo), "v"(hi)); return r; }
__device__ __forceinline__ float fsilu(float x) { return x * __builtin_amdgcn_rcpf(1.f + __expf(-x)); }

__device__ __forceinline__ int src_block(int kind, int nb) {
    const int pn = nb >> 3, jb = nb & 7;
    if (kind == 0) return 32 * nb;
    if (kind == 1) return (jb < 4) ? 128 * pn + 32 * jb : FF + 128 * pn + 32 * (jb - 4);
    if (kind == 2) {
        if (pn < 4) { const int rb = pn < 2 ? C_QR : C_KR; return rb + (4 * (pn & 1) + (jb & 3)) * 64 + 32 * (jb >> 2); }
        if (pn < 15) return 256 * pn + 32 * jb;
        return jb == 0 ? C_KPE : (jb == 4 ? C_KPE + 32 : -1);
    }
    if (pn < 4) return (2 * pn + (jb >> 2)) * DQK + 32 * (jb & 3);
    return (4 * (pn - 4) + (jb & 3)) * DQK + NOPE + 32 * (jb >> 2);
}
struct CvtDesc { const float* W; const float* scale; bf16_t* WT; const float* sh; float* bias; int ldw, K, k0, src0, dst0; };
__device__ __forceinline__ void cvt_load(const CvtDesc& d, f32x4 (&v)[8], int lane) {
    if (d.src0 >= 0) {
#pragma unroll
        for (int i = 0; i < 8; ++i) { const int row = i * 8 + (lane >> 3); v[i] = *(const f32x4*)(d.W + (size_t)(d.k0 + row) * d.ldw + d.src0 + 4 * (lane & 7)); }
    } else {
#pragma unroll
        for (int i = 0; i < 8; ++i) v[i] = (f32x4){0.f, 0.f, 0.f, 0.f};
    }
}
__device__ __forceinline__ void cvt_process(const CvtDesc& d, f32x4 (&v)[8], LAS float* scr, LAS float* shs, int lane) {
    if (d.scale) {
#pragma unroll
        for (int i = 0; i < 8; ++i) v[i] *= d.scale[d.k0 + i * 8 + (lane >> 3)]; }
#pragma unroll
    for (int i = 0; i < 8; ++i) { LAS float* q = scr + (i * 8 + (lane >> 3)) * 33 + 4 * (lane & 7); q[0] = v[i][0]; q[1] = v[i][1]; q[2] = v[i][2]; q[3] = v[i][3]; }
    const bool wb = d.sh && d.src0 >= 0;
    if (wb) {
#pragma unroll
        for (int j = 0; j < 4; ++j) shs[lane * 4 + j] = d.sh[(size_t)j * NMOD * D + d.k0 + lane];
    }
    LDS_WAIT(); asm volatile("" ::: "memory");
    const int c = lane & 7;
#pragma unroll
    for (int j = 0; j < 4; ++j) { const int n = (lane >> 3) + 8 * j; const LAS float* s = scr + (8 * c) * 33 + n;
        v4u o; o.x = pk2(s[0 * 33], s[1 * 33]); o.y = pk2(s[2 * 33], s[3 * 33]); o.z = pk2(s[4 * 33], s[5 * 33]); o.w = pk2(s[6 * 33], s[7 * 33]);
        *(v4u*)(d.WT + (size_t)(d.dst0 + n) * d.K + d.k0 + 8 * c) = o; }
    if (wb) {
        const int n = lane & 31, kh = lane >> 5; f32x4 a = {0.f, 0.f, 0.f, 0.f};
#pragma unroll 8
        for (int kk = 0; kk < 32; ++kk) { const int kq = kh * 32 + kk; a += *(const LAS f32x4*)(shs + kq * 4) * scr[kq * 33 + n]; }
#pragma unroll
        for (int j = 0; j < 4; ++j) { float t = a[j]; t += __shfl_xor(t, 32); if (lane < 32) __hip_atomic_fetch_add(d.bias + (size_t)j * NGU + d.dst0 + n, t, __ATOMIC_RELAXED, __HIP_MEMORY_SCOPE_AGENT); }
    }
    LDS_WAIT(); asm volatile("" ::: "memory");
}

struct EpiGU {
    static constexpr bool PERM = true, AFTER_DRAIN = false;
    bf16_t* act; const float* ss; const float* bias;
    __device__ __forceinline__ void operator()(const f32x4 (&acc)[2][2][4][2], const pg8::Unit& u, int wr, int wc, int fr, int fq) const {
        const int row0 = u.pm * 256 + wr * 64 + fr, b = u.pm >> 4, cb = u.pn * 256 + wc * 32 + 8 * fq, oc = u.pn * 128 + wc * 32 + 8 * fq;
        const float* bp = bias + (size_t)b * NGU + cb;
        const f32x4 bg0 = *(const f32x4*)bp, bg1 = *(const f32x4*)(bp + 4), bu0 = *(const f32x4*)(bp + 128), bu1 = *(const f32x4*)(bp + 132);
        float rsv[2][4];
#pragma unroll
        for (int ai = 0; ai < 2; ++ai)
#pragma unroll
            for (int m = 0; m < 4; ++m) rsv[ai][m] = ss[row0 + ai * 128 + m * 16];
        constexpr float NL2E = -1.4426950408889634f;
        const f32x4 cg0 = bg0 * NL2E, cg1 = bg1 * NL2E;
#pragma unroll
        for (int ai = 0; ai < 2; ++ai)
#pragma unroll
            for (int m = 0; m < 4; ++m) { const int row = row0 + ai * 128 + m * 16; const float rs = rsqrtf(rsv[ai][m] * (1.f / D) + EPS), rsn = rs * NL2E;
                const f32x4 g0 = acc[ai][0][m][0] * rs + bg0, g1 = acc[ai][0][m][1] * rs + bg1, u0 = acc[ai][1][m][0] * rs + bu0, u1 = acc[ai][1][m][1] * rs + bu1;
                f32x4 e0 = acc[ai][0][m][0] * rsn + cg0, e1 = acc[ai][0][m][1] * rsn + cg1;
#pragma unroll
                for (int i = 0; i < 4; ++i) { e0[i] = __builtin_amdgcn_exp2f(e0[i]); e1[i] = __builtin_amdgcn_exp2f(e1[i]); }
                e0 = e0 + 1.f; e1 = e1 + 1.f;
#pragma unroll
                for (int i = 0; i < 4; ++i) { e0[i] = __builtin_amdgcn_rcpf(e0[i]); e1[i] = __builtin_amdgcn_rcpf(e1[i]); }
                const f32x4 o0 = (g0 * u0) * e0, o1 = (g1 * u1) * e1;
                v4u w; w.x = cvtpk(o0[0], o0[1]); w.y = cvtpk(o0[2], o0[3]); w.z = cvtpk(o1[0], o1[1]); w.w = cvtpk(o1[2], o1[3]);
                *(v4u*)(act + (size_t)row * FF + oc) = w; }
    }
};
typedef _Float16 f16_t;
typedef _Float16 f16x8 __attribute__((ext_vector_type(8)));
template <bool XF32> struct EpiRes {
    static constexpr bool PERM = true, AFTER_DRAIN = false;
    const float* xin32; const f16_t* xin16; f16_t* xout; bf16_t* xg; float* ssn; const float* gatef; const float* gmn; int has_next, mode;
    __device__ __forceinline__ void operator()(const f32x4 (&acc)[2][2][4][2], const pg8::Unit& u, int wr, int wc, int fr, int fq) const {
        const int row0 = u.pm * 256 + wr * 64 + fr, b = u.pm >> 4, c0 = u.pn * 256 + wc * 32 + 8 * fq;
        const float* gp = gatef + (size_t)b * D + c0; const float* mp = gmn + (size_t)b * D + c0;
        f32x4 gt[2][2], gm[2][2];
#pragma unroll
        for (int bj = 0; bj < 2; ++bj)
#pragma unroll
            for (int n = 0; n < 2; ++n) { gt[bj][n] = *(const f32x4*)(gp + bj * 128 + 4 * n); gm[bj][n] = has_next ? *(const f32x4*)(mp + bj * 128 + 4 * n) : (f32x4){0.f, 0.f, 0.f, 0.f}; }
        f32x4 xv[2][2][2][2]; f16x8 xh[2][2][2];
#define ER_LOAD(q) do { _Pragma("unroll") for (int mm = 0; mm < 2; ++mm) _Pragma("unroll") for (int bj = 0; bj < 2; ++bj) { \
            const size_t off_ = (size_t)(row0 + ((q) >> 1) * 128 + (2 * ((q) & 1) + mm) * 16) * D + c0 + bj * 128; \
            if constexpr (XF32) { xv[(q) & 1][mm][bj][0] = *(const f32x4*)(xin32 + off_); xv[(q) & 1][mm][bj][1] = *(const f32x4*)(xin32 + off_ + 4); } \
            else { xh[(q) & 1][mm][bj] = *(const f16x8*)(xin16 + off_); } } } while (0)
        if constexpr (!XF32) ER_LOAD(0);
        float sqa[4];
#pragma unroll
        for (int q = 0; q < 4; ++q) { const int ai = q >> 1;
            if constexpr (XF32) ER_LOAD(q); else if (q + 1 < 4) ER_LOAD(q + 1);
#pragma unroll
            for (int mm = 0; mm < 2; ++mm) { const int m = 2 * (q & 1) + mm, row = row0 + ai * 128 + m * 16; float sq = 0.f;
#pragma unroll
                for (int bj = 0; bj < 2; ++bj) { const size_t off = (size_t)row * D + c0 + bj * 128;
                    f32x4 x0, x1;
                    if constexpr (XF32) { x0 = xv[q & 1][mm][bj][0]; x1 = xv[q & 1][mm][bj][1]; }
                    else { const f16x8 h = xh[q & 1][mm][bj]; x0 = (f32x4){(float)h[0], (float)h[1], (float)h[2], (float)h[3]}; x1 = (f32x4){(float)h[4], (float)h[5], (float)h[6], (float)h[7]}; }
                    const f32x4 n0 = x0 + gt[bj][0] * acc[ai][bj][m][0], n1 = x1 + gt[bj][1] * acc[ai][bj][m][1];
                    { f16x8 o; o[0] = (f16_t)n0[0]; o[1] = (f16_t)n0[1]; o[2] = (f16_t)n0[2]; o[3] = (f16_t)n0[3]; o[4] = (f16_t)n1[0]; o[5] = (f16_t)n1[1]; o[6] = (f16_t)n1[2]; o[7] = (f16_t)n1[3];
                      *(f16x8*)(xout + off) = o; }
                    sq += (n0[0] * n0[0] + n0[1] * n0[1]) + (n0[2] * n0[2] + n0[3] * n0[3]) + (n1[0] * n1[0] + n1[1] * n1[1]) + (n1[2] * n1[2] + n1[3] * n1[3]);
                    if (has_next) { const f32x4 a = n0 * gm[bj][0], c2 = n1 * gm[bj][1];
                        v4u w; w.x = cvtpk(a[0], a[1]); w.y = cvtpk(a[2], a[3]); w.z = cvtpk(c2[0], c2[1]); w.w = cvtpk(c2[2], c2[3]);
                        *(v4u*)(xg + off) = w; } }
                sq += __shfl_xor(sq, 16); sq += __shfl_xor(sq, 32); sqa[m] = sq; }
            if (q & 1) { const float sv = fq == 0 ? sqa[0] : fq == 1 ? sqa[1] : fq == 2 ? sqa[2] : sqa[3];
                __hip_atomic_fetch_add(ssn + (u.pm * 256 + wr * 64 + ai * 128 + fq * 16 + fr), sv, __ATOMIC_RELAXED, __HIP_MEMORY_SCOPE_AGENT); }
            asm volatile("" ::: "memory"); }
#undef ER_LOAD
    }
};
struct EpiIn {
    static constexpr bool PERM = true, AFTER_DRAIN = false;
    const float* ss; const float* bias; const float* cosT; const float* sinT;
    bf16_t *qr, *kr, *vr, *gr, *cq, *ckv, *Kb; float *ssq, *sskv;
    __device__ __forceinline__ void operator()(const f32x4 (&acc)[2][2][4][2], const pg8::Unit& u, int wr, int wc, int fr, int fq) const {
        const int row0 = u.pm * 256 + wr * 64 + fr, b = u.pm >> 4, pn = u.pn, cb = pn * 256 + wc * 32 + 8 * fq;
        const float* bp = bias + (size_t)b * NGU + cb;
        const f32x4 b00 = *(const f32x4*)bp, b01 = *(const f32x4*)(bp + 4), b10 = *(const f32x4*)(bp + 128), b11 = *(const f32x4*)(bp + 132);
        float rsv[2][4];
#pragma unroll
        for (int ai = 0; ai < 2; ++ai)
#pragma unroll
            for (int m = 0; m < 4; ++m) rsv[ai][m] = ss[row0 + ai * 128 + m * 16];
        asm volatile("" :: "v"(b00), "v"(b01), "v"(b10), "v"(b11), "v"(rsv[0][0]), "v"(rsv[0][1]), "v"(rsv[0][2]), "v"(rsv[0][3]), "v"(rsv[1][0]), "v"(rsv[1][1]), "v"(rsv[1][2]), "v"(rsv[1][3]));
        if (pn == 15 && wc != 0) return;
        if (pn < 4 || pn == 15) {
            const float scale = (pn == 2 || pn == 3) ? 0.125f : 1.0f;
#pragma unroll
            for (int ai = 0; ai < 2; ++ai)
#pragma unroll
                for (int m = 0; m < 4; ++m) { const int row = row0 + ai * 128 + m * 16; const float rs = rsqrtf(rsv[ai][m] * (1.f / D) + EPS);
                    const f32x4 x10 = acc[ai][0][m][0] * rs + b00, x11 = acc[ai][0][m][1] * rs + b01, x20 = acc[ai][1][m][0] * rs + b10, x21 = acc[ai][1][m][1] * rs + b11;
                    const f32x4 c0 = *(const f32x4*)(cosT + (size_t)row * 32 + 8 * fq), c1 = *(const f32x4*)(cosT + (size_t)row * 32 + 8 * fq + 4);
                    const f32x4 s0 = *(const f32x4*)(sinT + (size_t)row * 32 + 8 * fq), s1 = *(const f32x4*)(sinT + (size_t)row * 32 + 8 * fq + 4);
                    const f32x4 o10 = (x10 * c0 - x20 * s0) * scale, o11 = (x11 * c1 - x21 * s1) * scale, o20 = (x10 * s0 + x20 * c0) * scale, o21 = (x11 * s1 + x21 * c1) * scale;
                    v4u w1, w2; w1.x = cvtpk(o10[0], o10[1]); w1.y = cvtpk(o10[2], o10[3]); w1.z = cvtpk(o11[0], o11[1]); w1.w = cvtpk(o11[2], o11[3]);
                    w2.x = cvtpk(o20[0], o20[1]); w2.y = cvtpk(o20[2], o20[3]); w2.z = cvtpk(o21[0], o21[1]); w2.w = cvtpk(o21[2], o21[3]);
                    if (pn < 4) { bf16_t* dst = (pn < 2 ? qr : kr) + (size_t)row * 512 + (4 * (pn & 1) + wc) * 64 + 8 * fq; *(v4u*)dst = w1; *(v4u*)(dst + 32) = w2; }
                    else {
#pragma unroll
                        for (int h = 0; h < MH; ++h) { bf16_t* dst = Kb + (size_t)row * MH * DQK + h * DQK + NOPE + 8 * fq; *(v4u*)dst = w1; *(v4u*)(dst + 32) = w2; } }
                    asm volatile("" ::: "memory"); }
        } else {
            bf16_t* dbase; int ld; float* ssp = nullptr;
            if (pn < 8) { dbase = vr + (pn - 4) * 256; ld = 1024; } else if (pn < 12) { dbase = gr + (pn - 8) * 256; ld = 1024; }
            else if (pn < 14) { dbase = cq + (pn - 12) * 256; ld = 512; ssp = ssq; } else { dbase = ckv; ld = 256; ssp = sskv; }
            const bool gate = (pn >= 8 && pn < 12);
#pragma unroll
            for (int ai = 0; ai < 2; ++ai)
#pragma unroll
                for (int m = 0; m < 4; ++m) { const int row = row0 + ai * 128 + m * 16; const float rs = rsqrtf(rsv[ai][m] * (1.f / D) + EPS); float q = 0.f;
#pragma unroll
                    for (int bj = 0; bj < 2; ++bj) { f32x4 v0 = acc[ai][bj][m][0] * rs + (bj ? b10 : b00), v1 = acc[ai][bj][m][1] * rs + (bj ? b11 : b01);
                        q += (v0[0] * v0[0] + v0[1] * v0[1]) + (v0[2] * v0[2] + v0[3] * v0[3]) + (v1[0] * v1[0] + v1[1] * v1[1]) + (v1[2] * v1[2] + v1[3] * v1[3]);
                        if (gate) {
#pragma unroll
                            for (int i = 0; i < 4; ++i) { v0[i] = fsilu(v0[i]); v1[i] = fsilu(v1[i]); } }
                        v4u w; w.x = cvtpk(v0[0], v0[1]); w.y = cvtpk(v0[2], v0[3]); w.z = cvtpk(v1[0], v1[1]); w.w = cvtpk(v1[2], v1[3]);
                        *(v4u*)(dbase + (size_t)row * ld + bj * 128 + wc * 32 + 8 * fq) = w; }
                    if (ssp) { q += __shfl_xor(q, 16); q += __shfl_xor(q, 32); if (fq == 0) __hip_atomic_fetch_add(ssp + row, q, __ATOMIC_RELAXED, __HIP_MEMORY_SCOPE_AGENT); }
                    asm volatile("" ::: "memory"); }
        }
    }
};
struct EpiUq {
    static constexpr bool PERM = true, AFTER_DRAIN = false;
    const float* ssq; const float* cosT; const float* sinT; bf16_t* Qb;
    __device__ __forceinline__ void operator()(const f32x4 (&acc)[2][2][4][2], const pg8::Unit& u, int wr, int wc, int fr, int fq) const {
        const int row0 = u.pm * 256 + wr * 64 + fr, pn = u.pn;
        float rsv[2][4];
#pragma unroll
        for (int ai = 0; ai < 2; ++ai)
#pragma unroll
            for (int m = 0; m < 4; ++m) rsv[ai][m] = ssq[row0 + ai * 128 + m * 16];
#pragma unroll
        for (int ai = 0; ai < 2; ++ai)
#pragma unroll
            for (int m = 0; m < 4; ++m) { const int row = row0 + ai * 128 + m * 16; const float rs = rsqrtf(rsv[ai][m] * (1.f / QRANK) + EPS);
                if (pn < 4) {
#pragma unroll
                    for (int bj = 0; bj < 2; ++bj) { const f32x4 v0 = acc[ai][bj][m][0] * rs, v1 = acc[ai][bj][m][1] * rs;
                        v4u w; w.x = cvtpk(v0[0], v0[1]); w.y = cvtpk(v0[2], v0[3]); w.z = cvtpk(v1[0], v1[1]); w.w = cvtpk(v1[2], v1[3]);
                        *(v4u*)(Qb + (size_t)row * MH * DQK + (2 * pn + bj) * DQK + wc * 32 + 8 * fq) = w; }
                } else {
                    const f32x4 x10 = acc[ai][0][m][0] * rs, x11 = acc[ai][0][m][1] * rs, x20 = acc[ai][1][m][0] * rs, x21 = acc[ai][1][m][1] * rs;
                    const f32x4 c0 = *(const f32x4*)(cosT + (size_t)row * 32 + 8 * fq), c1 = *(const f32x4*)(cosT + (size_t)row * 32 + 8 * fq + 4);
                    const f32x4 s0 = *(const f32x4*)(sinT + (size_t)row * 32 + 8 * fq), s1 = *(const f32x4*)(sinT + (size_t)row * 32 + 8 * fq + 4);
                    const f32x4 o10 = x10 * c0 - x20 * s0, o11 = x11 * c1 - x21 * s1, o20 = x10 * s0 + x20 * c0, o21 = x11 * s1 + x21 * c1;
                    v4u w1, w2; w1.x = cvtpk(o10[0], o10[1]); w1.y = cvtpk(o10[2], o10[3]); w1.z = cvtpk(o11[0], o11[1]); w1.w = cvtpk(o11[2], o11[3]);
                    w2.x = cvtpk(o20[0], o20[1]); w2.y = cvtpk(o20[2], o20[3]); w2.z = cvtpk(o21[0], o21[1]); w2.w = cvtpk(o21[2], o21[3]);
                    bf16_t* dst = Qb + (size_t)row * MH * DQK + (4 * (pn - 4) + wc) * DQK + NOPE + 8 * fq; *(v4u*)dst = w1; *(v4u*)(dst + 32) = w2;
                }
                asm volatile("" ::: "memory"); }
    }
};
struct EpiUkv {
    static constexpr bool PERM = true, AFTER_DRAIN = false;
    const float* sskv; bf16_t* Kb; bf16_t* Vb;
    __device__ __forceinline__ void operator()(const f32x4 (&acc)[2][2][4][2], const pg8::Unit& u, int wr, int wc, int fr, int fq) const {
        const int row0 = u.pm * 256 + wr * 64 + fr, pn = u.pn;
        float rsv[2][4];
#pragma unroll
        for (int ai = 0; ai < 2; ++ai)
#pragma unroll
            for (int m = 0; m < 4; ++m) rsv[ai][m] = sskv[row0 + ai * 128 + m * 16];
#pragma unroll
        for (int ai = 0; ai < 2; ++ai)
#pragma unroll
            for (int m = 0; m < 4; ++m) { const int row = row0 + ai * 128 + m * 16; const float rs = rsqrtf(rsv[ai][m] * (1.f / KVRANK) + EPS);
#pragma unroll
                for (int bj = 0; bj < 2; ++bj) { const f32x4 v0 = acc[ai][bj][m][0] * rs, v1 = acc[ai][bj][m][1] * rs;
                    v4u w; w.x = cvtpk(v0[0], v0[1]); w.y = cvtpk(v0[2], v0[3]); w.z = cvtpk(v1[0], v1[1]); w.w = cvtpk(v1[2], v1[3]);
                    bf16_t* dst = bj ? Vb + (size_t)row * MH * MDV + pn * MDV + wc * 32 + 8 * fq : Kb + (size_t)row * MH * DQK + pn * DQK + wc * 32 + 8 * fq;
                    *(v4u*)dst = w; }
                asm volatile("" ::: "memory"); }
    }
};

namespace att {
typedef short s16x4 __attribute__((ext_vector_type(4)));
typedef float f32x16 __attribute__((ext_vector_type(16)));
constexpr int SHM_V = 64 * 128 * 2, SHM_K = 64 * DQK * 2;
constexpr int V_OFF = 0, K_OFF = 2 * SHM_V, WS_OFF = K_OFF + 2 * SHM_K;
constexpr float SCALE = 0.07216878364870323f;
constexpr float THR = 8.f;
#define ATT_SBAR() __builtin_amdgcn_sched_barrier(0)
__device__ __forceinline__ int v_st(int k, int c) { const int kk = (k & ~0xC) | ((k & 4) << 1) | ((k & 8) >> 1); return ((kk >> 3) * 4 + (c >> 5)) * 512 + ((kk & 7) * 32 + (c & 31)) * 2; }
__device__ __forceinline__ int v_rd_base(int lane) { return ((lane & 3) << 3) | (((lane >> 2) & 3) << 6) | (((lane >> 4) & 1) << 5) | (((lane >> 5) & 1) << 8); }
constexpr int v_rd_off(int d0, int ks, int half) { return d0 * 512 + ks * 4096 + half * 2048; }
__device__ __forceinline__ int crow(int r, int hi) { return (r & 3) + 8 * (r >> 2) + 4 * hi; }
__device__ __forceinline__ int k_off(int r, int ch) { return r * 384 + (((ch & ~7) | ((ch ^ (r >> 1)) & 7)) << 4); }
__device__ __forceinline__ void mask_tile(f32x16& p0, f32x16& p1, int dq) {
    const float NEG = -__builtin_inff();
#pragma unroll
    for (int r = 0; r < 16; ++r) { const int c = (r & 3) + 8 * (r >> 2); if (dq - c < 0) p0[r] = NEG; if (dq - c - 32 < 0) p1[r] = NEG; }
}
__device__ __forceinline__ void partialSM(f32x16& p0, f32x16& p1, float& m_reg, float& mn, float& alpha) {
    float pmax = p0[0];
#pragma unroll
    for (int r = 1; r < 16; ++r) pmax = fmaxf(pmax, p0[r]);
#pragma unroll
    for (int r = 0; r < 16; ++r) pmax = fmaxf(pmax, p1[r]);
    { auto rr = __builtin_amdgcn_permlane32_swap(__float_as_uint(pmax), __float_as_uint(pmax), false, false);
      pmax = fmaxf(__uint_as_float(rr[0]), __uint_as_float(rr[1])); }
    constexpr float C2 = 1.4426950408889634f * SCALE;
    if (__builtin_expect(__all((pmax - m_reg) * SCALE <= THR), 1)) { mn = m_reg; alpha = 1.f; }
    else { mn = fmaxf(m_reg, pmax); alpha = __builtin_amdgcn_exp2f((m_reg - mn) * C2); m_reg = mn; }
    const float mnL = -mn * C2;
#pragma unroll
    for (int r = 0; r < 16; ++r) p0[r] = fmaf(p0[r], C2, mnL);
#pragma unroll
    for (int r = 0; r < 16; ++r) p1[r] = fmaf(p1[r], C2, mnL);
#pragma unroll
    for (int r = 0; r < 16; ++r) p0[r] = __builtin_amdgcn_exp2f(p0[r]);
}
#define ATT_PK4(P, B_, OUT) do { unsigned a0 = cvtpk(P[B_+0], P[B_+1]), a1 = cvtpk(P[B_+2], P[B_+3]); unsigned b0 = cvtpk(P[B_+4], P[B_+5]), b1 = cvtpk(P[B_+6], P[B_+7]); \
        auto r0 = __builtin_amdgcn_permlane32_swap(a0, b0, false, false); auto r1 = __builtin_amdgcn_permlane32_swap(a1, b1, false, false); \
        v4u w = {r0[0], r1[0], r0[1], r1[1]}; OUT = *reinterpret_cast<bf16x8*>(&w); } while (0)
__device__ __forceinline__ void pack_p(const f32x16& p0, const f32x16& p1, bf16x8& pa0, bf16x8& pa1, bf16x8& pa2, bf16x8& pa3) {
    ATT_PK4(p0, 0, pa0); ATT_PK4(p0, 8, pa1); ATT_PK4(p1, 0, pa2); ATT_PK4(p1, 8, pa3);
}
__device__ __forceinline__ void finishSM(f32x16& p0, f32x16& p1, float alpha, float& l_reg, bf16x8& pa0, bf16x8& pa1, bf16x8& pa2, bf16x8& pa3) {
#pragma unroll
    for (int r = 0; r < 16; ++r) p1[r] = __builtin_amdgcn_exp2f(p1[r]);
    float ps = 0;
#pragma unroll
    for (int r = 0; r < 16; ++r) ps += p0[r];
#pragma unroll
    for (int r = 0; r < 16; ++r) ps += p1[r];
    { auto rr = __builtin_amdgcn_permlane32_swap(__float_as_uint(ps), __float_as_uint(ps), false, false);
      ps = __uint_as_float(rr[0]) + __uint_as_float(rr[1]); }
    l_reg = l_reg * alpha + ps;
    pack_p(p0, p1, pa0, pa1, pa2, pa3);
}
template <int ND, int KROW>
__device__ __forceinline__ void qkt(f32x16& p0, f32x16& p1, const LAS unsigned char* kbuf, int r32, int hi, const bf16x8* qf) {
    p0 = f32x16{}; p1 = f32x16{};
    int ka[4];
#pragma unroll
    for (int dd = 0; dd < 4; ++dd) ka[dd] = (int)(uintptr_t)kbuf + r32 * KROW + ((((2 * dd + hi) ^ (r32 >> 1)) & 7) << 4);
    bf16x8 f0[2], f1[2];
#define ATT_KRD(dst, addr, off) asm volatile("ds_read_b128 %0, %1 offset:%2" : "=&v"(dst) : "v"(addr), "i"(off) : "memory")
    __builtin_amdgcn_sched_barrier(0);
    ATT_KRD(f0[0], ka[0], 0); ATT_KRD(f1[0], ka[0], 32 * KROW);
#pragma unroll
    for (int d0 = 0; d0 < ND; ++d0) {
        if (d0 + 1 < ND) { ATT_KRD(f0[(d0 + 1) & 1], ka[(d0 + 1) & 3], ((d0 + 1) >> 2) * 128); ATT_KRD(f1[(d0 + 1) & 1], ka[(d0 + 1) & 3], ((d0 + 1) >> 2) * 128 + 32 * KROW); }
        if (d0 + 1 < ND) asm volatile("s_waitcnt lgkmcnt(2)" ::: "memory"); else asm volatile("s_waitcnt lgkmcnt(0)" ::: "memory");
        __builtin_amdgcn_sched_barrier(0);
        p0 = __builtin_amdgcn_mfma_f32_32x32x16_bf16(f0[d0 & 1], qf[d0], p0, 0, 0, 0);
        p1 = __builtin_amdgcn_mfma_f32_32x32x16_bf16(f1[d0 & 1], qf[d0], p1, 0, 0, 0);
        __builtin_amdgcn_sched_barrier(0);
    }
#undef ATT_KRD
}
template <int VB>
__device__ __forceinline__ void pv_tile(f32x16* o, int vb0, bf16x8 pa0, bf16x8 pa1, bf16x8 pa2, bf16x8 pa3) {
#define ATT_TRRD(dst, off) asm volatile("ds_read_b64_tr_b16 %0, %1 offset:%2" : "=&v"(dst) : "v"(vb0), "i"(off) : "memory")
#define ATT_PV_D0(d0) do { s16x4 l0, l1, l2, l3, h0, h1, h2, h3; constexpr int b_ = VB * SHM_V + v_rd_off(d0, 0, 0); \
        ATT_TRRD(l0, b_); ATT_TRRD(h0, b_ + 2048); ATT_TRRD(l1, b_ + 4096); ATT_TRRD(h1, b_ + 6144); ATT_TRRD(l2, b_ + 8192); ATT_TRRD(h2, b_ + 10240); ATT_TRRD(l3, b_ + 12288); ATT_TRRD(h3, b_ + 14336); \
        asm volatile("s_waitcnt lgkmcnt(0)" ::: "memory"); ATT_SBAR(); \
        o[d0] = __builtin_amdgcn_mfma_f32_32x32x16_bf16(pa0, (bf16x8){l0[0], l0[1], l0[2], l0[3], h0[0], h0[1], h0[2], h0[3]}, o[d0], 0, 0, 0); \
        o[d0] = __builtin_amdgcn_mfma_f32_32x32x16_bf16(pa1, (bf16x8){l1[0], l1[1], l1[2], l1[3], h1[0], h1[1], h1[2], h1[3]}, o[d0], 0, 0, 0); \
        o[d0] = __builtin_amdgcn_mfma_f32_32x32x16_bf16(pa2, (bf16x8){l2[0], l2[1], l2[2], l2[3], h2[0], h2[1], h2[2], h2[3]}, o[d0], 0, 0, 0); \
        o[d0] = __builtin_amdgcn_mfma_f32_32x32x16_bf16(pa3, (bf16x8){l3[0], l3[1], l3[2], l3[3], h3[0], h3[1], h3[2], h3[3]}, o[d0], 0, 0, 0); } while (0)
    ATT_PV_D0(0); ATT_PV_D0(1); ATT_PV_D0(2); ATT_PV_D0(3);
#undef ATT_PV_D0
#undef ATT_TRRD
}
__device__ __forceinline__ void store_o_bf16(const f32x16* o, const float* rsc, bf16_t* dst, int ld, int r32, int hi) {
#pragma unroll
    for (int r = 0; r < 16; ++r) { const int orow = crow(r, hi);
#pragma unroll
        for (int d0 = 0; d0 < 4; ++d0) { const float v = o[d0][r] * rsc[r]; const float vn = __shfl_xor(v, 1);
            if ((r32 & 1) == 0) *(unsigned*)(dst + (size_t)orow * ld + d0 * 32 + r32) = cvtpk(v, vn); } }
}

__device__ __forceinline__ bf16x8 bload8(__amdgpu_buffer_rsrc_t rs, int voff, int soff) { const v4u w = __builtin_amdgcn_raw_buffer_load_b128(rs, voff, soff, 0); return *reinterpret_cast<const bf16x8*>(&w); }
__device__ __forceinline__ void attn_phase(LAS unsigned char* lds, const bf16_t* Qb, const bf16_t* Kb, const bf16_t* Vb, bf16_t* y, int G, int bx, int mode = 0) {
    int tid_ = threadIdx.x; asm volatile("" : "+v"(tid_));
    const int tid = tid_, wid = __builtin_amdgcn_readfirstlane(tid >> 6), lane = tid & 63, r32 = lane & 31, hi = lane >> 5;
    const int late = wid >> 2;
    LAS unsigned char* V_lds = lds + V_OFF; LAS unsigned char* K_lds = lds + K_OFF;
    LAS float* wsr = (LAS float*)(lds + WS_OFF) + wid * 64; LAS float* li_l = wsr; LAS float* al_l = wsr + 32;
    const __amdgpu_buffer_rsrc_t rsQ = __builtin_amdgcn_make_buffer_rsrc((void*)Qb, (short)0, (int)((size_t)M * MH * DQK * 2), 0x00020000),
        rsK = __builtin_amdgcn_make_buffer_rsrc((void*)Kb, (short)0, (int)((size_t)M * MH * DQK * 2), 0x00020000), rsV = __builtin_amdgcn_make_buffer_rsrc((void*)Vb, (short)0, (int)((size_t)M * MH * MDV * 2), 0x00020000);
    int kgo[3], kld[3];
#pragma unroll
    for (int i = 0; i < 3; ++i) { const int id = tid + 512 * i, row = id / 24, ch = id % 24; kgo[i] = (row * MH * DQK + ch * 8) * 2; kld[i] = k_off(row, ch); }
    const int sr = tid >> 4, sc = (tid & 15) * 8, vst0 = v_st(sr, sc), vst1 = v_st(32 + sr, sc), vgo0 = (sr * MH * MDV + sc) * 2, vgo1 = ((32 + sr) * MH * MDV + sc) * 2;
    const int vb0 = (int)(uintptr_t)V_lds + v_rd_base(lane);
    const int qgo = ((wid * 32 + r32) * MH * DQK + hi * 8) * 2;
    for (int item = bx; item < NB * MH * 8; item += G) {
        const int h = item & 7, slot = item >> 3, b = slot >> 3, x = slot & 7;
        const int ksb = (b * SEQ * MH + h) * DQK * 2, vsb = (b * SEQ * MH + h) * MDV * 2;
        for (int pass = 0; pass < 2; ++pass) {
            const int qb = pass ? 15 - x : x, q0 = qb * 256, NT = 4 * qb + 4;
            bf16x8 qf[12];
#pragma unroll
            for (int d0 = 0; d0 < 12; ++d0) qf[d0] = bload8(rsQ, qgo + d0 * 32, ksb + q0 * MH * DQK * 2);
            const int qm = q0 + wid * 32 + r32 - 4 * hi;
            float m_reg = -1e30f, l_reg = 0.f; f32x16 o[4] = {};
            f32x16 p0, p1; bf16x8 pa0, pa1, pa2, pa3;
            bf16x8 sk0, sk1, sk2, sv0, sv1;
#define ATT_LOADK(kb_) do { const int ks_ = ksb + (kb_) * MH * DQK * 2; sk0 = bload8(rsK, kgo[0], ks_); sk1 = bload8(rsK, kgo[1], ks_); sk2 = bload8(rsK, kgo[2], ks_); } while (0)
#define ATT_LOADV(kb_) do { const int vs_ = vsb + (kb_) * MH * MDV * 2; sv0 = bload8(rsV, vgo0, vs_); sv1 = bload8(rsV, vgo1, vs_); } while (0)
#define ATT_WRITEK(bf) do { *(LAS bf16x8*)(K_lds + (bf) * SHM_K + kld[0]) = sk0; *(LAS bf16x8*)(K_lds + (bf) * SHM_K + kld[1]) = sk1; *(LAS bf16x8*)(K_lds + (bf) * SHM_K + kld[2]) = sk2; } while (0)
#define ATT_WRITEV(bf) do { *(LAS bf16x8*)(V_lds + (bf) * SHM_V + vst0) = sv0; *(LAS bf16x8*)(V_lds + (bf) * SHM_V + vst1) = sv1; } while (0)
#define ATT_RESC(a) do { if (__any((a) < 1.f)) { if (hi == 0) al_l[r32] = (a); asm volatile("s_waitcnt lgkmcnt(0)" ::: "memory"); \
        _Pragma("unroll") for (int d_ = 0; d_ < 4; ++d_) _Pragma("unroll") for (int r = 0; r < 16; ++r) o[d_][r] *= al_l[crow(r, hi)]; } } while (0)
#define ATT_BAR() do { asm volatile("s_waitcnt lgkmcnt(0)" ::: "memory"); __builtin_amdgcn_s_barrier(); asm volatile("" ::: "memory"); } while (0)
            ATT_LOADK(0); ATT_WRITEK(0); ATT_LOADK(64); ATT_LOADV(0);
            ATT_BAR();
#define ATT_QK(t) do { if (!(mode & 1)) qkt<12, 384>(p0, p1, K_lds + ((t) & 1) * SHM_K, r32, hi, qf); } while (0)
#define ATT_PV(t) do { if (!(mode & 2)) pv_tile<0>(o, vb0 + ((t) & 1) * SHM_V, pa0, pa1, pa2, pa3); } while (0)
#define ATT_SM(t) do { if (!(mode & 4)) { float mn, alpha; if ((t) >= NT - 4) mask_tile(p0, p1, qm - (t) * 64); \
        partialSM(p0, p1, m_reg, mn, alpha); ATT_RESC(alpha); finishSM(p0, p1, alpha, l_reg, pa0, pa1, pa2, pa3); } } while (0)
#define ATT_STAGE(t) do { if (!(mode & 8)) { if ((t) + 1 < NT) ATT_WRITEK(((t) + 1) & 1); ATT_WRITEV((t) & 1); if ((t) + 2 < NT) ATT_LOADK(((t) + 2) * 64); if ((t) + 1 < NT) ATT_LOADV(((t) + 1) * 64); } } while (0)
            if (late == 0) {
                ATT_QK(0); ATT_BAR();
                ATT_SM(0); ATT_STAGE(0); ATT_BAR();
                for (int t = 1; t < NT; ++t) {
                    ATT_PV(t - 1); ATT_QK(t); ATT_BAR();
                    ATT_SM(t); ATT_STAGE(t); ATT_BAR();
                }
                ATT_PV(NT - 1); ATT_BAR();
                ATT_BAR();
            } else {
                ATT_BAR();
                ATT_QK(0); ATT_STAGE(0); ATT_BAR();
                for (int t = 1; t < NT; ++t) {
                    ATT_SM(t - 1); ATT_BAR();
                    ATT_PV(t - 1); ATT_QK(t); ATT_STAGE(t); ATT_BAR();
                }
                ATT_SM(NT - 1); ATT_BAR();
                ATT_PV(NT - 1); ATT_BAR();
            }
#undef ATT_BAR
#undef ATT_QK
#undef ATT_PV
#undef ATT_SM
#undef ATT_STAGE
            if (hi == 0) li_l[r32] = l_reg; asm volatile("s_waitcnt lgkmcnt(0)" ::: "memory");
            float rli[16];
#pragma unroll
            for (int r = 0; r < 16; ++r) rli[r] = __builtin_amdgcn_rcpf(li_l[crow(r, hi)]);
            store_o_bf16(o, rli, y + ((size_t)b * SEQ + q0 + wid * 32) * MIXW + RETW + h * MDV, MIXW, r32, hi);
        }
    }
    __syncthreads();
#undef ATT_LOADK
#undef ATT_LOADV
#undef ATT_WRITEK
#undef ATT_WRITEV
#undef ATT_RESC
}
}

namespace ret {
using att::f32x16; using att::s16x4; using att::crow; using att::v_st; using att::v_rd_base; using att::bload8;
constexpr int TILE_V = 16384, TILE_K = 8192;
__device__ __forceinline__ float log2_gamma(int h) {
    return h == 0 ? -4.580368847e-02f : h == 1 ? -2.272007614e-02f : h == 2 ? -1.131531317e-02f : h == 3 ? -5.646563135e-03f : h == 4 ? -2.820519032e-03f : h == 5 ? -1.409570221e-03f : h == 6 ? -7.046129904e-04f : -3.522634797e-04f; }
#define RET_TRRD(dst, vb, off) asm volatile("ds_read_b64_tr_b16 %0, %1 offset:%2" : "=&v"(dst) : "v"(vb), "i"(off) : "memory")
__device__ __forceinline__ void inc_phase(LAS unsigned char* lds, const bf16_t* kr, const bf16_t* vr, float* incT, int G, int bx) {
    const __amdgpu_buffer_rsrc_t rsK = __builtin_amdgcn_make_buffer_rsrc((void*)kr, (short)0, (int)((size_t)M * 512 * 2), 0x00020000), rsV = __builtin_amdgcn_make_buffer_rsrc((void*)vr, (short)0, (int)((size_t)M * 1024 * 2), 0x00020000);
    LAS unsigned char* V_lds = lds; LAS unsigned char* K_lds = lds + 2 * TILE_V;
    const bool bal = (G == 256); const int ucnt = bal ? (bx < 128 ? 2 : 6) : 0, ubase = bal ? (bx < 128 ? 2 * bx : 256 + 6 * (bx - 128)) : 0;
    for (int ui = 0;; ++ui) {
        const int unit = bal ? ubase + ui : bx + ui * G;
        if (bal ? ui >= ucnt : unit >= NB * RH * 32) break;
        int tid_ = threadIdx.x; asm volatile("" : "+v"(tid_));
        const int tid = tid_, wid = __builtin_amdgcn_readfirstlane(tid >> 6), lane = tid & 63, r32 = lane & 31, hi = lane >> 5;
        const int eblk = wid & 3, dblk = wid >> 2;
        const int vbV = (int)(uintptr_t)V_lds + v_rd_base(lane) + eblk * 512, vbK = (int)(uintptr_t)K_lds + v_rd_base(lane) + dblk * 512;
        const int h = unit & 7, b = (unit >> 3) & 3, n = unit >> 5;
        const float l2g = log2_gamma(h);
        const int tok0 = b * SEQ + n * RCH;
        { bf16x8 kv[2], vv[4];
#pragma unroll
          for (int i = 0; i < 2; ++i) { const int id = tid + 512 * i, tok = id >> 3, ch = id & 7; kv[i] = bload8(rsK, (tok * 512 + ch * 8) * 2, (tok0 * 512 + h * 64) * 2); }
#pragma unroll
          for (int i = 0; i < 4; ++i) { const int id = tid + 512 * i, tok = id >> 4, c16 = id & 15; vv[i] = bload8(rsV, (tok * 1024 + c16 * 8) * 2, (tok0 * 1024 + h * 128) * 2); }
#pragma unroll
          for (int i = 0; i < 2; ++i) { const int id = tid + 512 * i, tok = id >> 3, ch = id & 7; const float dec = __builtin_amdgcn_exp2f(l2g * (float)(RCH - 1 - tok));
            v4u w; w.x = cvtpk(bf2f((bf16_t)kv[i][0]) * dec, bf2f((bf16_t)kv[i][1]) * dec); w.y = cvtpk(bf2f((bf16_t)kv[i][2]) * dec, bf2f((bf16_t)kv[i][3]) * dec);
            w.z = cvtpk(bf2f((bf16_t)kv[i][4]) * dec, bf2f((bf16_t)kv[i][5]) * dec); w.w = cvtpk(bf2f((bf16_t)kv[i][6]) * dec, bf2f((bf16_t)kv[i][7]) * dec);
            *(LAS v4u*)(K_lds + (tok >> 6) * TILE_V + v_st(tok & 63, ch * 8)) = w; }
#pragma unroll
          for (int i = 0; i < 4; ++i) { const int id = tid + 512 * i, tok = id >> 4, c16 = id & 15; *(LAS bf16x8*)(V_lds + (tok >> 6) * TILE_V + v_st(tok & 63, c16 * 8)) = vv[i]; } }
        __syncthreads();
        f32x16 acc = {};
#define RET_INC_STEP(KT, KS) do { s16x4 al, ah, bl, bh_; constexpr int o_ = (KT) * TILE_V + (KS) * 4096; \
        RET_TRRD(al, vbV, o_); RET_TRRD(ah, vbV, o_ + 2048); RET_TRRD(bl, vbK, o_); RET_TRRD(bh_, vbK, o_ + 2048); \
        asm volatile("s_waitcnt lgkmcnt(0)" ::: "memory"); __builtin_amdgcn_sched_barrier(0); \
        acc = __builtin_amdgcn_mfma_f32_32x32x16_bf16((bf16x8){al[0], al[1], al[2], al[3], ah[0], ah[1], ah[2], ah[3]}, (bf16x8){bl[0], bl[1], bl[2], bl[3], bh_[0], bh_[1], bh_[2], bh_[3]}, acc, 0, 0, 0); } while (0)
        RET_INC_STEP(0, 0); RET_INC_STEP(0, 1); RET_INC_STEP(0, 2); RET_INC_STEP(0, 3); RET_INC_STEP(1, 0); RET_INC_STEP(1, 1); RET_INC_STEP(1, 2); RET_INC_STEP(1, 3);
#undef RET_INC_STEP
        float* op = incT + ((size_t)((b * RH + h) * 32 + n)) * (RDV * RDK) + (size_t)(32 * eblk) * RDK + 32 * dblk + r32;
#pragma unroll
        for (int r = 0; r < 16; ++r) op[(size_t)crow(r, hi) * RDK] = acc[r];
        __syncthreads();
    }
}
__device__ __forceinline__ void scan_phase(const float* incT, bf16_t* prevT, int G, int vcu) {
    typedef float f32x2 __attribute__((ext_vector_type(2)));
    int tid_ = threadIdx.x; asm volatile("" : "+v"(tid_));
    for (int p = vcu * NWAVES * 64 + tid_; p < NB * RH * RDV * RDK / 2; p += G * NWAVES * 64) {
        const int bh = p >> 12, off = (p & 4095) * 2; const float cd = exp2f(log2_gamma(bh & 7) * (float)RCH);
        const float* ip = incT + (size_t)bh * 32 * (RDV * RDK) + off; bf16_t* pp = prevT + (size_t)bh * 32 * (RDV * RDK) + off;
        f32x2 st = {0.f, 0.f};
#pragma unroll
        for (int n0 = 0; n0 < 32; n0 += 16) { f32x2 iv[16];
#pragma unroll
            for (int j = 0; j < 16; ++j) iv[j] = *(const f32x2*)(ip + (size_t)(n0 + j) * (RDV * RDK));
#pragma unroll
            for (int j = 0; j < 16; ++j) { *(unsigned*)(pp + (size_t)(n0 + j) * (RDV * RDK)) = cvtpk(st[0], st[1]); st = st * cd + iv[j]; } }
    }
}
constexpr int OST_ROW = 272;
__device__ __forceinline__ void out_phase(LAS unsigned char* lds, const bf16_t* qr, const bf16_t* kr, const bf16_t* vr, const bf16_t* gr, const bf16_t* prevT, const float* rgain, bf16_t* y, int G, int bx) {
    const __amdgpu_buffer_rsrc_t rsQ = __builtin_amdgcn_make_buffer_rsrc((void*)qr, (short)0, (int)((size_t)M * 512 * 2), 0x00020000), rsK = __builtin_amdgcn_make_buffer_rsrc((void*)kr, (short)0, (int)((size_t)M * 512 * 2), 0x00020000),
        rsV = __builtin_amdgcn_make_buffer_rsrc((void*)vr, (short)0, (int)((size_t)M * 1024 * 2), 0x00020000), rsP = __builtin_amdgcn_make_buffer_rsrc((void*)prevT, (short)0, (int)((size_t)NB * RH * 32 * RDV * RDK * 2), 0x00020000),
        rsG = __builtin_amdgcn_make_buffer_rsrc((void*)gr, (short)0, (int)((size_t)M * 1024 * 2), 0x00020000);
    LAS unsigned char* V_lds = lds; LAS unsigned char* K_lds = lds + 4 * TILE_V;
    for (int unit = bx; unit < NB * RH * 16; unit += G) {
        int tid_ = threadIdx.x; asm volatile("" : "+v"(tid_));
        const int tid = tid_, wid = __builtin_amdgcn_readfirstlane(tid >> 6), lane = tid & 63, r32 = lane & 31, hi = lane >> 5;
        const int c = wid >> 2, s = wid & 3;
        const int vb0 = (int)(uintptr_t)V_lds + v_rd_base(lane) + c * 2 * TILE_V;
        const int h = unit & 7, b = (unit >> 3) & 3, cb = unit >> 5;
        const float l2g = log2_gamma(h);
        const int tok0 = b * SEQ + cb * 256;
        bf16x8 qf[4];
        { bf16x8 kv[4], vv[8];
#pragma unroll
          for (int i = 0; i < 4; ++i) { const int id = tid + 512 * i, tok = id >> 3, ch = id & 7; kv[i] = bload8(rsK, (tok * 512 + ch * 8) * 2, (tok0 * 512 + h * 64) * 2); }
#pragma unroll
          for (int i = 0; i < 8; ++i) { const int id = tid + 512 * i, tok = id >> 4, c16 = id & 15; vv[i] = bload8(rsV, (tok * 1024 + c16 * 8) * 2, (tok0 * 1024 + h * 128) * 2); }
#pragma unroll
          for (int d0 = 0; d0 < 4; ++d0) qf[d0] = bload8(rsQ, ((c * 128 + s * 32 + r32) * 512 + hi * 8) * 2 + d0 * 32, (tok0 * 512 + h * 64) * 2);
#pragma unroll
          for (int i = 0; i < 4; ++i) { const int id = tid + 512 * i, tok = id >> 3, ch = id & 7, row = tok & 63; *(LAS bf16x8*)(K_lds + (tok >> 6) * TILE_K + row * 128 + (((ch ^ (row >> 1)) & 7) << 4)) = kv[i]; }
#pragma unroll
          for (int i = 0; i < 8; ++i) { const int id = tid + 512 * i, tok = id >> 4, c16 = id & 15; *(LAS bf16x8*)(V_lds + (tok >> 6) * TILE_V + v_st(tok & 63, c16 * 8)) = vv[i]; } }
        f32x16 o[4] = {};
        const int psb = (((b * RH + h) * 32 + 2 * cb + c) * (RDV * RDK)) * 2;
#pragma unroll
        for (int hp = 0; hp < 2; ++hp) { bf16x8 pf[2][4];
#pragma unroll
            for (int dd = 0; dd < 2; ++dd)
#pragma unroll
                for (int ks = 0; ks < 4; ++ks) pf[dd][ks] = bload8(rsP, (((2 * hp + dd) * 32 + r32) * RDK + hi * 8) * 2 + ks * 32, psb);
#pragma unroll
            for (int dd = 0; dd < 2; ++dd)
#pragma unroll
                for (int ks = 0; ks < 4; ++ks) o[2 * hp + dd] = __builtin_amdgcn_mfma_f32_32x32x16_bf16(qf[ks], pf[dd][ks], o[2 * hp + dd], 0, 0, 0);
            asm volatile("" ::: "memory"); }
#pragma unroll
        for (int r = 0; r < 16; ++r) { const float qd = __builtin_amdgcn_exp2f(l2g * (float)(s * 32 + crow(r, hi) + 1));
#pragma unroll
            for (int d0e = 0; d0e < 4; ++d0e) o[d0e][r] *= qd; }
        __syncthreads();
#define RET_INTRA(KT) do { if ((KT) * 64 <= s * 32 + 31) { f32x16 p0, p1; bf16x8 pa0, pa1, pa2, pa3; \
        att::qkt<4, 128>(p0, p1, K_lds + (2 * c + (KT)) * TILE_K, r32, hi, qf); \
        const int di = s * 32 + r32 - (KT) * 64 - 4 * hi;            \
        _Pragma("unroll") for (int r = 0; r < 16; ++r) { const int d0_ = di - ((r & 3) + 8 * (r >> 2)), d1_ = d0_ - 32; \
            p0[r] = d0_ >= 0 ? p0[r] * __builtin_amdgcn_exp2f(l2g * (float)d0_) : 0.f; p1[r] = d1_ >= 0 ? p1[r] * __builtin_amdgcn_exp2f(l2g * (float)d1_) : 0.f; } \
        att::pack_p(p0, p1, pa0, pa1, pa2, pa3); __builtin_amdgcn_sched_barrier(0); \
        att::pv_tile<(KT)>(o, vb0, pa0, pa1, pa2, pa3); } } while (0)
        RET_INTRA(0); RET_INTRA(1);
#undef RET_INTRA
#pragma unroll
        for (int r = 0; r < 16; ++r) { float q = (o[0][r] * o[0][r] + o[1][r] * o[1][r]) + (o[2][r] * o[2][r] + o[3][r] * o[3][r]);
            q += __shfl_xor(q, 1); q += __shfl_xor(q, 2); q += __shfl_xor(q, 4); q += __shfl_xor(q, 8); q += __shfl_xor(q, 16);
            const float rs = rsqrtf(q * (1.f / RDV) + EPS);
#pragma unroll
            for (int d0e = 0; d0e < 4; ++d0e) o[d0e][r] *= rs; }
        __syncthreads();
        LAS unsigned char* OST = lds;
#pragma unroll
        for (int r = 0; r < 16; ++r) { const int lrow = c * 128 + s * 32 + crow(r, hi);
#pragma unroll
            for (int d0e = 0; d0e < 4; ++d0e) { const float v = o[d0e][r]; const float vn = __shfl_xor(v, 1);
                if ((r32 & 1) == 0) *(LAS unsigned*)(OST + lrow * OST_ROW + (d0e * 32 + r32) * 2) = cvtpk(v, vn); } }
        __syncthreads();
        { const int c16 = tid & 15; const f32x4 g0 = *(const f32x4*)(rgain + h * RDV + c16 * 8), g1 = *(const f32x4*)(rgain + h * RDV + c16 * 8 + 4);
          bf16x8 gv[8];
#pragma unroll
          for (int i = 0; i < 8; ++i) gv[i] = bload8(rsG, (((tid >> 4) + 32 * i) * 1024 + c16 * 8) * 2, (tok0 * 1024 + h * 128) * 2);
#pragma unroll
          for (int i = 0; i < 8; ++i) { const int row = (tid >> 4) + 32 * i;
              const bf16x8 ov = *(const LAS bf16x8*)(OST + row * OST_ROW + c16 * 16);
              v4u w; w.x = cvtpk(bf2f((bf16_t)ov[0]) * g0[0] * bf2f((bf16_t)gv[i][0]), bf2f((bf16_t)ov[1]) * g0[1] * bf2f((bf16_t)gv[i][1]));
              w.y = cvtpk(bf2f((bf16_t)ov[2]) * g0[2] * bf2f((bf16_t)gv[i][2]), bf2f((bf16_t)ov[3]) * g0[3] * bf2f((bf16_t)gv[i][3]));
              w.z = cvtpk(bf2f((bf16_t)ov[4]) * g1[0] * bf2f((bf16_t)gv[i][4]), bf2f((bf16_t)ov[5]) * g1[1] * bf2f((bf16_t)gv[i][5]));
              w.w = cvtpk(bf2f((bf16_t)ov[6]) * g1[2] * bf2f((bf16_t)gv[i][6]), bf2f((bf16_t)ov[7]) * g1[3] * bf2f((bf16_t)gv[i][7]));
              *(v4u*)(y + ((size_t)tok0 + row) * MIXW + h * RDV + c16 * 8) = w; } }
        __syncthreads();
    }
}
#undef RET_TRRD
}

struct MkArgs { Ptrs P; int ph_lo, ph_hi; };
constexpr int PH_P0A = 0, PH_P0B = 1, PH_L0 = 2, PH_PER_LAYER = 9, PH_FINAL = PH_L0 + DEPTH * PH_PER_LAYER, PH_COUNT = PH_FINAL + 1;
constexpr int PO_GU1 = 0, PO_DN1 = 1, PO_IN = 2, PO_UP = 3, PO_SCAN = 4, PO_ATT = 5, PO_OUT = 6, PO_GU2 = 7, PO_DN2 = 8;

typedef const __attribute__((address_space(4))) MkArgs* KArgP;
typedef const __attribute__((address_space(4))) Ptrs& PtrsRef;
__global__ void __launch_bounds__(NWAVES * 64, 2) mk_fwd(MkArgs args) {
    extern __shared__ __attribute__((aligned(16))) unsigned char lds_raw[];
    LAS unsigned char* lds = (LAS unsigned char*)lds_raw;
    const int G = gridDim.x, bx = blockIdx.x;
    const int vcu = (G % 8 == 0) ? (bx % 8) * (G / 8) + bx / 8 : bx;
    const int NGW = G * NWAVES;
    const KArgP kargs = (KArgP)__builtin_amdgcn_kernarg_segment_ptr();
    const int lo = args.ph_lo, hi = args.ph_hi;
    for (int u = threadIdx.x; u < (LDS_BYTES - LDSCTL_OFF) / 4; u += NWAVES * 64) ((LAS unsigned*)(lds + LDSCTL_OFF))[u] = 0u;
    __syncthreads();
    (void)xcd_barrier_post((unsigned*)(kargs->P.ws + WS_CTL) + CW_BAR, (volatile LAS unsigned*)(lds + MISC_OFF) + 8);
#define IN(k) (lo <= (k) && (k) < hi)
#define SEAM(k) do { if (IN(k) && IN((k) + 1)) { KArgP ap_ = kargs; asm volatile("" : "+s"(ap_)); XcdBarrier bar_; bar_.bar = (unsigned*)(ap_->P.ws + WS_CTL) + CW_BAR; bar_.x = xb_xcc_id(); \
        bar_.st = (volatile LAS unsigned*)(lds + MISC_OFF) + 8; xcd_barrier(bar_); } } while (0)
#define PH_LOCALS \
    int tid = threadIdx.x; asm volatile("" : "+v"(tid)); \
    const int lane = tid & 63, wave = __builtin_amdgcn_readfirstlane(tid >> 6), gw = vcu * NWAVES + wave; (void)lane; (void)gw; \
    KArgP ap = kargs; asm volatile("" : "+s"(ap)); int Gp = G, bxp = bx; asm volatile("" : "+s"(Gp), "+s"(bxp)); (void)Gp; (void)bxp; \
    PtrsRef P = ap->P; unsigned char* ws = P.ws; \
    float* mod = (float*)(ws + CT_MOD); float* ssx = (float*)(ws + CT_SS); float* biasb = (float*)(ws + CT_BIAS); \
    float* gatef = (float*)(ws + CT_GATE); float* gmt = (float*)(ws + CT_GM); \
    float* cosT = (float*)(ws + WS_COS); float* sinT = (float*)(ws + WS_SIN); \
    f16_t* xres = (f16_t*)(ws + WS_XRES); bf16_t* xg = (bf16_t*)(ws + WS_XG); bf16_t* act = (bf16_t*)(ws + WS_ACT); \
    (void)mod; (void)ssx; (void)biasb; (void)gatef; (void)gmt; (void)cosT; (void)sinT; (void)xres; (void)xg; (void)act
#define MIX_LOCALS \
    bf16_t *qr = (bf16_t*)(ws + WS_QR), *kr = (bf16_t*)(ws + WS_KR), *vr = (bf16_t*)(ws + WS_VR), *gr = (bf16_t*)(ws + WS_GR), *cq = (bf16_t*)(ws + WS_CQ), *ckv = (bf16_t*)(ws + WS_CKV); \
    bf16_t *Qb = (bf16_t*)(ws + WS_Q), *Kb = (bf16_t*)(ws + WS_K), *Vb = (bf16_t*)(ws + WS_V), *yb = (bf16_t*)(ws + WS_Y); \
    float* ssq = (float*)(ws + CT_SSQ) + (size_t)l * M; float* sskv = (float*)(ws + CT_SSKV) + (size_t)l * M; \
    (void)qr; (void)kr; (void)vr; (void)gr; (void)cq; (void)ckv; (void)Qb; (void)Kb; (void)Vb; (void)yb; (void)ssq; (void)sskv
#define LAYER_LOCALS \
    const float* mod_l = mod + (size_t)l * NB * NMOD * D; unsigned char* wt = ws + WS_WT + (size_t)l * WT_LAYER; (void)mod_l; (void)wt

    if (IN(PH_P0A)) {
        PH_LOCALS;
        LAS float* CA = (LAS float*)lds;
        LAS float* RED = (LAS float*)(lds + 32768);
        for (int i = tid; i < NB * D; i += NWAVES * 64) CA[i] = siluf(P.c[i]);
        __syncthreads();
        for (int u = vcu; u < 2 * 72 * 8; u += G) {
            const int l = u / 576, r = u % 576, strip = r >> 3, kc = r & 7;
            f32x4 a0 = {0, 0, 0, 0}, a1 = a0, a2 = a0, a3 = a0;
            const float* wp = P.w_ada + ((size_t)l * D + kc * 256 + wave * 32) * (NMOD * D) + strip * 256 + 4 * lane;
            const LAS float* cp = CA + kc * 256 + wave * 32;
#pragma unroll 16
            for (int i = 0; i < 32; ++i) { const f32x4 wv = *(const f32x4*)(wp + (size_t)i * (NMOD * D));
                a0 += wv * cp[i]; a1 += wv * cp[D + i]; a2 += wv * cp[2 * D + i]; a3 += wv * cp[3 * D + i]; }
            *(LAS f32x4*)(RED + (wave * 4 + 0) * 256 + 4 * lane) = a0; *(LAS f32x4*)(RED + (wave * 4 + 1) * 256 + 4 * lane) = a1;
            *(LAS f32x4*)(RED + (wave * 4 + 2) * 256 + 4 * lane) = a2; *(LAS f32x4*)(RED + (wave * 4 + 3) * 256 + 4 * lane) = a3;
            __syncthreads();
            for (int o = tid; o < 1024; o += NWAVES * 64) { const int b = o >> 8, j = o & 255; float s = 0.f;
#pragma unroll
                for (int w = 0; w < 8; ++w) s += RED[(w * 4 + b) * 256 + j];
                const int col = strip * 256 + j; if (kc == 0) s += P.b_ada[l * NMOD * D + col];
                __hip_atomic_fetch_add(mod + ((size_t)l * NB + b) * NMOD * D + col, s, __ATOMIC_RELAXED, __HIP_MEMORY_SCOPE_AGENT); }
            __syncthreads();
        }
        for (int i = vcu * NWAVES * 64 + tid; i < M * 32; i += G * NWAVES * 64) { const int m = i >> 5, f = i & 31;
            const float inv = (float)pow(10000.0, -(double)f / 32.0); const float ang = (float)P.pos[m] * inv;
            cosT[i] = (float)cos((double)ang); sinT[i] = (float)sin((double)ang); }
    }
    SEAM(PH_P0A);
    if (IN(PH_P0B)) {
        PH_LOCALS;
        for (int row = gw; row < M; row += NGW) { const int b = row / SEQ;
            const float* xr = P.x + (size_t)row * D; const float* gn = P.norm_ffn1; const float* scp = mod + (size_t)b * NMOD * D + D;
            float s = 0.f; f32x4 xv[8], gv[8];
#pragma unroll
            for (int j = 0; j < 8; ++j) { const int c = 4 * (lane + 64 * j); xv[j] = *(const f32x4*)(xr + c); gv[j] = *(const f32x4*)(gn + c) * (*(const f32x4*)(scp + c) + 1.f); }
#pragma unroll
            for (int j = 0; j < 8; ++j) { const int c = 4 * (lane + 64 * j); const f32x4 v = xv[j], o = v * gv[j];
                s += (v[0] * v[0] + v[1] * v[1]) + (v[2] * v[2] + v[3] * v[3]);
                v2u w; w.x = cvtpk(o[0], o[1]); w.y = cvtpk(o[2], o[3]); *(v2u*)(xg + (size_t)row * D + c) = w; }
            s = wave_sum(s); if (lane == 0) ssx[row] = s; }
        for (int i = vcu * NWAVES * 64 + tid; i < DEPTH * 3 * NB * D; i += G * NWAVES * 64) { const int c = i & 2047, b = (i >> 11) & 3, q = i >> 13, l = q / 3, s = q % 3;
            const float* ml = mod + ((size_t)l * NB + b) * NMOD * D; const float* gn = (s == 0 ? P.norm_ffn1 : s == 1 ? P.norm_mix : P.norm_ffn2) + (size_t)l * D;
            gatef[i] = (s == 1 ? 1.0f : 0.5f) * ml[(3 * s + 2) * D + c]; gmt[i] = gn[c] * (1.f + ml[(3 * s + 1) * D + c]); }
        LAS float* scr = (LAS float*)(lds + wave * 8448); LAS float* shs = (LAS float*)(lds + 8 * 8448 + wave * 1024);
        constexpr int IT_GU = (D / 64) * (NGU / 32), IT_DN = (FF / 64) * (D / 32), IT_IN = (D / 64) * (NPIN / 32), IT_UQ = (QRANK / 64) * (1536 / 32),
                      IT_UKV = (KVRANK / 64) * (2048 / 32), IT_OUT = (D / 64) * (D / 32), IT_LAYER = 2 * IT_GU + 2 * IT_DN + IT_IN + IT_UQ + IT_UKV + IT_OUT;
        auto decode = [&](int it) -> CvtDesc {
            const int l = it / IT_LAYER; int r = it % IT_LAYER;
            unsigned char* wt = ws + WS_WT + (size_t)l * WT_LAYER;
            const float* W; const float* sc = nullptr; bf16_t* WT; int K, ldw, NP, kind, sb = -1;
            if (r < IT_GU) { W = P.ffn1_w_gu + (size_t)l * D * NGU; WT = (bf16_t*)(wt + WT_GU1); K = D; ldw = NGU; NP = NGU; kind = 1; sb = 0; }
            else if ((r -= IT_GU) < IT_DN) { W = P.ffn1_w_down + (size_t)l * FF * D; WT = (bf16_t*)(wt + WT_DN1); K = FF; ldw = D; NP = D; kind = 0; }
            else if ((r -= IT_DN) < IT_IN) { W = P.w_in + (size_t)l * D * INCOLS; WT = (bf16_t*)(wt + WT_IN); K = D; ldw = INCOLS; NP = NPIN; kind = 2; sb = 1; }
            else if ((r -= IT_IN) < IT_UQ) { W = P.w_uq + (size_t)l * QRANK * MH * DQK; sc = P.q_norm_g + (size_t)l * QRANK; WT = (bf16_t*)(wt + WT_UQ); K = QRANK; ldw = MH * DQK; NP = 1536; kind = 3; }
            else if ((r -= IT_UQ) < IT_UKV) { W = P.w_ukv + (size_t)l * KVRANK * 2048; sc = P.kv_norm_g + (size_t)l * KVRANK; WT = (bf16_t*)(wt + WT_UKV); K = KVRANK; ldw = 2048; NP = 2048; kind = 0; }
            else if ((r -= IT_UKV) < IT_OUT) { W = P.w_out + (size_t)l * MIXW * D; WT = (bf16_t*)(wt + WT_OUT); K = MIXW; ldw = D; NP = D; kind = 0; }
            else if ((r -= IT_OUT) < IT_GU) { W = P.ffn2_w_gu + (size_t)l * D * NGU; WT = (bf16_t*)(wt + WT_GU2); K = D; ldw = NGU; NP = NGU; kind = 1; sb = 2; }
            else { r -= IT_GU; W = P.ffn2_w_down + (size_t)l * FF * D; WT = (bf16_t*)(wt + WT_DN2); K = FF; ldw = D; NP = D; kind = 0; }
            const int nblk = NP / 32, kb = r / nblk, nb = r % nblk;
            CvtDesc d; d.W = W; d.scale = sc; d.WT = WT; d.sh = sb >= 0 ? mod + (size_t)l * NB * NMOD * D + (size_t)(3 * sb) * D : nullptr;
            d.bias = biasb + (size_t)(3 * l + (sb < 0 ? 0 : sb)) * NB * NGU; d.ldw = ldw; d.K = K; d.k0 = 64 * kb; d.src0 = src_block(kind, nb); d.dst0 = 32 * nb; return d; };
        {
            int it = gw;
            if (it < DEPTH * IT_LAYER) {
                CvtDesc cur = decode(it); f32x4 v[8]; cvt_load(cur, v, lane);
                for (;;) {
                    const int itn = it + NGW; const bool more = itn < DEPTH * IT_LAYER;
                    CvtDesc nxt = cur; f32x4 vn[8];
                    if (more) { nxt = decode(itn); cvt_load(nxt, vn, lane); }
                    cvt_process(cur, v, scr, shs, lane);
                    if (!more) break;
                    cur = nxt; it = itn;
#pragma unroll
                    for (int i = 0; i < 8; ++i) v[i] = vn[i];
                }
            }
        }
    }
    SEAM(PH_P0B);
    for (int l = 0; l < DEPTH; ++l) {
        const int pb = PH_L0 + l * PH_PER_LAYER;
        for (int s = 0; s < 3; s += 2) {
            const int p_gu = pb + (s == 0 ? PO_GU1 : PO_GU2), p_dn = p_gu + 1;
            if (IN(p_gu)) {
                PH_LOCALS; LAYER_LOCALS;
                pg8::Gemm g{xg, (const bf16_t*)(wt + (s == 0 ? WT_GU1 : WT_GU2)), M, NGU, D}; pg8::StaticOrder S; S.init(M, NGU, Gp, bxp);
                EpiGU E{act, ssx + (size_t)(3 * l + s) * M, biasb + (size_t)(3 * l + s) * NB * NGU};
                pg8::gemm_phase<EpiGU, pg8::StaticOrder, true, true>(lds, g, S, E);
            }
            SEAM(p_gu);
            if (IN(p_dn)) {
                PH_LOCALS; LAYER_LOCALS;
                pg8::Gemm g{act, (const bf16_t*)(wt + (s == 0 ? WT_DN1 : WT_DN2)), M, D, FF}; pg8::StaticOrder S; S.init(M, D, Gp, bxp);
                const int last = (l == DEPTH - 1 && s == 2);
                const int qn = 3 * l + s + 1;
                if (l == 0 && s == 0) { EpiRes<true> E{P.x, nullptr, xres, xg, ssx + (size_t)qn * M, gatef + (size_t)(3 * l + s) * NB * D, gmt + (size_t)qn * NB * D, 1, 0};
                    pg8::gemm_phase<EpiRes<true>, pg8::StaticOrder, true, true>(lds, g, S, E); }
                else { EpiRes<false> E{nullptr, xres, xres, xg, ssx + (size_t)qn * M, gatef + (size_t)(3 * l + s) * NB * D, gmt + (size_t)(last ? 0 : qn) * NB * D, last ? 0 : 1, 0};
                    pg8::gemm_phase<EpiRes<false>, pg8::StaticOrder, true, true>(lds, g, S, E); }
            }
            SEAM(p_dn);
            if (s == 0) {
                if (IN(pb + PO_IN)) {
                    PH_LOCALS; LAYER_LOCALS; MIX_LOCALS;
                    pg8::Gemm g{xg, (const bf16_t*)(wt + WT_IN), M, NPIN, D}; pg8::StaticOrder S; S.init(M, NPIN, Gp, bxp);
                    EpiIn E{ssx + (size_t)(3 * l + 1) * M, biasb + (size_t)(3 * l + 1) * NB * NGU, cosT, sinT, qr, kr, vr, gr, cq, ckv, Kb, ssq, sskv};
                    pg8::gemm_phase<EpiIn, pg8::StaticOrder, true, true>(lds, g, S, E);
                }
                SEAM(pb + PO_IN);
                if (IN(pb + PO_UP)) {
                    PH_LOCALS; LAYER_LOCALS; MIX_LOCALS;
                    {
                    { pg8::Gemm g{cq, (const bf16_t*)(wt + WT_UQ), M, 1536, QRANK}; pg8::StaticOrder S; S.init(M, 1536, Gp, bxp);
                      EpiUq E{ssq, cosT, sinT, Qb};
                      pg8::gemm_phase<EpiUq, pg8::StaticOrder, true, true>(lds, g, S, E); }
                    { pg8::Gemm g{ckv, (const bf16_t*)(wt + WT_UKV), M, 2048, KVRANK}; pg8::StaticOrder S; S.init(M, 2048, Gp, bxp);
                      EpiUkv E{sskv, Kb, Vb};
                      pg8::gemm_phase<EpiUkv, pg8::StaticOrder, true, true>(lds, g, S, E); }
                    ret::inc_phase(lds, kr, vr, (float*)(ws + WS_INC), Gp, bxp);
                    }
                }
                SEAM(pb + PO_UP);
                if (IN(pb + PO_SCAN)) {
                    PH_LOCALS; LAYER_LOCALS; MIX_LOCALS;
                    ret::scan_phase((const float*)(ws + WS_INC), (bf16_t*)(ws + WS_PREVT), G, vcu);
                }
                SEAM(pb + PO_SCAN);
                if (IN(pb + PO_ATT)) {
                    PH_LOCALS; LAYER_LOCALS; MIX_LOCALS;
                    att::attn_phase(lds, Qb, Kb, Vb, yb, Gp, bxp, 0);
                    ret::out_phase(lds, qr, kr, vr, gr, (const bf16_t*)(ws + WS_PREVT), P.ret_norm_g + (size_t)l * RETW, yb, Gp, bxp);
                }
                SEAM(pb + PO_ATT);
                if (IN(pb + PO_OUT)) {
                    PH_LOCALS; LAYER_LOCALS; MIX_LOCALS;
                    pg8::Gemm g{yb, (const bf16_t*)(wt + WT_OUT), M, D, MIXW}; pg8::StaticOrder S; S.init(M, D, Gp, bxp);
                    EpiRes<false> E{nullptr, xres, xres, xg, ssx + (size_t)(3 * l + 2) * M, gatef + (size_t)(3 * l + 1) * NB * D, gmt + (size_t)(3 * l + 2) * NB * D, 1, 0};
                    pg8::gemm_phase<EpiRes<false>, pg8::StaticOrder, true, true>(lds, g, S, E);
                }
                SEAM(pb + PO_OUT);
            }
        }
    }
    if (IN(PH_FINAL)) {
        PH_LOCALS;
        const float* ssf = ssx + (size_t)6 * M;
        for (int row = gw; row < M; row += NGW) { const float rs = rsqrtf(ssf[row] * (1.f / D) + EPS);
            f16x8 hv[4];
#pragma unroll
            for (int j = 0; j < 4; ++j) hv[j] = *(const f16x8*)(xres + (size_t)row * D + 8 * (lane + 64 * j));
#pragma unroll
            for (int j = 0; j < 4; ++j) { const int c = 8 * (lane + 64 * j); const f16x8 h = hv[j];
                const f32x4 g0 = *(const f32x4*)(P.final_norm + c), g1 = *(const f32x4*)(P.final_norm + c + 4);
                *(f32x4*)(P.out + (size_t)row * D + c) = (f32x4){(float)h[0], (float)h[1], (float)h[2], (float)h[3]} * rs * g0;
                *(f32x4*)(P.out + (size_t)row * D + c + 4) = (f32x4){(float)h[4], (float)h[5], (float)h[6], (float)h[7]} * rs * g1; } }
    }
#undef IN
#undef SEAM
#undef PH_LOCALS
#undef LAYER_LOCALS
#undef MIX_LOCALS
}

static int g_grid = 0;
static void mk(hipStream_t st, const Ptrs& P, int lo, int hi) {
    MkArgs a{}; a.P = P; a.ph_lo = lo; a.ph_hi = hi;
    hipLaunchKernelGGL(mk_fwd, dim3(g_grid), dim3(NWAVES * 64), LDS_BYTES, st, a);
}

extern "C" void kernel_launch(void* const* d_in, const int* in_sizes, int n_in, void* d_out, int out_size, void* d_ws, size_t ws_size, hipStream_t stream) {
    if (n_in != 20 || ws_size < WS_END) { fprintf(stderr, "kernel_launch: bad args n_in %d ws %zu need %zu\n", n_in, ws_size, (size_t)WS_END); return; }
    if (g_grid == 0) {
        int dev = 0, cus = 0;
        if (hipGetDevice(&dev) != hipSuccess || hipDeviceGetAttribute(&cus, hipDeviceAttributeMultiprocessorCount, dev) != hipSuccess || cus <= 0) { g_grid = -1; return; }
        if (hipFuncSetAttribute((const void*)mk_fwd, hipFuncAttributeMaxDynamicSharedMemorySize, LDS_BYTES) != hipSuccess) { fprintf(stderr, "hipFuncSetAttribute failed\n"); g_grid = -1; return; }
        g_grid = cus;
    }
    if (g_grid < 0) return;
    Ptrs P{};
    P.x = (const float*)d_in[0]; P.c = (const float*)d_in[1]; P.pos = (const int*)d_in[2]; P.w_ada = (const float*)d_in[3]; P.b_ada = (const float*)d_in[4];
    P.norm_ffn1 = (const float*)d_in[5]; P.ffn1_w_gu = (const float*)d_in[6]; P.ffn1_w_down = (const float*)d_in[7]; P.norm_mix = (const float*)d_in[8];
    P.w_in = (const float*)d_in[9]; P.ret_norm_g = (const float*)d_in[10]; P.q_norm_g = (const float*)d_in[11]; P.w_uq = (const float*)d_in[12];
    P.kv_norm_g = (const float*)d_in[13]; P.w_ukv = (const float*)d_in[14]; P.w_out = (const float*)d_in[15]; P.norm_ffn2 = (const float*)d_in[16];
    P.ffn2_w_gu = (const float*)d_in[17]; P.ffn2_w_down = (const float*)d_in[18]; P.final_norm = (const float*)d_in[19];
    P.out = (float*)d_out; P.ws = (unsigned char*)d_ws;
    unsigned char* ws = P.ws;
    (void)hipMemsetAsync(ws + WS_CTL, 0, CTL_BYTES, stream);
    mk(stream, P, 0, PH_COUNT);
}
```

```cpp
#include <hip/hip_runtime.h>
#include <cstdio>
#include <cstdint>
#include <cmath>

constexpr int D = 2048, NB = 4, SEQ = 4096, DEPTH = 2, M = NB * SEQ;
constexpr int RH = 8, RDK = 64, RDV = 128, RCH = 128;
constexpr int MH = 8, QRANK = 512, KVRANK = 256, NOPE = 128, ROPE = 64, MDV = 128, DQK = NOPE + ROPE;
constexpr int RETW = RH * RDV, MLAW = MH * MDV, MIXW = RETW + MLAW;
constexpr int INCOLS = 2 * RH * RDK + 2 * RETW + QRANK + KVRANK + ROPE;
constexpr int FF = 5632, NGU = 2 * FF;
constexpr int NMOD = 9;
constexpr float EPS = 1e-6f;
constexpr int C_QR = 0, C_KR = 512, C_VR = 1024, C_GR = 2048, C_CQ = 3072, C_CKV = 3584, C_KPE = 3840;

typedef unsigned short bf16_t;
typedef short bf16x8 __attribute__((ext_vector_type(8)));
typedef float f32x4 __attribute__((ext_vector_type(4)));

constexpr size_t MiB = 1u << 20;
constexpr size_t WS_CTL = 0, CTL_BYTES = 4 * MiB;
constexpr size_t CT_SS = 64 * 1024;
constexpr size_t CT_SSQ = CT_SS + 7 * (size_t)M * 4;
constexpr size_t CT_SSKV = CT_SSQ + 2 * (size_t)M * 4;
constexpr size_t CT_MOD = CT_SSKV + 2 * (size_t)M * 4;
constexpr size_t CT_END = CT_MOD + (size_t)DEPTH * NB * NMOD * D * 4;
static_assert(CT_END <= CTL_BYTES, "ctl");
constexpr size_t WS_COS = 4 * MiB, WS_SIN = 6 * MiB;
constexpr size_t WS_XRES = 8 * MiB;
constexpr size_t WS_XG = WS_XRES + (size_t)M * D * 4;
constexpr size_t WS_Y = WS_XG + (size_t)M * D * 2;
constexpr size_t WS_H = WS_Y;
constexpr size_t WS_INC = WS_Y + (size_t)M * MIXW * 2;
constexpr size_t WS_PREVT = WS_INC + (size_t)NB * RH * 32 * 64 * 128 * 4;
constexpr size_t WS_CQF = WS_INC;
constexpr size_t WS_CKVF = WS_PREVT;
constexpr size_t WS_MIX = WS_PREVT + (size_t)NB * RH * 32 * 64 * 128 * 2;
constexpr size_t WS_QR = WS_MIX;
constexpr size_t WS_KR = WS_QR + (size_t)M * 512 * 2;
constexpr size_t WS_VR = WS_KR + (size_t)M * 512 * 2;
constexpr size_t WS_GR = WS_VR + (size_t)M * 1024 * 2;
constexpr size_t WS_CQ = WS_GR + (size_t)M * 1024 * 2;
constexpr size_t WS_CKV = WS_CQ + (size_t)M * 512 * 2;
constexpr size_t WS_Q = WS_CKV + (size_t)M * 256 * 2;
constexpr size_t WS_K = WS_Q + (size_t)M * MH * DQK * 2;
constexpr size_t WS_V = WS_K + (size_t)M * MH * DQK * 2;
constexpr size_t WS_MIX_END = WS_V + (size_t)M * MH * MDV * 2;
constexpr size_t WS_WT = WS_MIX_END;
constexpr size_t WS_ACT = WS_WT + 340 * MiB;
constexpr size_t WS_END = WS_ACT + (size_t)M * FF * 2;

__device__ __forceinline__ bf16_t f2bf(float f) { unsigned u = __float_as_uint(f); u += 0x7fffu + ((u >> 16) & 1u); return (bf16_t)(u >> 16); }
__device__ __forceinline__ float bf2f(bf16_t b) { return __uint_as_float(((unsigned)b) << 16); }
__device__ __forceinline__ float siluf(float x) { return x / (1.f + __expf(-x)); }
__device__ __forceinline__ float wave_sum(float v) {
#pragma unroll
    for (int o = 1; o < 64; o <<= 1) v += __shfl_xor(v, o);
    return v;
}

struct Ptrs {
    const float *x, *c; const int* pos; const float *w_ada, *b_ada, *norm_ffn1, *ffn1_w_gu, *ffn1_w_down, *norm_mix, *w_in, *ret_norm_g, *q_norm_g, *w_uq,
        *kv_norm_g, *w_ukv, *w_out, *norm_ffn2, *ffn2_w_gu, *ffn2_w_down, *final_norm;
    float* out; unsigned char* ws;
};

namespace pg8 {
#define PG8_LAS __attribute__((address_space(3)))
typedef unsigned short bf16_t;
typedef short bf16x8 __attribute__((ext_vector_type(8)));
typedef float f32x4 __attribute__((ext_vector_type(4)));
typedef unsigned u32x4 __attribute__((ext_vector_type(4)));
constexpr int BM = 256, BK = 64, HALF = 128, HTB = HALF * BK * 2  , STAGE_BYTES = 8 * HTB, NXCD = 8, WGM = 8;

__host__ __device__ __forceinline__ int lds_byte(int r, int c) { const int st = (r >> 4) * 2 + (c >> 5), rr = r & 15, cc = c & 31, ob = rr * 64 + cc * 2; return st * 1024 + (ob ^ (((ob >> 9) & 1) << 5)); }
__host__ __device__ __forceinline__ void stage_rc(int b, int& R, int& C) { const int st = b / 1024, sb = b % 1024, swz = sb ^ (((sb >> 9) & 1) << 5); R = (st >> 1) * 16 + swz / 64; C = (st & 1) * 32 + (swz % 64) / 2; }
__host__ __device__ __forceinline__ int perm32(int rho) { const int n = rho >> 4, i = rho & 15; return 8 * (i >> 2) + 4 * n + (i & 3); }

struct Unit { int pm, pn; };
struct Gemm { const bf16_t* A; const bf16_t* Bt; int M, N, K; };

struct StaticOrder {
    int nM, nN, nwg, G, c;
    __host__ __device__ void init(int M, int N, int G_, int c_) { nM = M / BM; nN = N / BM; nwg = nM * nN; G = G_; c = c_; }
    __host__ __device__ bool next(int i, Unit& u) const {
        const long L = (long)i * G + c; if (L >= nwg) return false;
        int wgid = (int)L; { const int q = nwg / NXCD, r = nwg % NXCD, xcd = wgid % NXCD, off = wgid / NXCD; wgid = (xcd < r ? xcd * (q + 1) : r * (q + 1) + (xcd - r) * q) + off; }
        const int nig = WGM * nN, gid = wgid / nig, fm = gid * WGM, gsz = (nM - fm) < WGM ? (nM - fm) : WGM;
        u.pm = fm + ((wgid % nig) % gsz); u.pn = (wgid % nig) / gsz; return true;
    }
    __device__ __forceinline__ void a_ready(const Unit&) const {}
    __device__ __forceinline__ void done(const Unit&) const {}
};

template <class Epi, class Sched, bool ALIGN_EPI = false, bool SP2 = false>
__device__ __forceinline__ void gemm_phase(PG8_LAS unsigned char* lds, const Gemm g, const Sched& S, const Epi& E) {
    int tid_ = threadIdx.x; asm volatile("" : "+v"(tid_));
    const int tid = tid_, wid = __builtin_amdgcn_readfirstlane(tid >> 6), lane = tid & 63, wr = wid >> 2, wc = wid & 3, fr = lane & 15, fq = lane >> 4;
    const int K = g.K, nt = K / BK;
    unsigned voffA[2], voffB[2];
#pragma unroll
    for (int i = 0; i < 2; ++i) { int R, C; stage_rc(tid * 16 + i * 8192, R, C); const int Rb = Epi::PERM ? ((R & ~31) + perm32(R & 31)) : R;
        voffA[i] = (unsigned)(R * K + C) * 2u; voffB[i] = (unsigned)(Rb * K + C) * 2u; }
    const unsigned kstep = (unsigned)(BK * 2);
    const unsigned hstep = (unsigned)HALF * K * 2;
    const unsigned tstep = 2 * hstep;
    const __amdgpu_buffer_rsrc_t rsA = __builtin_amdgcn_make_buffer_rsrc((void*)g.A, (short)0, (int)((size_t)g.M * K * 2), 0x00020000), rsB = __builtin_amdgcn_make_buffer_rsrc((void*)g.Bt, (short)0, (int)((size_t)g.N * K * 2), 0x00020000);
    const unsigned ldsw = (unsigned)wid * 1024u;
    const int aoff = lds_byte(wr * 64 + fr, fq * 8), boff = lds_byte(wc * 32 + fr, fq * 8);
#define PG8_SA(b, h) (((b) * 2 + (h)) * HTB)
#define PG8_SB(b, h) ((4 + (b) * 2 + (h)) * HTB)
#define PG8_STAGE_(rs, bufoff, gbase, voff) do { _Pragma("unroll") for (int _i = 0; _i < 2; ++_i) \
        __builtin_amdgcn_raw_ptr_buffer_load_lds(rs, (PG8_LAS void*)(lds + (bufoff) + ldsw + _i * 8192), 16, (int)(voff)[_i], (int)(gbase), 0, 0); } while (0)
#define PG8_STAGE(bufoff, gbase, voff) PG8_STAGE_##voff(bufoff, gbase)
#define PG8_STAGE_voffA(bufoff, gbase) PG8_STAGE_(rsA, bufoff, gbase, voffA)
#define PG8_STAGE_voffB(bufoff, gbase) PG8_STAGE_(rsB, bufoff, gbase, voffB)
#define PG8_LDA(dst, b, h) do { _Pragma("unroll") for (int m = 0; m < 4; ++m) _Pragma("unroll") for (int k = 0; k < 2; ++k) dst[m][k] = *(const PG8_LAS bf16x8*)(lds + PG8_SA(b, h) + aoff + m * 2048 + k * 1024); } while (0)
#define PG8_LDB(dst, b, h) do { _Pragma("unroll") for (int n = 0; n < 2; ++n) _Pragma("unroll") for (int k = 0; k < 2; ++k) dst[n][k] = *(const PG8_LAS bf16x8*)(lds + PG8_SB(b, h) + boff + n * 2048 + k * 1024); } while (0)
#define PG8_MMA(ai, bj, At, Bt) do { __builtin_amdgcn_s_setprio(1); _Pragma("unroll") for (int m = 0; m < 4; ++m) _Pragma("unroll") for (int n = 0; n < 2; ++n) _Pragma("unroll") for (int k = 0; k < 2; ++k) \
        acc[ai][bj][m][n] = __builtin_amdgcn_mfma_f32_16x16x32_bf16(Bt[n][k], At[m][k], acc[ai][bj][m][n], 0, 0, 0); __builtin_amdgcn_s_setprio(0); } while (0)
#define PG8_WAIT_V(n) asm volatile("s_waitcnt vmcnt(" #n ")" ::: "memory")
#define PG8_WAIT_L(n) asm volatile("s_waitcnt lgkmcnt(" #n ")" ::: "memory")
#define PG8_BAR __builtin_amdgcn_s_barrier()
#define PG8_SCHED __builtin_amdgcn_sched_barrier(0)
    Unit cur, nxt; int ui = 0;
    if (!S.next(0, cur)) return;
    f32x4 acc[2][2][4][2];
#pragma unroll
    for (int a = 0; a < 2; ++a)
#pragma unroll
        for (int b = 0; b < 2; ++b)
#pragma unroll
            for (int m = 0; m < 4; ++m)
#pragma unroll
                for (int n = 0; n < 2; ++n) acc[a][b][m][n] = (f32x4){0.f, 0.f, 0.f, 0.f};
    bf16x8 At[4][2], B0[2][2], B1[2][2];
    unsigned cA = (unsigned)cur.pm * tstep, cB = (unsigned)cur.pn * tstep;
    S.a_ready(cur);
    if constexpr (SP2) {
        PG8_STAGE(PG8_SB(0, 0), cB, voffB); PG8_STAGE(PG8_SB(0, 1), cB + hstep, voffB); PG8_STAGE(PG8_SA(0, 0), cA, voffA); PG8_STAGE(PG8_SA(0, 1), cA + hstep, voffA);
        if (wr == 1) PG8_BAR;
        PG8_WAIT_V(2); PG8_BAR;
        PG8_STAGE(PG8_SB(1, 0), cB + kstep, voffB); PG8_STAGE(PG8_SA(1, 0), cA + kstep, voffA); PG8_STAGE(PG8_SB(1, 1), cB + hstep + kstep, voffB);
        PG8_WAIT_V(6); PG8_BAR;
    } else {
        PG8_STAGE(PG8_SB(0, 0), cB, voffB); PG8_STAGE(PG8_SA(0, 0), cA, voffA); PG8_STAGE(PG8_SB(0, 1), cB + hstep, voffB); PG8_STAGE(PG8_SA(0, 1), cA + hstep, voffA);
        if (wr == 1) PG8_BAR;
        PG8_WAIT_V(4); PG8_BAR;
        PG8_STAGE(PG8_SB(1, 0), cB + kstep, voffB); PG8_STAGE(PG8_SA(1, 0), cA + kstep, voffA); PG8_STAGE(PG8_SB(1, 1), cB + hstep + kstep, voffB);
        PG8_WAIT_V(6); PG8_BAR;
    }
    for (;;) {
        const bool has_next = S.next(ui + 1, nxt);
        const unsigned nA = has_next ? (unsigned)nxt.pm * tstep : cA, nB = has_next ? (unsigned)nxt.pn * tstep : cB;
        for (int t = 0; t < nt; t += 2) {
            const bool last = (t == nt - 2);
            const unsigned a1 = cA + (unsigned)(t + 1) * kstep;
            const unsigned a2 = last ? nA : cA + (unsigned)(t + 2) * kstep, b2 = last ? nB : cB + (unsigned)(t + 2) * kstep;
            const unsigned a3 = a2 + kstep, b3 = b2 + kstep;
            if (last && has_next) S.a_ready(nxt);
            if constexpr (SP2) {
            PG8_LDB(B0, 0, 0); PG8_LDB(B1, 0, 1); PG8_SCHED; PG8_LDA(At, 0, 0); PG8_STAGE(PG8_SA(1, 1), a1 + hstep, voffA);
            PG8_WAIT_V(8); PG8_WAIT_L(0); PG8_BAR; PG8_MMA(0, 0, At, B0); PG8_MMA(0, 1, At, B1); PG8_BAR; PG8_SCHED;
            PG8_LDA(At, 0, 1); PG8_STAGE(PG8_SB(0, 0), b2, voffB); PG8_STAGE(PG8_SB(0, 1), b2 + hstep, voffB); PG8_STAGE(PG8_SA(0, 0), a2, voffA);
            PG8_WAIT_V(8); PG8_WAIT_L(0); PG8_BAR; PG8_MMA(1, 0, At, B0); PG8_MMA(1, 1, At, B1); PG8_BAR; PG8_SCHED;
            PG8_LDB(B0, 1, 0); PG8_LDB(B1, 1, 1); PG8_SCHED; PG8_LDA(At, 1, 0); PG8_STAGE(PG8_SA(0, 1), a2 + hstep, voffA);
            PG8_WAIT_V(8); PG8_WAIT_L(0); PG8_BAR; PG8_MMA(0, 0, At, B0); PG8_MMA(0, 1, At, B1); PG8_BAR; PG8_SCHED;
            PG8_LDA(At, 1, 1); PG8_STAGE(PG8_SB(1, 0), b3, voffB); PG8_STAGE(PG8_SB(1, 1), b3 + hstep, voffB); PG8_STAGE(PG8_SA(1, 0), a3, voffA);
            PG8_WAIT_V(8); PG8_WAIT_L(0); PG8_BAR; PG8_MMA(1, 0, At, B0); PG8_MMA(1, 1, At, B1); PG8_BAR; PG8_SCHED;
            } else {
            PG8_LDB(B0, 0, 0); PG8_SCHED; PG8_LDA(At, 0, 0); PG8_STAGE(PG8_SA(1, 1), a1 + hstep, voffA);
            PG8_WAIT_L(8); PG8_BAR; PG8_WAIT_L(0); PG8_MMA(0, 0, At, B0); PG8_BAR; PG8_SCHED;
            PG8_LDB(B1, 0, 1); PG8_STAGE(PG8_SB(0, 0), b2, voffB);
            PG8_BAR; PG8_WAIT_L(0); PG8_MMA(0, 1, At, B1); PG8_BAR;
            PG8_LDA(At, 0, 1); PG8_STAGE(PG8_SA(0, 0), a2, voffA);
            PG8_BAR; PG8_WAIT_L(0); PG8_MMA(1, 0, At, B0); PG8_BAR; PG8_SCHED;
            PG8_STAGE(PG8_SB(0, 1), b2 + hstep, voffB);
            PG8_WAIT_V(6); PG8_BAR; PG8_MMA(1, 1, At, B1); PG8_BAR;
            PG8_LDB(B0, 1, 0); PG8_SCHED; PG8_LDA(At, 1, 0); PG8_STAGE(PG8_SA(0, 1), a2 + hstep, voffA);
            PG8_WAIT_L(8); PG8_BAR; PG8_WAIT_L(0); PG8_MMA(0, 0, At, B0); PG8_BAR; PG8_SCHED;
            PG8_LDB(B1, 1, 1); PG8_STAGE(PG8_SB(1, 0), b3, voffB);
            PG8_BAR; PG8_WAIT_L(0); PG8_MMA(0, 1, At, B1); PG8_BAR;
            PG8_LDA(At, 1, 1); PG8_STAGE(PG8_SA(1, 0), a3, voffA);
            PG8_BAR; PG8_WAIT_L(0); PG8_MMA(1, 0, At, B0); PG8_BAR; PG8_SCHED;
            PG8_STAGE(PG8_SB(1, 1), b3 + hstep, voffB);
            PG8_WAIT_V(6); PG8_BAR; PG8_MMA(1, 1, At, B1); PG8_BAR;
            }
        }
        if constexpr (ALIGN_EPI) { if (wr == 0) PG8_BAR; }
        if constexpr (!Epi::AFTER_DRAIN) { E(acc, cur, wr, wc, fr, fq); S.done(cur); }
        if (!has_next) break;
#pragma unroll
        for (int a = 0; a < 2; ++a)
#pragma unroll
            for (int b = 0; b < 2; ++b)
#pragma unroll
                for (int m = 0; m < 4; ++m)
#pragma unroll
                    for (int n = 0; n < 2; ++n) acc[a][b][m][n] = (f32x4){0.f, 0.f, 0.f, 0.f};
        cur = nxt; cA = nA; cB = nB; ++ui;
        if constexpr (ALIGN_EPI) { if (wr == 1) PG8_BAR; }
    }
    PG8_WAIT_V(0);
    if constexpr (!ALIGN_EPI) { if (wr == 0) PG8_BAR; }
    PG8_BAR;
    if constexpr (Epi::AFTER_DRAIN) { E.fused(acc, cur, wr, wc, fr, fq, lds, wid, lane); S.done(cur); }
#undef PG8_SA
#undef PG8_SB
#undef PG8_STAGE
#undef PG8_STAGE_
#undef PG8_STAGE_voffA
#undef PG8_STAGE_voffB
#undef PG8_LDA
#undef PG8_LDB
#undef PG8_MMA
#undef PG8_WAIT_V
#undef PG8_WAIT_L
#undef PG8_BAR
#undef PG8_SCHED
}
}

#define GAS __attribute__((address_space(1)))
#define LAS __attribute__((address_space(3)))
#define XB_TMO      128
#define XB_XCNT(j)  (256  + 64 * (j))
#define XB_XSUB(j)  (1280 + 64 * (j))
#define XB_XGEN(j)  (2304 + 64 * (j))
#define XB_TOP      3328
#define XB_TOPGEN   3392
#define XCD_BAR_WORDS 3456
#define XB_SPIN_CAP (1u << 18)

__device__ __forceinline__ unsigned xb_ld(unsigned* p)              { return __hip_atomic_load(p, __ATOMIC_RELAXED, __HIP_MEMORY_SCOPE_AGENT); }
__device__ __forceinline__ unsigned xb_add(unsigned* p, unsigned v) { return __hip_atomic_fetch_add(p, v, __ATOMIC_RELAXED, __HIP_MEMORY_SCOPE_AGENT); }
__device__ __forceinline__ unsigned xb_xcc_id() { return (unsigned)__builtin_amdgcn_s_getreg((3 << 11) | 20) & 0xFu; }
#define XB_SPIN(cond, bar) do { unsigned _sp = 0; while (cond) { __builtin_amdgcn_s_sleep(1); \
    if ((++_sp & 255u) == 0u) { if (xb_ld(&(bar)[XB_TMO])) break; if (_sp > XB_SPIN_CAP) { atomicAdd(&(bar)[XB_TMO], 1u); break; } } } } while (0)

struct XcdBarrier {
    unsigned n;
    unsigned* bar; unsigned x;
    volatile LAS unsigned* st;
};

__device__ __forceinline__ XcdBarrier xcd_barrier_post(unsigned* bar, volatile LAS unsigned* st, unsigned n) {
    XcdBarrier b; b.n = n; b.bar = bar; b.x = xb_xcc_id(); b.st = st;
    if (threadIdx.x == 0) (void)xb_add(&bar[XB_XCNT(b.x)], 1u);
    return b;
}
__device__ __forceinline__ void xcd_barrier_complete(unsigned* bar, unsigned x, unsigned G, unsigned& nloc, unsigned& nx) {
    unsigned sum, cnt, mine, sp = 0u;
    for (;;) {
        sum = 0u; cnt = 0u; mine = 0u;
#pragma unroll
        for (unsigned j = 0; j < 16; ++j) { const unsigned c = xb_ld(&bar[XB_XCNT(j)]); sum += c; cnt += (c > 0u) ? 1u : 0u; mine = (j == x) ? c : mine; }
        if (sum == G) break;
        __builtin_amdgcn_s_sleep(1);
        if ((++sp & 255u) == 0u) { if (xb_ld(&bar[XB_TMO])) break; if (sp > XB_SPIN_CAP) { atomicAdd(&bar[XB_TMO], 1u); break; } }
    }
    nloc = mine > 0u ? mine : 1u; nx = cnt > 0u ? cnt : 1u;
}

__device__ __forceinline__ void xcd_barrier(const XcdBarrier& b) {
    asm volatile("s_waitcnt vmcnt(0)" ::: "memory");
    __syncthreads();
    if (threadIdx.x == 0) {
        unsigned* bar = b.bar;
        __builtin_amdgcn_s_waitcnt(0);
        unsigned nloc = b.st[0], nx = b.st[1];
        if (nloc == 0u) { xcd_barrier_complete(bar, b.x, b.n, nloc, nx); b.st[0] = nloc; b.st[1] = nx; }
        const unsigned old = xb_add(&bar[XB_XSUB(b.x)], 1u);
        const unsigned gen = old / nloc;
        if (old + 1u == (gen + 1u) * nloc) {
            __builtin_amdgcn_fence(__ATOMIC_RELEASE, "agent");
            asm volatile("s_waitcnt vmcnt(0)" ::: "memory");
            const unsigned og = xb_add(&bar[XB_TOP], 1u);
            const unsigned tg = og / nx;
            if (og + 1u == (tg + 1u) * nx) xb_add(&bar[XB_TOPGEN], 1u);
            else XB_SPIN(xb_ld(&bar[XB_TOPGEN]) == tg, bar);
            __builtin_amdgcn_fence(__ATOMIC_ACQUIRE, "agent");
            xb_add(&bar[XB_XGEN(b.x)], 1u);
            asm volatile("s_waitcnt vmcnt(0)" ::: "memory");
        } else {
            XB_SPIN(xb_ld(&bar[XB_XGEN(b.x)]) == gen, bar);
            __builtin_amdgcn_fence(__ATOMIC_ACQUIRE, "agent");
            asm volatile("s_waitcnt vmcnt(0)" ::: "memory");
        }
    }
    __syncthreads();
}

#define LDS_WAIT() asm volatile("s_waitcnt lgkmcnt(0)" ::: "memory")
#define VM_WAIT() asm volatile("s_waitcnt vmcnt(0)" ::: "memory")
typedef unsigned v4u __attribute__((ext_vector_type(4)));
typedef unsigned v2u __attribute__((ext_vector_type(2)));
constexpr int NWAVES = 8;
constexpr int RING_BYTES = 131072, LDSCTL_OFF = RING_BYTES, MISC_OFF = LDSCTL_OFF + 320, LDS_BYTES = 147456;
constexpr int CW_GBAR = 835584;
constexpr int NGROUPS = 4;
constexpr int CW_XMASK = CW_GBAR + 8 * XCD_BAR_WORDS;
constexpr int CW_LB = CW_XMASK + 512;
static_assert((CW_LB + 512) * 4 <= CTL_BYTES, "control region");
constexpr int CW_TMO = 0, CW_BAR = 1024;
constexpr size_t CT_BIAS = 1572864;
constexpr size_t CT_GATE = CT_BIAS + (size_t)DEPTH * 3 * NB * NGU * 4;
constexpr size_t CT_GM = CT_GATE + (size_t)DEPTH * 3 * NB * D * 4;
static_assert(CT_END <= CT_BIAS && CT_GM + (size_t)DEPTH * 3 * NB * D * 4 <= (size_t)CW_GBAR * 4 && ((size_t)CW_GBAR + 8 * 3456) * 4 <= CTL_BYTES, "ctl map");
constexpr size_t WT_GU1 = 0, WT_DN1 = WT_GU1 + (size_t)NGU * D * 2, WT_IN = WT_DN1 + (size_t)D * FF * 2, WT_UQ = WT_IN + (size_t)4096 * D * 2,
                 WT_UKV = WT_UQ + (size_t)1536 * 512 * 2, WT_OUT = WT_UKV + (size_t)2048 * 256 * 2, WT_GU2 = WT_OUT + (size_t)D * D * 2, WT_DN2 = WT_GU2 + (size_t)NGU * D * 2,
                 WT_LAYER = WT_DN2 + (size_t)D * FF * 2;
static_assert(2 * WT_LAYER <= 340 * MiB, "wt");
constexpr int NPIN = 4096;

__device__ __forceinline__ unsigned pk2(float lo, float hi) { return (unsigned)f2bf(lo) | ((unsigned)f2bf(hi) << 16); }
__device__ __forceinline__ unsigned cvtpk(float lo, float hi) { unsigned r; asm volatile("v_cvt_pk_bf16_f32 %0, %1, %2" : "=v"(r) : "v"(lo), "v"(hi)); return r; }
__device__ __forceinline__ float fsilu(float x) { return x * __builtin_amdgcn_rcpf(1.f + __expf(-x)); }

__device__ __forceinline__ int src_block(int kind, int nb) {
    const int pn = nb >> 3, jb = nb & 7;
    if (kind == 0) return 32 * nb;
    if (kind == 1) return (jb < 4) ? 128 * pn + 32 * jb : FF + 128 * pn + 32 * (jb - 4);
    if (kind == 2) {
        if (pn < 4) { const int rb = pn < 2 ? C_QR : C_KR; return rb + (4 * (pn & 1) + (jb & 3)) * 64 + 32 * (jb >> 2); }
        if (pn < 15) return 256 * pn + 32 * jb;
        return jb == 0 ? C_KPE : (jb == 4 ? C_KPE + 32 : -1);
    }
    if (pn < 4) return (2 * pn + (jb >> 2)) * DQK + 32 * (jb & 3);
    return (4 * (pn - 4) + (jb & 3)) * DQK + NOPE + 32 * (jb >> 2);
}
struct CvtDesc { const float* W; const float* scale; bf16_t* WT; const float* sh; float* bias; int ldw, K, k0, src0, dst0; };
__device__ __forceinline__ void cvt_load(const CvtDesc& d, f32x4 (&v)[8], int lane) {
    if (d.src0 >= 0) {
#pragma unroll
        for (int i = 0; i < 8; ++i) { const int row = i * 8 + (lane >> 3); v[i] = *(const f32x4*)(d.W + (size_t)(d.k0 + row) * d.ldw + d.src0 + 4 * (lane & 7)); }
    } else {
#pragma unroll
        for (int i = 0; i < 8; ++i) v[i] = (f32x4){0.f, 0.f, 0.f, 0.f};
    }
}
__device__ __forceinline__ void cvt_process(const CvtDesc& d, f32x4 (&v)[8], LAS float* scr, LAS float* shs, int lane) {
    if (d.scale) {
#pragma unroll
        for (int i = 0; i < 8; ++i) v[i] *= d.scale[d.k0 + i * 8 + (lane >> 3)]; }
#pragma unroll
    for (int i = 0; i < 8; ++i) { LAS float* q = scr + (i * 8 + (lane >> 3)) * 33 + 4 * (lane & 7); q[0] = v[i][0]; q[1] = v[i][1]; q[2] = v[i][2]; q[3] = v[i][3]; }
    const bool wb = d.sh && d.src0 >= 0;
    if (wb) {
#pragma unroll
        for (int j = 0; j < 4; ++j) shs[lane * 4 + j] = d.sh[(size_t)j * NMOD * D + d.k0 + lane];
    }
    LDS_WAIT(); asm volatile("" ::: "memory");
    const int c = lane & 7;
#pragma unroll
    for (int j = 0; j < 4; ++j) { const int n = (lane >> 3) + 8 * j; const LAS float* s = scr + (8 * c) * 33 + n;
        v4u o; o.x = pk2(s[0 * 33], s[1 * 33]); o.y = pk2(s[2 * 33], s[3 * 33]); o.z = pk2(s[4 * 33], s[5 * 33]); o.w = pk2(s[6 * 33], s[7 * 33]);
        *(v4u*)(d.WT + (size_t)(d.dst0 + n) * d.K + d.k0 + 8 * c) = o; }
    if (wb) {
        const int n = lane & 31, kh = lane >> 5; f32x4 a = {0.f, 0.f, 0.f, 0.f};
#pragma unroll 8
        for (int kk = 0; kk < 32; ++kk) { const int kq = kh * 32 + kk; a += *(const LAS f32x4*)(shs + kq * 4) * scr[kq * 33 + n]; }
#pragma unroll
        for (int j = 0; j < 4; ++j) { float t = a[j]; t += __shfl_xor(t, 32); if (lane < 32) __hip_atomic_fetch_add(d.bias + (size_t)j * NGU + d.dst0 + n, t, __ATOMIC_RELAXED, __HIP_MEMORY_SCOPE_AGENT); }
    }
    LDS_WAIT(); asm volatile("" ::: "memory");
}

struct EpiGU {
    static constexpr bool PERM = true, AFTER_DRAIN = false;
    bf16_t* act; const float* ss; const float* bias; int pm0, pad_;
    __device__ __forceinline__ void operator()(const f32x4 (&acc)[2][2][4][2], const pg8::Unit& u, int wr, int wc, int fr, int fq) const {
        const int pm = u.pm + pm0, row0 = pm * 256 + wr * 64 + fr, b = pm >> 4, cb = u.pn * 256 + wc * 32 + 8 * fq, oc = u.pn * 128 + wc * 32 + 8 * fq;
        const float* bp = bias + (size_t)b * NGU + cb;
        const f32x4 bg0 = *(const f32x4*)bp, bg1 = *(const f32x4*)(bp + 4), bu0 = *(const f32x4*)(bp + 128), bu1 = *(const f32x4*)(bp + 132);
        float rsv[2][4];
#pragma unroll
        for (int ai = 0; ai < 2; ++ai)
#pragma unroll
            for (int m = 0; m < 4; ++m) rsv[ai][m] = ss[row0 + ai * 128 + m * 16];
        constexpr float NL2E = -1.4426950408889634f;
        const f32x4 cg0 = bg0 * NL2E, cg1 = bg1 * NL2E;
#pragma unroll
        for (int ai = 0; ai < 2; ++ai)
#pragma unroll
            for (int m = 0; m < 4; ++m) { const int row = row0 + ai * 128 + m * 16; const float rs = rsqrtf(rsv[ai][m] * (1.f / D) + EPS), rsn = rs * NL2E;
                const f32x4 g0 = acc[ai][0][m][0] * rs + bg0, g1 = acc[ai][0][m][1] * rs + bg1, u0 = acc[ai][1][m][0] * rs + bu0, u1 = acc[ai][1][m][1] * rs + bu1;
                f32x4 e0 = acc[ai][0][m][0] * rsn + cg0, e1 = acc[ai][0][m][1] * rsn + cg1;
#pragma unroll
                for (int i = 0; i < 4; ++i) { e0[i] = __builtin_amdgcn_exp2f(e0[i]); e1[i] = __builtin_amdgcn_exp2f(e1[i]); }
                e0 = e0 + 1.f; e1 = e1 + 1.f;
#pragma unroll
                for (int i = 0; i < 4; ++i) { e0[i] = __builtin_amdgcn_rcpf(e0[i]); e1[i] = __builtin_amdgcn_rcpf(e1[i]); }
                const f32x4 o0 = (g0 * u0) * e0, o1 = (g1 * u1) * e1;
                v4u w; w.x = cvtpk(o0[0], o0[1]); w.y = cvtpk(o0[2], o0[3]); w.z = cvtpk(o1[0], o1[1]); w.w = cvtpk(o1[2], o1[3]);
                *(v4u*)(act + (size_t)row * FF + oc) = w; }
    }
};
typedef _Float16 f16_t;
typedef _Float16 f16x8 __attribute__((ext_vector_type(8)));
template <bool XF32> struct EpiRes {
    static constexpr bool PERM = true, AFTER_DRAIN = false;
    const float* xin32; const f16_t* xin16; f16_t* xout; bf16_t* xg; float* ssn; const float* gatef; const float* gmn; int has_next, pm0;
    __device__ __forceinline__ void operator()(const f32x4 (&acc)[2][2][4][2], const pg8::Unit& u, int wr, int wc, int fr, int fq) const {
        const int pm = u.pm + pm0, row0 = pm * 256 + wr * 64 + fr, b = pm >> 4, c0 = u.pn * 256 + wc * 32 + 8 * fq;
        const float* gp = gatef + (size_t)b * D + c0; const float* mp = gmn + (size_t)b * D + c0;
        f32x4 gt[2][2], gm[2][2];
#pragma unroll
        for (int bj = 0; bj < 2; ++bj)
#pragma unroll
            for (int n = 0; n < 2; ++n) { gt[bj][n] = *(const f32x4*)(gp + bj * 128 + 4 * n); gm[bj][n] = has_next ? *(const f32x4*)(mp + bj * 128 + 4 * n) : (f32x4){0.f, 0.f, 0.f, 0.f}; }
        f32x4 xv[2][2][2][2]; f16x8 xh[2][2][2];
#define ER_LOAD(q) do { _Pragma("unroll") for (int mm = 0; mm < 2; ++mm) _Pragma("unroll") for (int bj = 0; bj < 2; ++bj) { \
            const size_t off_ = (size_t)(row0 + ((q) >> 1) * 128 + (2 * ((q) & 1) + mm) * 16) * D + c0 + bj * 128; \
            if constexpr (XF32) { xv[(q) & 1][mm][bj][0] = *(const f32x4*)(xin32 + off_); xv[(q) & 1][mm][bj][1] = *(const f32x4*)(xin32 + off_ + 4); } \
            else { xh[(q) & 1][mm][bj] = *(const f16x8*)(xin16 + off_); } } } while (0)
        if constexpr (!XF32) ER_LOAD(0);
        float sqa[4];
#pragma unroll
        for (int q = 0; q < 4; ++q) { const int ai = q >> 1;
            if constexpr (XF32) ER_LOAD(q); else if (q + 1 < 4) ER_LOAD(q + 1);
#pragma unroll
            for (int mm = 0; mm < 2; ++mm) { const int m = 2 * (q & 1) + mm, row = row0 + ai * 128 + m * 16; float sq = 0.f;
#pragma unroll
                for (int bj = 0; bj < 2; ++bj) { const size_t off = (size_t)row * D + c0 + bj * 128;
                    f32x4 x0, x1;
                    if constexpr (XF32) { x0 = xv[q & 1][mm][bj][0]; x1 = xv[q & 1][mm][bj][1]; }
                    else { const f16x8 h = xh[q & 1][mm][bj]; x0 = (f32x4){(float)h[0], (float)h[1], (float)h[2], (float)h[3]}; x1 = (f32x4){(float)h[4], (float)h[5], (float)h[6], (float)h[7]}; }
                    const f32x4 n0 = x0 + gt[bj][0] * acc[ai][bj][m][0], n1 = x1 + gt[bj][1] * acc[ai][bj][m][1];
                    { f16x8 o; o[0] = (f16_t)n0[0]; o[1] = (f16_t)n0[1]; o[2] = (f16_t)n0[2]; o[3] = (f16_t)n0[3]; o[4] = (f16_t)n1[0]; o[5] = (f16_t)n1[1]; o[6] = (f16_t)n1[2]; o[7] = (f16_t)n1[3];
                      *(f16x8*)(xout + off) = o; }
                    sq += (n0[0] * n0[0] + n0[1] * n0[1]) + (n0[2] * n0[2] + n0[3] * n0[3]) + (n1[0] * n1[0] + n1[1] * n1[1]) + (n1[2] * n1[2] + n1[3] * n1[3]);
                    if (has_next) { const f32x4 a = n0 * gm[bj][0], c2 = n1 * gm[bj][1];
                        v4u w; w.x = cvtpk(a[0], a[1]); w.y = cvtpk(a[2], a[3]); w.z = cvtpk(c2[0], c2[1]); w.w = cvtpk(c2[2], c2[3]);
                        *(v4u*)(xg + off) = w; } }
                sq += __shfl_xor(sq, 16); sq += __shfl_xor(sq, 32); sqa[m] = sq; }
            if (q & 1) { const float sv = fq == 0 ? sqa[0] : fq == 1 ? sqa[1] : fq == 2 ? sqa[2] : sqa[3];
                __hip_atomic_fetch_add(ssn + (pm * 256 + wr * 64 + ai * 128 + fq * 16 + fr), sv, __ATOMIC_RELAXED, __HIP_MEMORY_SCOPE_AGENT); }
            asm volatile("" ::: "memory"); }
#undef ER_LOAD
    }
};
struct EpiIn {
    static constexpr bool PERM = true, AFTER_DRAIN = false;
    const float* ss; const float* bias; const float* cosT; const float* sinT;
    bf16_t *qr, *kr, *vr, *gr, *cq, *ckv, *Kb; float *ssq, *sskv; int pm0, pad_;
    __device__ __forceinline__ void operator()(const f32x4 (&acc)[2][2][4][2], const pg8::Unit& u, int wr, int wc, int fr, int fq) const {
        const int pm = u.pm + pm0, row0 = pm * 256 + wr * 64 + fr, b = pm >> 4, pn = u.pn, cb = pn * 256 + wc * 32 + 8 * fq;
        const float* bp = bias + (size_t)b * NGU + cb;
        const f32x4 b00 = *(const f32x4*)bp, b01 = *(const f32x4*)(bp + 4), b10 = *(const f32x4*)(bp + 128), b11 = *(const f32x4*)(bp + 132);
        float rsv[2][4];
#pragma unroll
        for (int ai = 0; ai < 2; ++ai)
#pragma unroll
            for (int m = 0; m < 4; ++m) rsv[ai][m] = ss[row0 + ai * 128 + m * 16];
        asm volatile("" :: "v"(b00), "v"(b01), "v"(b10), "v"(b11), "v"(rsv[0][0]), "v"(rsv[0][1]), "v"(rsv[0][2]), "v"(rsv[0][3]), "v"(rsv[1][0]), "v"(rsv[1][1]), "v"(rsv[1][2]), "v"(rsv[1][3]));
        if (pn == 15 && wc != 0) return;
        if (pn < 4 || pn == 15) {
            const float scale = (pn == 2 || pn == 3) ? 0.125f : 1.0f;
#pragma unroll
            for (int ai = 0; ai < 2; ++ai)
#pragma unroll
                for (int m = 0; m < 4; ++m) { const int row = row0 + ai * 128 + m * 16; const float rs = rsqrtf(rsv[ai][m] * (1.f / D) + EPS);
                    const f32x4 x10 = acc[ai][0][m][0] * rs + b00, x11 = acc[ai][0][m][1] * rs + b01, x20 = acc[ai][1][m][0] * rs + b10, x21 = acc[ai][1][m][1] * rs + b11;
                    const f32x4 c0 = *(const f32x4*)(cosT + (size_t)row * 32 + 8 * fq), c1 = *(const f32x4*)(cosT + (size_t)row * 32 + 8 * fq + 4);
                    const f32x4 s0 = *(const f32x4*)(sinT + (size_t)row * 32 + 8 * fq), s1 = *(const f32x4*)(sinT + (size_t)row * 32 + 8 * fq + 4);
                    const f32x4 o10 = (x10 * c0 - x20 * s0) * scale, o11 = (x11 * c1 - x21 * s1) * scale, o20 = (x10 * s0 + x20 * c0) * scale, o21 = (x11 * s1 + x21 * c1) * scale;
                    v4u w1, w2; w1.x = cvtpk(o10[0], o10[1]); w1.y = cvtpk(o10[2], o10[3]); w1.z = cvtpk(o11[0], o11[1]); w1.w = cvtpk(o11[2], o11[3]);
                    w2.x = cvtpk(o20[0], o20[1]); w2.y = cvtpk(o20[2], o20[3]); w2.z = cvtpk(o21[0], o21[1]); w2.w = cvtpk(o21[2], o21[3]);
                    if (pn < 4) { bf16_t* dst = (pn < 2 ? qr : kr) + (size_t)row * 512 + (4 * (pn & 1) + wc) * 64 + 8 * fq; *(v4u*)dst = w1; *(v4u*)(dst + 32) = w2; }
                    else {
#pragma unroll
                        for (int h = 0; h < MH; ++h) { bf16_t* dst = Kb + (size_t)row * MH * DQK + h * DQK + NOPE + 8 * fq; *(v4u*)dst = w1; *(v4u*)(dst + 32) = w2; } }
                    asm volatile("" ::: "memory"); }
        } else {
            bf16_t* dbase; int ld; float* ssp = nullptr;
            if (pn < 8) { dbase = vr + (pn - 4) * 256; ld = 1024; } else if (pn < 12) { dbase = gr + (pn - 8) * 256; ld = 1024; }
            else if (pn < 14) { dbase = cq + (pn - 12) * 256; ld = 512; ssp = ssq; } else { dbase = ckv; ld = 256; ssp = sskv; }
            const bool gate = (pn >= 8 && pn < 12);
#pragma unroll
            for (int ai = 0; ai < 2; ++ai)
#pragma unroll
                for (int m = 0; m < 4; ++m) { const int row = row0 + ai * 128 + m * 16; const float rs = rsqrtf(rsv[ai][m] * (1.f / D) + EPS); float q = 0.f;
#pragma unroll
                    for (int bj = 0; bj < 2; ++bj) { f32x4 v0 = acc[ai][bj][m][0] * rs + (bj ? b10 : b00), v1 = acc[ai][bj][m][1] * rs + (bj ? b11 : b01);
                        q += (v0[0] * v0[0] + v0[1] * v0[1]) + (v0[2] * v0[2] + v0[3] * v0[3]) + (v1[0] * v1[0] + v1[1] * v1[1]) + (v1[2] * v1[2] + v1[3] * v1[3]);
                        if (gate) {
#pragma unroll
                            for (int i = 0; i < 4; ++i) { v0[i] = fsilu(v0[i]); v1[i] = fsilu(v1[i]); } }
                        v4u w; w.x = cvtpk(v0[0], v0[1]); w.y = cvtpk(v0[2], v0[3]); w.z = cvtpk(v1[0], v1[1]); w.w = cvtpk(v1[2], v1[3]);
                        *(v4u*)(dbase + (size_t)row * ld + bj * 128 + wc * 32 + 8 * fq) = w; }
                    if (ssp) { q += __shfl_xor(q, 16); q += __shfl_xor(q, 32); if (fq == 0) __hip_atomic_fetch_add(ssp + row, q, __ATOMIC_RELAXED, __HIP_MEMORY_SCOPE_AGENT); }
                    asm volatile("" ::: "memory"); }
        }
    }
};
struct EpiUq {
    static constexpr bool PERM = true, AFTER_DRAIN = false;
    const float* ssq; const float* cosT; const float* sinT; bf16_t* Qb; int pm0, pad_;
    __device__ __forceinline__ void operator()(const f32x4 (&acc)[2][2][4][2], const pg8::Unit& u, int wr, int wc, int fr, int fq) const {
        const int row0 = (u.pm + pm0) * 256 + wr * 64 + fr, pn = u.pn;
        float rsv[2][4];
#pragma unroll
        for (int ai = 0; ai < 2; ++ai)
#pragma unroll
            for (int m = 0; m < 4; ++m) rsv[ai][m] = ssq[row0 + ai * 128 + m * 16];
#pragma unroll
        for (int ai = 0; ai < 2; ++ai)
#pragma unroll
            for (int m = 0; m < 4; ++m) { const int row = row0 + ai * 128 + m * 16; const float rs = rsqrtf(rsv[ai][m] * (1.f / QRANK) + EPS);
                if (pn < 4) {
#pragma unroll
                    for (int bj = 0; bj < 2; ++bj) { const f32x4 v0 = acc[ai][bj][m][0] * rs, v1 = acc[ai][bj][m][1] * rs;
                        v4u w; w.x = cvtpk(v0[0], v0[1]); w.y = cvtpk(v0[2], v0[3]); w.z = cvtpk(v1[0], v1[1]); w.w = cvtpk(v1[2], v1[3]);
                        *(v4u*)(Qb + (size_t)row * MH * DQK + (2 * pn + bj) * DQK + wc * 32 + 8 * fq) = w; }
                } else {
                    const f32x4 x10 = acc[ai][0][m][0] * rs, x11 = acc[ai][0][m][1] * rs, x20 = acc[ai][1][m][0] * rs, x21 = acc[ai][1][m][1] * rs;
                    const f32x4 c0 = *(const f32x4*)(cosT + (size_t)row * 32 + 8 * fq), c1 = *(const f32x4*)(cosT + (size_t)row * 32 + 8 * fq + 4);
                    const f32x4 s0 = *(const f32x4*)(sinT + (size_t)row * 32 + 8 * fq), s1 = *(const f32x4*)(sinT + (size_t)row * 32 + 8 * fq + 4);
                    const f32x4 o10 = x10 * c0 - x20 * s0, o11 = x11 * c1 - x21 * s1, o20 = x10 * s0 + x20 * c0, o21 = x11 * s1 + x21 * c1;
                    v4u w1, w2; w1.x = cvtpk(o10[0], o10[1]); w1.y = cvtpk(o10[2], o10[3]); w1.z = cvtpk(o11[0], o11[1]); w1.w = cvtpk(o11[2], o11[3]);
                    w2.x = cvtpk(o20[0], o20[1]); w2.y = cvtpk(o20[2], o20[3]); w2.z = cvtpk(o21[0], o21[1]); w2.w = cvtpk(o21[2], o21[3]);
                    bf16_t* dst = Qb + (size_t)row * MH * DQK + (4 * (pn - 4) + wc) * DQK + NOPE + 8 * fq; *(v4u*)dst = w1; *(v4u*)(dst + 32) = w2;
                }
                asm volatile("" ::: "memory"); }
    }
};
struct EpiUkv {
    static constexpr bool PERM = true, AFTER_DRAIN = false;
    const float* sskv; bf16_t* Kb; bf16_t* Vb; int pm0, pad_;
    __device__ __forceinline__ void operator()(const f32x4 (&acc)[2][2][4][2], const pg8::Unit& u, int wr, int wc, int fr, int fq) const {
        const int row0 = (u.pm + pm0) * 256 + wr * 64 + fr, pn = u.pn;
        float rsv[2][4];
#pragma unroll
        for (int ai = 0; ai < 2; ++ai)
#pragma unroll
            for (int m = 0; m < 4; ++m) rsv[ai][m] = sskv[row0 + ai * 128 + m * 16];
#pragma unroll
        for (int ai = 0; ai < 2; ++ai)
#pragma unroll
            for (int m = 0; m < 4; ++m) { const int row = row0 + ai * 128 + m * 16; const float rs = rsqrtf(rsv[ai][m] * (1.f / KVRANK) + EPS);
#pragma unroll
                for (int bj = 0; bj < 2; ++bj) { const f32x4 v0 = acc[ai][bj][m][0] * rs, v1 = acc[ai][bj][m][1] * rs;
                    v4u w; w.x = cvtpk(v0[0], v0[1]); w.y = cvtpk(v0[2], v0[3]); w.z = cvtpk(v1[0], v1[1]); w.w = cvtpk(v1[2], v1[3]);
                    bf16_t* dst = bj ? Vb + (size_t)row * MH * MDV + pn * MDV + wc * 32 + 8 * fq : Kb + (size_t)row * MH * DQK + pn * DQK + wc * 32 + 8 * fq;
                    *(v4u*)dst = w; }
                asm volatile("" ::: "memory"); }
    }
};

namespace att {
typedef short s16x4 __attribute__((ext_vector_type(4)));
typedef float f32x16 __attribute__((ext_vector_type(16)));
constexpr int SHM_V = 64 * 128 * 2, SHM_K = 64 * DQK * 2;
constexpr int V_OFF = 0, K_OFF = 2 * SHM_V, WS_OFF = K_OFF + 2 * SHM_K;
constexpr float SCALE = 0.07216878364870323f;
constexpr float THR = 8.f;
#define ATT_SBAR() __builtin_amdgcn_sched_barrier(0)
__device__ __forceinline__ int v_st(int k, int c) { const int kk = (k & ~0xC) | ((k & 4) << 1) | ((k & 8) >> 1); return ((kk >> 3) * 4 + (c >> 5)) * 512 + ((kk & 7) * 32 + (c & 31)) * 2; }
__device__ __forceinline__ int v_rd_base(int lane) { return ((lane & 3) << 3) | (((lane >> 2) & 3) << 6) | (((lane >> 4) & 1) << 5) | (((lane >> 5) & 1) << 8); }
constexpr int v_rd_off(int d0, int ks, int half) { return d0 * 512 + ks * 4096 + half * 2048; }
__device__ __forceinline__ int crow(int r, int hi) { return (r & 3) + 8 * (r >> 2) + 4 * hi; }
__device__ __forceinline__ int k_off(int r, int ch) { return r * 384 + (((ch & ~7) | ((ch ^ (r >> 1)) & 7)) << 4); }
__device__ __forceinline__ void mask_tile(f32x16& p0, f32x16& p1, int dq) {
    const float NEG = -__builtin_inff();
#pragma unroll
    for (int r = 0; r < 16; ++r) { const int c = (r & 3) + 8 * (r >> 2); if (dq - c < 0) p0[r] = NEG; if (dq - c - 32 < 0) p1[r] = NEG; }
}
__device__ __forceinline__ void partialSM(f32x16& p0, f32x16& p1, float& m_reg, float& mn, float& alpha) {
    float pmax = p0[0];
#pragma unroll
    for (int r = 1; r < 16; ++r) pmax = fmaxf(pmax, p0[r]);
#pragma unroll
    for (int r = 0; r < 16; ++r) pmax = fmaxf(pmax, p1[r]);
    { auto rr = __builtin_amdgcn_permlane32_swap(__float_as_uint(pmax), __float_as_uint(pmax), false, false);
      pmax = fmaxf(__uint_as_float(rr[0]), __uint_as_float(rr[1])); }
    constexpr float C2 = 1.4426950408889634f * SCALE;
    if (__builtin_expect(__all((pmax - m_reg) * SCALE <= THR), 1)) { mn = m_reg; alpha = 1.f; }
    else { mn = fmaxf(m_reg, pmax); alpha = __builtin_amdgcn_exp2f((m_reg - mn) * C2); m_reg = mn; }
    const float mnL = -mn * C2;
#pragma unroll
    for (int r = 0; r < 16; ++r) p0[r] = fmaf(p0[r], C2, mnL);
#pragma unroll
    for (int r = 0; r < 16; ++r) p1[r] = fmaf(p1[r], C2, mnL);
#pragma unroll
    for (int r = 0; r < 16; ++r) p0[r] = __builtin_amdgcn_exp2f(p0[r]);
}
#define ATT_PK4(P, B_, OUT) do { unsigned a0 = cvtpk(P[B_+0], P[B_+1]), a1 = cvtpk(P[B_+2], P[B_+3]); unsigned b0 = cvtpk(P[B_+4], P[B_+5]), b1 = cvtpk(P[B_+6], P[B_+7]); \
        auto r0 = __builtin_amdgcn_permlane32_swap(a0, b0, false, false); auto r1 = __builtin_amdgcn_permlane32_swap(a1, b1, false, false); \
        v4u w = {r0[0], r1[0], r0[1], r1[1]}; OUT = *reinterpret_cast<bf16x8*>(&w); } while (0)
__device__ __forceinline__ void pack_p(const f32x16& p0, const f32x16& p1, bf16x8& pa0, bf16x8& pa1, bf16x8& pa2, bf16x8& pa3) {
    ATT_PK4(p0, 0, pa0); ATT_PK4(p0, 8, pa1); ATT_PK4(p1, 0, pa2); ATT_PK4(p1, 8, pa3);
}
__device__ __forceinline__ void finishSM(f32x16& p0, f32x16& p1, float alpha, float& l_reg, bf16x8& pa0, bf16x8& pa1, bf16x8& pa2, bf16x8& pa3) {
#pragma unroll
    for (int r = 0; r < 16; ++r) p1[r] = __builtin_amdgcn_exp2f(p1[r]);
    float ps = 0;
#pragma unroll
    for (int r = 0; r < 16; ++r) ps += p0[r];
#pragma unroll
    for (int r = 0; r < 16; ++r) ps += p1[r];
    { auto rr = __builtin_amdgcn_permlane32_swap(__float_as_uint(ps), __float_as_uint(ps), false, false);
      ps = __uint_as_float(rr[0]) + __uint_as_float(rr[1]); }
    l_reg = l_reg * alpha + ps;
    pack_p(p0, p1, pa0, pa1, pa2, pa3);
}
template <int ND, int KROW>
__device__ __forceinline__ void qkt(f32x16& p0, f32x16& p1, const LAS unsigned char* kbuf, int r32, int hi, const bf16x8* qf) {
    p0 = f32x16{}; p1 = f32x16{};
    int ka[4];
#pragma unroll
    for (int dd = 0; dd < 4; ++dd) ka[dd] = (int)(uintptr_t)kbuf + r32 * KROW + ((((2 * dd + hi) ^ (r32 >> 1)) & 7) << 4);
    bf16x8 f0[2], f1[2];
#define ATT_KRD(dst, addr, off) asm volatile("ds_read_b128 %0, %1 offset:%2" : "=&v"(dst) : "v"(addr), "i"(off) : "memory")
    __builtin_amdgcn_sched_barrier(0);
    ATT_KRD(f0[0], ka[0], 0); ATT_KRD(f1[0], ka[0], 32 * KROW);
#pragma unroll
    for (int d0 = 0; d0 < ND; ++d0) {
        if (d0 + 1 < ND) { ATT_KRD(f0[(d0 + 1) & 1], ka[(d0 + 1) & 3], ((d0 + 1) >> 2) * 128); ATT_KRD(f1[(d0 + 1) & 1], ka[(d0 + 1) & 3], ((d0 + 1) >> 2) * 128 + 32 * KROW); }
        if (d0 + 1 < ND) asm volatile("s_waitcnt lgkmcnt(2)" ::: "memory"); else asm volatile("s_waitcnt lgkmcnt(0)" ::: "memory");
        __builtin_amdgcn_sched_barrier(0);
        p0 = __builtin_amdgcn_mfma_f32_32x32x16_bf16(f0[d0 & 1], qf[d0], p0, 0, 0, 0);
        p1 = __builtin_amdgcn_mfma_f32_32x32x16_bf16(f1[d0 & 1], qf[d0], p1, 0, 0, 0);
        __builtin_amdgcn_sched_barrier(0);
    }
#undef ATT_KRD
}
template <int VB>
__device__ __forceinline__ void pv_tile(f32x16* o, int vb0, bf16x8 pa0, bf16x8 pa1, bf16x8 pa2, bf16x8 pa3) {
#define ATT_TRRD(dst, off) asm volatile("ds_read_b64_tr_b16 %0, %1 offset:%2" : "=&v"(dst) : "v"(vb0), "i"(off) : "memory")
#define ATT_PV_D0(d0) do { s16x4 l0, l1, l2, l3, h0, h1, h2, h3; constexpr int b_ = VB * SHM_V + v_rd_off(d0, 0, 0); \
        ATT_TRRD(l0, b_); ATT_TRRD(h0, b_ + 2048); ATT_TRRD(l1, b_ + 4096); ATT_TRRD(h1, b_ + 6144); ATT_TRRD(l2, b_ + 8192); ATT_TRRD(h2, b_ + 10240); ATT_TRRD(l3, b_ + 12288); ATT_TRRD(h3, b_ + 14336); \
        asm volatile("s_waitcnt lgkmcnt(0)" ::: "memory"); ATT_SBAR(); \
        o[d0] = __builtin_amdgcn_mfma_f32_32x32x16_bf16(pa0, (bf16x8){l0[0], l0[1], l0[2], l0[3], h0[0], h0[1], h0[2], h0[3]}, o[d0], 0, 0, 0); \
        o[d0] = __builtin_amdgcn_mfma_f32_32x32x16_bf16(pa1, (bf16x8){l1[0], l1[1], l1[2], l1[3], h1[0], h1[1], h1[2], h1[3]}, o[d0], 0, 0, 0); \
        o[d0] = __builtin_amdgcn_mfma_f32_32x32x16_bf16(pa2, (bf16x8){l2[0], l2[1], l2[2], l2[3], h2[0], h2[1], h2[2], h2[3]}, o[d0], 0, 0, 0); \
        o[d0] = __builtin_amdgcn_mfma_f32_32x32x16_bf16(pa3, (bf16x8){l3[0], l3[1], l3[2], l3[3], h3[0], h3[1], h3[2], h3[3]}, o[d0], 0, 0, 0); } while (0)
    ATT_PV_D0(0); ATT_PV_D0(1); ATT_PV_D0(2); ATT_PV_D0(3);
#undef ATT_PV_D0
#undef ATT_TRRD
}
__device__ __forceinline__ void store_o_bf16(const f32x16* o, const float* rsc, bf16_t* dst, int ld, int r32, int hi) {
#pragma unroll
    for (int r = 0; r < 16; ++r) { const int orow = crow(r, hi);
#pragma unroll
        for (int d0 = 0; d0 < 4; ++d0) { const float v = o[d0][r] * rsc[r]; const float vn = __shfl_xor(v, 1);
            if ((r32 & 1) == 0) *(unsigned*)(dst + (size_t)orow * ld + d0 * 32 + r32) = cvtpk(v, vn); } }
}

__device__ __forceinline__ bf16x8 bload8(__amdgpu_buffer_rsrc_t rs, int voff, int soff) { const v4u w = __builtin_amdgcn_raw_buffer_load_b128(rs, voff, soff, 0); return *reinterpret_cast<const bf16x8*>(&w); }
__device__ __forceinline__ void attn_phase(LAS unsigned char* lds, const bf16_t* Qb, const bf16_t* Kb, const bf16_t* Vb, bf16_t* y, int GS, int rk, int b0, int nbg, int mode = 0) {
    int tid_ = threadIdx.x; asm volatile("" : "+v"(tid_));
    const int tid = tid_, wid = __builtin_amdgcn_readfirstlane(tid >> 6), lane = tid & 63, r32 = lane & 31, hi = lane >> 5;
    const int late = wid >> 2;
    LAS unsigned char* V_lds = lds + V_OFF; LAS unsigned char* K_lds = lds + K_OFF;
    LAS float* wsr = (LAS float*)(lds + WS_OFF) + wid * 64; LAS float* li_l = wsr; LAS float* al_l = wsr + 32;
    const __amdgpu_buffer_rsrc_t rsQ = __builtin_amdgcn_make_buffer_rsrc((void*)Qb, (short)0, (int)((size_t)M * MH * DQK * 2), 0x00020000),
        rsK = __builtin_amdgcn_make_buffer_rsrc((void*)Kb, (short)0, (int)((size_t)M * MH * DQK * 2), 0x00020000), rsV = __builtin_amdgcn_make_buffer_rsrc((void*)Vb, (short)0, (int)((size_t)M * MH * MDV * 2), 0x00020000);
    int kgo[3], kld[3];
#pragma unroll
    for (int i = 0; i < 3; ++i) { const int id = tid + 512 * i, row = id / 24, ch = id % 24; kgo[i] = (row * MH * DQK + ch * 8) * 2; kld[i] = k_off(row, ch); }
    const int sr = tid >> 4, sc = (tid & 15) * 8, vst0 = v_st(sr, sc), vst1 = v_st(32 + sr, sc), vgo0 = (sr * MH * MDV + sc) * 2, vgo1 = ((32 + sr) * MH * MDV + sc) * 2;
    const int vb0 = (int)(uintptr_t)V_lds + v_rd_base(lane);
    const int qgo = ((wid * 32 + r32) * MH * DQK + hi * 8) * 2;
    for (int item = rk; item < nbg * MH * 8; item += GS) {
        const int h = item & 7, slot = item >> 3, b = b0 + (slot >> 3), x = slot & 7;
        const int ksb = (b * SEQ * MH + h) * DQK * 2, vsb = (b * SEQ * MH + h) * MDV * 2;
        for (int pass = 0; pass < 2; ++pass) {
            const int qb = pass ? 15 - x : x, q0 = qb * 256, NT = 4 * qb + 4;
            bf16x8 qf[12];
#pragma unroll
            for (int d0 = 0; d0 < 12; ++d0) qf[d0] = bload8(rsQ, qgo + d0 * 32, ksb + q0 * MH * DQK * 2);
            const int qm = q0 + wid * 32 + r32 - 4 * hi;
            float m_reg = -1e30f, l_reg = 0.f; f32x16 o[4] = {};
            f32x16 p0, p1; bf16x8 pa0, pa1, pa2, pa3;
            bf16x8 sk0, sk1, sk2, sv0, sv1;
#define ATT_LOADK(kb_) do { const int ks_ = ksb + (kb_) * MH * DQK * 2; sk0 = bload8(rsK, kgo[0], ks_); sk1 = bload8(rsK, kgo[1], ks_); sk2 = bload8(rsK, kgo[2], ks_); } while (0)
#define ATT_LOADV(kb_) do { const int vs_ = vsb + (kb_) * MH * MDV * 2; sv0 = bload8(rsV, vgo0, vs_); sv1 = bload8(rsV, vgo1, vs_); } while (0)
#define ATT_WRITEK(bf) do { *(LAS bf16x8*)(K_lds + (bf) * SHM_K + kld[0]) = sk0; *(LAS bf16x8*)(K_lds + (bf) * SHM_K + kld[1]) = sk1; *(LAS bf16x8*)(K_lds + (bf) * SHM_K + kld[2]) = sk2; } while (0)
#define ATT_WRITEV(bf) do { *(LAS bf16x8*)(V_lds + (bf) * SHM_V + vst0) = sv0; *(LAS bf16x8*)(V_lds + (bf) * SHM_V + vst1) = sv1; } while (0)
#define ATT_RESC(a) do { if (__any((a) < 1.f)) { if (hi == 0) al_l[r32] = (a); asm volatile("s_waitcnt lgkmcnt(0)" ::: "memory"); \
        _Pragma("unroll") for (int d_ = 0; d_ < 4; ++d_) _Pragma("unroll") for (int r = 0; r < 16; ++r) o[d_][r] *= al_l[crow(r, hi)]; } } while (0)
#define ATT_BAR() do { asm volatile("s_waitcnt lgkmcnt(0)" ::: "memory"); __builtin_amdgcn_s_barrier(); asm volatile("" ::: "memory"); } while (0)
            ATT_LOADK(0); ATT_WRITEK(0); ATT_LOADK(64); ATT_LOADV(0);
            ATT_BAR();
#define ATT_QK(t) do { if (!(mode & 1)) qkt<12, 384>(p0, p1, K_lds + ((t) & 1) * SHM_K, r32, hi, qf); } while (0)
#define ATT_PV(t) do { if (!(mode & 2)) pv_tile<0>(o, vb0 + ((t) & 1) * SHM_V, pa0, pa1, pa2, pa3); } while (0)
#define ATT_SM(t) do { if (!(mode & 4)) { float mn, alpha; if ((t) >= NT - 4) mask_tile(p0, p1, qm - (t) * 64); \
        partialSM(p0, p1, m_reg, mn, alpha); ATT_RESC(alpha); finishSM(p0, p1, alpha, l_reg, pa0, pa1, pa2, pa3); } } while (0)
#define ATT_STAGE(t) do { if (!(mode & 8)) { if ((t) + 1 < NT) ATT_WRITEK(((t) + 1) & 1); ATT_WRITEV((t) & 1); if ((t) + 2 < NT) ATT_LOADK(((t) + 2) * 64); if ((t) + 1 < NT) ATT_LOADV(((t) + 1) * 64); } } while (0)
            if (late == 0) {
                ATT_QK(0); ATT_BAR();
                ATT_SM(0); ATT_STAGE(0); ATT_BAR();
                for (int t = 1; t < NT; ++t) {
                    ATT_PV(t - 1); ATT_QK(t); ATT_BAR();
                    ATT_SM(t); ATT_STAGE(t); ATT_BAR();
                }
                ATT_PV(NT - 1); ATT_BAR();
                ATT_BAR();
            } else {
                ATT_BAR();
                ATT_QK(0); ATT_STAGE(0); ATT_BAR();
                for (int t = 1; t < NT; ++t) {
                    ATT_SM(t - 1); ATT_BAR();
                    ATT_PV(t - 1); ATT_QK(t); ATT_STAGE(t); ATT_BAR();
                }
                ATT_SM(NT - 1); ATT_BAR();
                ATT_PV(NT - 1); ATT_BAR();
            }
#undef ATT_BAR
#undef ATT_QK
#undef ATT_PV
#undef ATT_SM
#undef ATT_STAGE
            if (hi == 0) li_l[r32] = l_reg; asm volatile("s_waitcnt lgkmcnt(0)" ::: "memory");
            float rli[16];
#pragma unroll
            for (int r = 0; r < 16; ++r) rli[r] = __builtin_amdgcn_rcpf(li_l[crow(r, hi)]);
            store_o_bf16(o, rli, y + ((size_t)b * SEQ + q0 + wid * 32) * MIXW + RETW + h * MDV, MIXW, r32, hi);
        }
    }
    __syncthreads();
#undef ATT_LOADK
#undef ATT_LOADV
#undef ATT_WRITEK
#undef ATT_WRITEV
#undef ATT_RESC
}
}

namespace ret {
using att::f32x16; using att::s16x4; using att::crow; using att::v_st; using att::v_rd_base; using att::bload8;
constexpr int TILE_V = 16384, TILE_K = 8192;
__device__ __forceinline__ float log2_gamma(int h) {
    return h == 0 ? -4.580368847e-02f : h == 1 ? -2.272007614e-02f : h == 2 ? -1.131531317e-02f : h == 3 ? -5.646563135e-03f : h == 4 ? -2.820519032e-03f : h == 5 ? -1.409570221e-03f : h == 6 ? -7.046129904e-04f : -3.522634797e-04f; }
#define RET_TRRD(dst, vb, off) asm volatile("ds_read_b64_tr_b16 %0, %1 offset:%2" : "=&v"(dst) : "v"(vb), "i"(off) : "memory")
__device__ __forceinline__ void inc_phase(LAS unsigned char* lds, const bf16_t* kr, const bf16_t* vr, float* incT, int GS, int rk, int b0, int nbg) {
    const __amdgpu_buffer_rsrc_t rsK = __builtin_amdgcn_make_buffer_rsrc((void*)kr, (short)0, (int)((size_t)M * 512 * 2), 0x00020000), rsV = __builtin_amdgcn_make_buffer_rsrc((void*)vr, (short)0, (int)((size_t)M * 1024 * 2), 0x00020000);
    LAS unsigned char* V_lds = lds; LAS unsigned char* K_lds = lds + 2 * TILE_V;
    for (int uq_ = rk; uq_ < nbg * RH * 32; uq_ += GS) {
        const int unit = (uq_ & 7) | ((b0 + (uq_ >> 3) % nbg) << 3) | (((uq_ >> 3) / nbg) << 5);
        int tid_ = threadIdx.x; asm volatile("" : "+v"(tid_));
        const int tid = tid_, wid = __builtin_amdgcn_readfirstlane(tid >> 6), lane = tid & 63, r32 = lane & 31, hi = lane >> 5;
        const int eblk = wid & 3, dblk = wid >> 2;
        const int vbV = (int)(uintptr_t)V_lds + v_rd_base(lane) + eblk * 512, vbK = (int)(uintptr_t)K_lds + v_rd_base(lane) + dblk * 512;
        const int h = unit & 7, b = (unit >> 3) & 3, n = unit >> 5;
        const float l2g = log2_gamma(h);
        const int tok0 = b * SEQ + n * RCH;
        { bf16x8 kv[2], vv[4];
#pragma unroll
          for (int i = 0; i < 2; ++i) { const int id = tid + 512 * i, tok = id >> 3, ch = id & 7; kv[i] = bload8(rsK, (tok * 512 + ch * 8) * 2, (tok0 * 512 + h * 64) * 2); }
#pragma unroll
          for (int i = 0; i < 4; ++i) { const int id = tid + 512 * i, tok = id >> 4, c16 = id & 15; vv[i] = bload8(rsV, (tok * 1024 + c16 * 8) * 2, (tok0 * 1024 + h * 128) * 2); }
#pragma unroll
          for (int i = 0; i < 2; ++i) { const int id = tid + 512 * i, tok = id >> 3, ch = id & 7; const float dec = __builtin_amdgcn_exp2f(l2g * (float)(RCH - 1 - tok));
            v4u w; w.x = cvtpk(bf2f((bf16_t)kv[i][0]) * dec, bf2f((bf16_t)kv[i][1]) * dec); w.y = cvtpk(bf2f((bf16_t)kv[i][2]) * dec, bf2f((bf16_t)kv[i][3]) * dec);
            w.z = cvtpk(bf2f((bf16_t)kv[i][4]) * dec, bf2f((bf16_t)kv[i][5]) * dec); w.w = cvtpk(bf2f((bf16_t)kv[i][6]) * dec, bf2f((bf16_t)kv[i][7]) * dec);
            *(LAS v4u*)(K_lds + (tok >> 6) * TILE_V + v_st(tok & 63, ch * 8)) = w; }
#pragma unroll
          for (int i = 0; i < 4; ++i) { const int id = tid + 512 * i, tok = id >> 4, c16 = id & 15; *(LAS bf16x8*)(V_lds + (tok >> 6) * TILE_V + v_st(tok & 63, c16 * 8)) = vv[i]; } }
        __syncthreads();
        f32x16 acc = {};
#define RET_INC_STEP(KT, KS) do { s16x4 al, ah, bl, bh_; constexpr int o_ = (KT) * TILE_V + (KS) * 4096; \
        RET_TRRD(al, vbV, o_); RET_TRRD(ah, vbV, o_ + 2048); RET_TRRD(bl, vbK, o_); RET_TRRD(bh_, vbK, o_ + 2048); \
        asm volatile("s_waitcnt lgkmcnt(0)" ::: "memory"); __builtin_amdgcn_sched_barrier(0); \
        acc = __builtin_amdgcn_mfma_f32_32x32x16_bf16((bf16x8){al[0], al[1], al[2], al[3], ah[0], ah[1], ah[2], ah[3]}, (bf16x8){bl[0], bl[1], bl[2], bl[3], bh_[0], bh_[1], bh_[2], bh_[3]}, acc, 0, 0, 0); } while (0)
        RET_INC_STEP(0, 0); RET_INC_STEP(0, 1); RET_INC_STEP(0, 2); RET_INC_STEP(0, 3); RET_INC_STEP(1, 0); RET_INC_STEP(1, 1); RET_INC_STEP(1, 2); RET_INC_STEP(1, 3);
#undef RET_INC_STEP
        float* op = incT + ((size_t)((b * RH + h) * 32 + n)) * (RDV * RDK) + (size_t)(32 * eblk) * RDK + 32 * dblk + r32;
#pragma unroll
        for (int r = 0; r < 16; ++r) op[(size_t)crow(r, hi) * RDK] = acc[r];
        __syncthreads();
    }
}
__device__ __forceinline__ void scan_phase(const float* incT, bf16_t* prevT, int GS, int rk, int b0, int nbg) {
    typedef float f32x2 __attribute__((ext_vector_type(2)));
    int tid_ = threadIdx.x; asm volatile("" : "+v"(tid_));
    for (int p = rk * NWAVES * 64 + tid_; p < nbg * RH * RDV * RDK / 2; p += GS * NWAVES * 64) {
        const int bh = b0 * RH + (p >> 12), off = (p & 4095) * 2; const float cd = exp2f(log2_gamma(bh & 7) * (float)RCH);
        const float* ip = incT + (size_t)bh * 32 * (RDV * RDK) + off; bf16_t* pp = prevT + (size_t)bh * 32 * (RDV * RDK) + off;
        f32x2 st = {0.f, 0.f};
#pragma unroll
        for (int n0 = 0; n0 < 32; n0 += 16) { f32x2 iv[16];
#pragma unroll
            for (int j = 0; j < 16; ++j) iv[j] = *(const f32x2*)(ip + (size_t)(n0 + j) * (RDV * RDK));
#pragma unroll
            for (int j = 0; j < 16; ++j) { *(unsigned*)(pp + (size_t)(n0 + j) * (RDV * RDK)) = cvtpk(st[0], st[1]); st = st * cd + iv[j]; } }
    }
}
constexpr int OST_ROW = 272;
__device__ __forceinline__ void out_phase(LAS unsigned char* lds, const bf16_t* qr, const bf16_t* kr, const bf16_t* vr, const bf16_t* gr, const bf16_t* prevT, const float* rgain, bf16_t* y, int GS, int rk, int b0, int nbg) {
    const __amdgpu_buffer_rsrc_t rsQ = __builtin_amdgcn_make_buffer_rsrc((void*)qr, (short)0, (int)((size_t)M * 512 * 2), 0x00020000), rsK = __builtin_amdgcn_make_buffer_rsrc((void*)kr, (short)0, (int)((size_t)M * 512 * 2), 0x00020000),
        rsV = __builtin_amdgcn_make_buffer_rsrc((void*)vr, (short)0, (int)((size_t)M * 1024 * 2), 0x00020000), rsP = __builtin_amdgcn_make_buffer_rsrc((void*)prevT, (short)0, (int)((size_t)NB * RH * 32 * RDV * RDK * 2), 0x00020000),
        rsG = __builtin_amdgcn_make_buffer_rsrc((void*)gr, (short)0, (int)((size_t)M * 1024 * 2), 0x00020000);
    LAS unsigned char* V_lds = lds; LAS unsigned char* K_lds = lds + 4 * TILE_V;
    for (int uq_ = rk; uq_ < nbg * RH * 16; uq_ += GS) {
        int tid_ = threadIdx.x; asm volatile("" : "+v"(tid_));
        const int tid = tid_, wid = __builtin_amdgcn_readfirstlane(tid >> 6), lane = tid & 63, r32 = lane & 31, hi = lane >> 5;
        const int c = wid >> 2, s = wid & 3;
        const int vb0 = (int)(uintptr_t)V_lds + v_rd_base(lane) + c * 2 * TILE_V;
        const int h = uq_ & 7, b = b0 + (uq_ >> 3) % nbg, cb = (uq_ >> 3) / nbg;
        const float l2g = log2_gamma(h);
        const int tok0 = b * SEQ + cb * 256;
        bf16x8 qf[4];
        { bf16x8 kv[4], vv[8];
#pragma unroll
          for (int i = 0; i < 4; ++i) { const int id = tid + 512 * i, tok = id >> 3, ch = id & 7; kv[i] = bload8(rsK, (tok * 512 + ch * 8) * 2, (tok0 * 512 + h * 64) * 2); }
#pragma unroll
          for (int i = 0; i < 8; ++i) { const int id = tid + 512 * i, tok = id >> 4, c16 = id & 15; vv[i] = bload8(rsV, (tok * 1024 + c16 * 8) * 2, (tok0 * 1024 + h * 128) * 2); }
#pragma unroll
          for (int d0 = 0; d0 < 4; ++d0) qf[d0] = bload8(rsQ, ((c * 128 + s * 32 + r32) * 512 + hi * 8) * 2 + d0 * 32, (tok0 * 512 + h * 64) * 2);
#pragma unroll
          for (int i = 0; i < 4; ++i) { const int id = tid + 512 * i, tok = id >> 3, ch = id & 7, row = tok & 63; *(LAS bf16x8*)(K_lds + (tok >> 6) * TILE_K + row * 128 + (((ch ^ (row >> 1)) & 7) << 4)) = kv[i]; }
#pragma unroll
          for (int i = 0; i < 8; ++i) { const int id = tid + 512 * i, tok = id >> 4, c16 = id & 15; *(LAS bf16x8*)(V_lds + (tok >> 6) * TILE_V + v_st(tok & 63, c16 * 8)) = vv[i]; } }
        f32x16 o[4] = {};
        const int psb = (((b * RH + h) * 32 + 2 * cb + c) * (RDV * RDK)) * 2;
#pragma unroll
        for (int hp = 0; hp < 2; ++hp) { bf16x8 pf[2][4];
#pragma unroll
            for (int dd = 0; dd < 2; ++dd)
#pragma unroll
                for (int ks = 0; ks < 4; ++ks) pf[dd][ks] = bload8(rsP, (((2 * hp + dd) * 32 + r32) * RDK + hi * 8) * 2 + ks * 32, psb);
#pragma unroll
            for (int dd = 0; dd < 2; ++dd)
#pragma unroll
                for (int ks = 0; ks < 4; ++ks) o[2 * hp + dd] = __builtin_amdgcn_mfma_f32_32x32x16_bf16(qf[ks], pf[dd][ks], o[2 * hp + dd], 0, 0, 0);
            asm volatile("" ::: "memory"); }
#pragma unroll
        for (int r = 0; r < 16; ++r) { const float qd = __builtin_amdgcn_exp2f(l2g * (float)(s * 32 + crow(r, hi) + 1));
#pragma unroll
            for (int d0e = 0; d0e < 4; ++d0e) o[d0e][r] *= qd; }
        __syncthreads();
#define RET_INTRA(KT) do { if ((KT) * 64 <= s * 32 + 31) { f32x16 p0, p1; bf16x8 pa0, pa1, pa2, pa3; \
        att::qkt<4, 128>(p0, p1, K_lds + (2 * c + (KT)) * TILE_K, r32, hi, qf); \
        const int di = s * 32 + r32 - (KT) * 64 - 4 * hi;            \
        _Pragma("unroll") for (int r = 0; r < 16; ++r) { const int d0_ = di - ((r & 3) + 8 * (r >> 2)), d1_ = d0_ - 32; \
            p0[r] = d0_ >= 0 ? p0[r] * __builtin_amdgcn_exp2f(l2g * (float)d0_) : 0.f; p1[r] = d1_ >= 0 ? p1[r] * __builtin_amdgcn_exp2f(l2g * (float)d1_) : 0.f; } \
        att::pack_p(p0, p1, pa0, pa1, pa2, pa3); __builtin_amdgcn_sched_barrier(0); \
        att::pv_tile<(KT)>(o, vb0, pa0, pa1, pa2, pa3); } } while (0)
        RET_INTRA(0); RET_INTRA(1);
#undef RET_INTRA
#pragma unroll
        for (int r = 0; r < 16; ++r) { float q = (o[0][r] * o[0][r] + o[1][r] * o[1][r]) + (o[2][r] * o[2][r] + o[3][r] * o[3][r]);
            q += __shfl_xor(q, 1); q += __shfl_xor(q, 2); q += __shfl_xor(q, 4); q += __shfl_xor(q, 8); q += __shfl_xor(q, 16);
            const float rs = rsqrtf(q * (1.f / RDV) + EPS);
#pragma unroll
            for (int d0e = 0; d0e < 4; ++d0e) o[d0e][r] *= rs; }
        __syncthreads();
        LAS unsigned char* OST = lds;
#pragma unroll
        for (int r = 0; r < 16; ++r) { const int lrow = c * 128 + s * 32 + crow(r, hi);
#pragma unroll
            for (int d0e = 0; d0e < 4; ++d0e) { const float v = o[d0e][r]; const float vn = __shfl_xor(v, 1);
                if ((r32 & 1) == 0) *(LAS unsigned*)(OST + lrow * OST_ROW + (d0e * 32 + r32) * 2) = cvtpk(v, vn); } }
        __syncthreads();
        { const int c16 = tid & 15; const f32x4 g0 = *(const f32x4*)(rgain + h * RDV + c16 * 8), g1 = *(const f32x4*)(rgain + h * RDV + c16 * 8 + 4);
          bf16x8 gv[8];
#pragma unroll
          for (int i = 0; i < 8; ++i) gv[i] = bload8(rsG, (((tid >> 4) + 32 * i) * 1024 + c16 * 8) * 2, (tok0 * 1024 + h * 128) * 2);
#pragma unroll
          for (int i = 0; i < 8; ++i) { const int row = (tid >> 4) + 32 * i;
              const bf16x8 ov = *(const LAS bf16x8*)(OST + row * OST_ROW + c16 * 16);
              v4u w; w.x = cvtpk(bf2f((bf16_t)ov[0]) * g0[0] * bf2f((bf16_t)gv[i][0]), bf2f((bf16_t)ov[1]) * g0[1] * bf2f((bf16_t)gv[i][1]));
              w.y = cvtpk(bf2f((bf16_t)ov[2]) * g0[2] * bf2f((bf16_t)gv[i][2]), bf2f((bf16_t)ov[3]) * g0[3] * bf2f((bf16_t)gv[i][3]));
              w.z = cvtpk(bf2f((bf16_t)ov[4]) * g1[0] * bf2f((bf16_t)gv[i][4]), bf2f((bf16_t)ov[5]) * g1[1] * bf2f((bf16_t)gv[i][5]));
              w.w = cvtpk(bf2f((bf16_t)ov[6]) * g1[2] * bf2f((bf16_t)gv[i][6]), bf2f((bf16_t)ov[7]) * g1[3] * bf2f((bf16_t)gv[i][7]));
              *(v4u*)(y + ((size_t)tok0 + row) * MIXW + h * RDV + c16 * 8) = w; } }
        __syncthreads();
    }
}
#undef RET_TRRD
}

struct MkArgs { Ptrs P; int ph_lo, ph_hi; };
constexpr int PH_P0A = 0, PH_P0B = 1, PH_L0 = 2, PH_PER_LAYER = 9, PH_FINAL = PH_L0 + DEPTH * PH_PER_LAYER, PH_COUNT = PH_FINAL + 1;
constexpr int PO_GU1 = 0, PO_DN1 = 1, PO_IN = 2, PO_UP = 3, PO_SCAN = 4, PO_ATT = 5, PO_OUT = 6, PO_GU2 = 7, PO_DN2 = 8;

typedef const __attribute__((address_space(4))) MkArgs* KArgP;
typedef const __attribute__((address_space(4))) Ptrs& PtrsRef;
__global__ void __launch_bounds__(NWAVES * 64, 2) mk_fwd(MkArgs args) {
    extern __shared__ __attribute__((aligned(16))) unsigned char lds_raw[];
    LAS unsigned char* lds = (LAS unsigned char*)lds_raw;
    const int G = gridDim.x, bx = blockIdx.x;
    const int vcu = (G % 8 == 0) ? (bx % 8) * (G / 8) + bx / 8 : bx;
    const int NGW = G * NWAVES;
    const KArgP kargs = (KArgP)__builtin_amdgcn_kernarg_segment_ptr();
    const int lo = args.ph_lo, hi = args.ph_hi;
    for (int u = threadIdx.x; u < (LDS_BYTES - LDSCTL_OFF) / 4; u += NWAVES * 64) ((LAS unsigned*)(lds + LDSCTL_OFF))[u] = 0u;
    __syncthreads();
    const bool dual = (G == 256);
    constexpr int NG = NGROUPS, XG = 8 / NG;
    const int NGRP = dual ? NG : 1, grp = dual ? (bx & 7) / XG : 0, GS = G / NGRP;
    const int rk = dual ? ((bx >> 3) / NG) * 8 + ((bx & 7) % XG) * NG + ((bx >> 3) % NG) : bx;
    const int nbg = NB / NGRP, b0g = grp * nbg, gM = M / NGRP, pm0g = grp * (gM / 256);
    (void)xcd_barrier_post((unsigned*)(kargs->P.ws + WS_CTL) + CW_BAR, (volatile LAS unsigned*)(lds + MISC_OFF) + 8, (unsigned)G);
    if (dual) (void)xcd_barrier_post((unsigned*)(kargs->P.ws + WS_CTL) + CW_GBAR + grp * XCD_BAR_WORDS, (volatile LAS unsigned*)(lds + MISC_OFF) + 10, (unsigned)GS);
    if (dual && threadIdx.x == 0) (void)__hip_atomic_fetch_or((unsigned*)(kargs->P.ws + WS_CTL) + CW_XMASK + (bx & 7) * 64, 1u << xb_xcc_id(), __ATOMIC_RELAXED, __HIP_MEMORY_SCOPE_AGENT);
#define IN(k) (lo <= (k) && (k) < hi)
#define SEAM_(k, group) do { if (IN(k) && IN((k) + 1)) { KArgP ap_ = kargs; asm volatile("" : "+s"(ap_)); XcdBarrier bar_; bar_.x = xb_xcc_id(); \
        if ((group) && dual) { bar_.n = (unsigned)GS; bar_.bar = (unsigned*)(ap_->P.ws + WS_CTL) + CW_GBAR + grp * XCD_BAR_WORDS; bar_.st = (volatile LAS unsigned*)(lds + MISC_OFF) + 10; } \
        else { bar_.n = (unsigned)G; bar_.bar = (unsigned*)(ap_->P.ws + WS_CTL) + CW_BAR; bar_.st = (volatile LAS unsigned*)(lds + MISC_OFF) + 8; } \
        xcd_barrier(bar_); } } while (0)
#define SEAM(k) SEAM_(k, false)
#define SEAMG(k) SEAM_(k, true)
#define SEAML(k) do { if (IN(k) && IN((k) + 1)) { \
        volatile LAS unsigned* st_ = (volatile LAS unsigned*)(lds + MISC_OFF) + 12; \
        if (dual) { asm volatile("s_waitcnt vmcnt(0)" ::: "memory"); __syncthreads(); \
            if (threadIdx.x == 0) { KArgP ap_ = kargs; asm volatile("" : "+s"(ap_)); unsigned* ctl_ = (unsigned*)(ap_->P.ws + WS_CTL); \
                unsigned f_ = st_[0]; if (f_ == 0u) { f_ = (__builtin_popcount(xb_ld(ctl_ + CW_XMASK + (bx & 7) * 64)) == 1) ? 1u : 2u; st_[0] = f_; } \
                if (f_ == 1u) { unsigned* c_ = ctl_ + CW_LB + (bx & 7) * 64; const unsigned tgt_ = (st_[1] + 1u) * (unsigned)(GS / (8 / NGROUPS)); st_[1] = st_[1] + 1u; \
                    __builtin_amdgcn_s_waitcnt(0); (void)xb_add(c_, 1u); XB_SPIN(xb_ld(c_) < tgt_, ctl_ + CW_BAR); \
                    __builtin_amdgcn_fence(__ATOMIC_ACQUIRE, "agent"); asm volatile("s_waitcnt vmcnt(0)" ::: "memory"); } } \
            __syncthreads(); } \
        if (!dual || st_[0] != 1u) SEAM_(k, true); } } while (0)
#define PH_LOCALS \
    int tid = threadIdx.x; asm volatile("" : "+v"(tid)); \
    const int lane = tid & 63, wave = __builtin_amdgcn_readfirstlane(tid >> 6), gw = vcu * NWAVES + wave; (void)lane; (void)gw; \
    KArgP ap = kargs; asm volatile("" : "+s"(ap)); int Gp = GS, bxp = rk; asm volatile("" : "+s"(Gp), "+s"(bxp)); (void)Gp; (void)bxp;     \
    int gMp = gM, pm0 = pm0g, b0 = b0g, nbp = nbg; asm volatile("" : "+s"(gMp), "+s"(pm0), "+s"(b0), "+s"(nbp)); (void)gMp; (void)pm0; (void)b0; (void)nbp; \
    PtrsRef P = ap->P; unsigned char* ws = P.ws; \
    float* mod = (float*)(ws + CT_MOD); float* ssx = (float*)(ws + CT_SS); float* biasb = (float*)(ws + CT_BIAS); \
    float* gatef = (float*)(ws + CT_GATE); float* gmt = (float*)(ws + CT_GM); \
    float* cosT = (float*)(ws + WS_COS); float* sinT = (float*)(ws + WS_SIN); \
    f16_t* xres = (f16_t*)(ws + WS_XRES); bf16_t* xg = (bf16_t*)(ws + WS_XG); bf16_t* act = (bf16_t*)(ws + WS_ACT); \
    (void)mod; (void)ssx; (void)biasb; (void)gatef; (void)gmt; (void)cosT; (void)sinT; (void)xres; (void)xg; (void)act
#define MIX_LOCALS \
    bf16_t *qr = (bf16_t*)(ws + WS_QR), *kr = (bf16_t*)(ws + WS_KR), *vr = (bf16_t*)(ws + WS_VR), *gr = (bf16_t*)(ws + WS_GR), *cq = (bf16_t*)(ws + WS_CQ), *ckv = (bf16_t*)(ws + WS_CKV); \
    bf16_t *Qb = (bf16_t*)(ws + WS_Q), *Kb = (bf16_t*)(ws + WS_K), *Vb = (bf16_t*)(ws + WS_V), *yb = (bf16_t*)(ws + WS_Y); \
    float* ssq = (float*)(ws + CT_SSQ) + (size_t)l * M; float* sskv = (float*)(ws + CT_SSKV) + (size_t)l * M; \
    (void)qr; (void)kr; (void)vr; (void)gr; (void)cq; (void)ckv; (void)Qb; (void)Kb; (void)Vb; (void)yb; (void)ssq; (void)sskv
#define LAYER_LOCALS \
    const float* mod_l = mod + (size_t)l * NB * NMOD * D; unsigned char* wt = ws + WS_WT + (size_t)l * WT_LAYER; (void)mod_l; (void)wt

    if (IN(PH_P0A)) {
        PH_LOCALS;
        LAS float* CA = (LAS float*)lds;
        LAS float* RED = (LAS float*)(lds + 32768);
        for (int i = tid; i < NB * D; i += NWAVES * 64) CA[i] = siluf(P.c[i]);
        __syncthreads();
        for (int u = vcu; u < 2 * 72 * 8; u += G) {
            const int l = u / 576, r = u % 576, strip = r >> 3, kc = r & 7;
            f32x4 a0 = {0, 0, 0, 0}, a1 = a0, a2 = a0, a3 = a0;
            const float* wp = P.w_ada + ((size_t)l * D + kc * 256 + wave * 32) * (NMOD * D) + strip * 256 + 4 * lane;
            const LAS float* cp = CA + kc * 256 + wave * 32;
#pragma unroll 16
            for (int i = 0; i < 32; ++i) { const f32x4 wv = *(const f32x4*)(wp + (size_t)i * (NMOD * D));
                a0 += wv * cp[i]; a1 += wv * cp[D + i]; a2 += wv * cp[2 * D + i]; a3 += wv * cp[3 * D + i]; }
            *(LAS f32x4*)(RED + (wave * 4 + 0) * 256 + 4 * lane) = a0; *(LAS f32x4*)(RED + (wave * 4 + 1) * 256 + 4 * lane) = a1;
            *(LAS f32x4*)(RED + (wave * 4 + 2) * 256 + 4 * lane) = a2; *(LAS f32x4*)(RED + (wave * 4 + 3) * 256 + 4 * lane) = a3;
            __syncthreads();
            for (int o = tid; o < 1024; o += NWAVES * 64) { const int b = o >> 8, j = o & 255; float s = 0.f;
#pragma unroll
                for (int w = 0; w < 8; ++w) s += RED[(w * 4 + b) * 256 + j];
                const int col = strip * 256 + j; if (kc == 0) s += P.b_ada[l * NMOD * D + col];
                __hip_atomic_fetch_add(mod + ((size_t)l * NB + b) * NMOD * D + col, s, __ATOMIC_RELAXED, __HIP_MEMORY_SCOPE_AGENT); }
            __syncthreads();
        }
        for (int i = vcu * NWAVES * 64 + tid; i < M * 32; i += G * NWAVES * 64) { const int m = i >> 5, f = i & 31;
            const float inv = (float)pow(10000.0, -(double)f / 32.0); const float ang = (float)P.pos[m] * inv;
            cosT[i] = (float)cos((double)ang); sinT[i] = (float)sin((double)ang); }
    }
    SEAM(PH_P0A);
    if (IN(PH_P0B)) {
        PH_LOCALS;
        for (int row = gw; row < M; row += NGW) { const int b = row / SEQ;
            const float* xr = P.x + (size_t)row * D; const float* gn = P.norm_ffn1; const float* scp = mod + (size_t)b * NMOD * D + D;
            float s = 0.f; f32x4 xv[8], gv[8];
#pragma unroll
            for (int j = 0; j < 8; ++j) { const int c = 4 * (lane + 64 * j); xv[j] = *(const f32x4*)(xr + c); gv[j] = *(const f32x4*)(gn + c) * (*(const f32x4*)(scp + c) + 1.f); }
#pragma unroll
            for (int j = 0; j < 8; ++j) { const int c = 4 * (lane + 64 * j); const f32x4 v = xv[j], o = v * gv[j];
                s += (v[0] * v[0] + v[1] * v[1]) + (v[2] * v[2] + v[3] * v[3]);
                v2u w; w.x = cvtpk(o[0], o[1]); w.y = cvtpk(o[2], o[3]); *(v2u*)(xg + (size_t)row * D + c) = w; }
            s = wave_sum(s); if (lane == 0) ssx[row] = s; }
        for (int i = vcu * NWAVES * 64 + tid; i < DEPTH * 3 * NB * D; i += G * NWAVES * 64) { const int c = i & 2047, b = (i >> 11) & 3, q = i >> 13, l = q / 3, s = q % 3;
            const float* ml = mod + ((size_t)l * NB + b) * NMOD * D; const float* gn = (s == 0 ? P.norm_ffn1 : s == 1 ? P.norm_mix : P.norm_ffn2) + (size_t)l * D;
            gatef[i] = (s == 1 ? 1.0f : 0.5f) * ml[(3 * s + 2) * D + c]; gmt[i] = gn[c] * (1.f + ml[(3 * s + 1) * D + c]); }
        LAS float* scr = (LAS float*)(lds + wave * 8448); LAS float* shs = (LAS float*)(lds + 8 * 8448 + wave * 1024);
        constexpr int IT_GU = (D / 64) * (NGU / 32), IT_DN = (FF / 64) * (D / 32), IT_IN = (D / 64) * (NPIN / 32), IT_UQ = (QRANK / 64) * (1536 / 32),
                      IT_UKV = (KVRANK / 64) * (2048 / 32), IT_OUT = (D / 64) * (D / 32), IT_LAYER = 2 * IT_GU + 2 * IT_DN + IT_IN + IT_UQ + IT_UKV + IT_OUT;
        auto decode = [&](int it) -> CvtDesc {
            const int l = it / IT_LAYER; int r = it % IT_LAYER;
            unsigned char* wt = ws + WS_WT + (size_t)l * WT_LAYER;
            const float* W; const float* sc = nullptr; bf16_t* WT; int K, ldw, NP, kind, sb = -1;
            if (r < IT_GU) { W = P.ffn1_w_gu + (size_t)l * D * NGU; WT = (bf16_t*)(wt + WT_GU1); K = D; ldw = NGU; NP = NGU; kind = 1; sb = 0; }
            else if ((r -= IT_GU) < IT_DN) { W = P.ffn1_w_down + (size_t)l * FF * D; WT = (bf16_t*)(wt + WT_DN1); K = FF; ldw = D; NP = D; kind = 0; }
            else if ((r -= IT_DN) < IT_IN) { W = P.w_in + (size_t)l * D * INCOLS; WT = (bf16_t*)(wt + WT_IN); K = D; ldw = INCOLS; NP = NPIN; kind = 2; sb = 1; }
            else if ((r -= IT_IN) < IT_UQ) { W = P.w_uq + (size_t)l * QRANK * MH * DQK; sc = P.q_norm_g + (size_t)l * QRANK; WT = (bf16_t*)(wt + WT_UQ); K = QRANK; ldw = MH * DQK; NP = 1536; kind = 3; }
            else if ((r -= IT_UQ) < IT_UKV) { W = P.w_ukv + (size_t)l * KVRANK * 2048; sc = P.kv_norm_g + (size_t)l * KVRANK; WT = (bf16_t*)(wt + WT_UKV); K = KVRANK; ldw = 2048; NP = 2048; kind = 0; }
            else if ((r -= IT_UKV) < IT_OUT) { W = P.w_out + (size_t)l * MIXW * D; WT = (bf16_t*)(wt + WT_OUT); K = MIXW; ldw = D; NP = D; kind = 0; }
            else if ((r -= IT_OUT) < IT_GU) { W = P.ffn2_w_gu + (size_t)l * D * NGU; WT = (bf16_t*)(wt + WT_GU2); K = D; ldw = NGU; NP = NGU; kind = 1; sb = 2; }
            else { r -= IT_GU; W = P.ffn2_w_down + (size_t)l * FF * D; WT = (bf16_t*)(wt + WT_DN2); K = FF; ldw = D; NP = D; kind = 0; }
            const int nblk = NP / 32, kb = r / nblk, nb = r % nblk;
            CvtDesc d; d.W = W; d.scale = sc; d.WT = WT; d.sh = sb >= 0 ? mod + (size_t)l * NB * NMOD * D + (size_t)(3 * sb) * D : nullptr;
            d.bias = biasb + (size_t)(3 * l + (sb < 0 ? 0 : sb)) * NB * NGU; d.ldw = ldw; d.K = K; d.k0 = 64 * kb; d.src0 = src_block(kind, nb); d.dst0 = 32 * nb; return d; };
        {
            int it = gw;
            if (it < DEPTH * IT_LAYER) {
                CvtDesc cur = decode(it); f32x4 v[8]; cvt_load(cur, v, lane);
                for (;;) {
                    const int itn = it + NGW; const bool more = itn < DEPTH * IT_LAYER;
                    CvtDesc nxt = cur; f32x4 vn[8];
                    if (more) { nxt = decode(itn); cvt_load(nxt, vn, lane); }
                    cvt_process(cur, v, scr, shs, lane);
                    if (!more) break;
                    cur = nxt; it = itn;
#pragma unroll
                    for (int i = 0; i < 8; ++i) v[i] = vn[i];
                }
            }
        }
    }
    SEAM(PH_P0B);
    for (int l = 0; l < DEPTH; ++l) {
        const int pb = PH_L0 + l * PH_PER_LAYER;
        for (int s = 0; s < 3; s += 2) {
            const int p_gu = pb + (s == 0 ? PO_GU1 : PO_GU2), p_dn = p_gu + 1;
            if (IN(p_gu)) {
                PH_LOCALS; LAYER_LOCALS;
                pg8::Gemm g{xg + (size_t)pm0 * 256 * D, (const bf16_t*)(wt + (s == 0 ? WT_GU1 : WT_GU2)), gMp, NGU, D}; pg8::StaticOrder S; S.init(gMp, NGU, Gp, bxp);
                EpiGU E{act, ssx + (size_t)(3 * l + s) * M, biasb + (size_t)(3 * l + s) * NB * NGU, pm0, 0};
                pg8::gemm_phase<EpiGU, pg8::StaticOrder, true, true>(lds, g, S, E);
            }
            SEAML(p_gu);
            if (IN(p_dn)) {
                PH_LOCALS; LAYER_LOCALS;
                pg8::Gemm g{act + (size_t)pm0 * 256 * FF, (const bf16_t*)(wt + (s == 0 ? WT_DN1 : WT_DN2)), gMp, D, FF}; pg8::StaticOrder S; S.init(gMp, D, Gp, bxp);
                const int last = (l == DEPTH - 1 && s == 2);
                const int qn = 3 * l + s + 1;
                if (l == 0 && s == 0) { EpiRes<true> E{P.x, nullptr, xres, xg, ssx + (size_t)qn * M, gatef + (size_t)(3 * l + s) * NB * D, gmt + (size_t)qn * NB * D, 1, pm0};
                    pg8::gemm_phase<EpiRes<true>, pg8::StaticOrder, true, true>(lds, g, S, E); }
                else { EpiRes<false> E{nullptr, xres, xres, xg, ssx + (size_t)qn * M, gatef + (size_t)(3 * l + s) * NB * D, gmt + (size_t)(last ? 0 : qn) * NB * D, last ? 0 : 1, pm0};
                    pg8::gemm_phase<EpiRes<false>, pg8::StaticOrder, true, true>(lds, g, S, E); }
            }
            if (l == DEPTH - 1 && s == 2) SEAMG(p_dn); else SEAML(p_dn);
            if (s == 0) {
                if (IN(pb + PO_IN)) {
                    PH_LOCALS; LAYER_LOCALS; MIX_LOCALS;
                    pg8::Gemm g{xg + (size_t)pm0 * 256 * D, (const bf16_t*)(wt + WT_IN), gMp, NPIN, D}; pg8::StaticOrder S; S.init(gMp, NPIN, Gp, bxp);
                    EpiIn E{ssx + (size_t)(3 * l + 1) * M, biasb + (size_t)(3 * l + 1) * NB * NGU, cosT, sinT, qr, kr, vr, gr, cq, ckv, Kb, ssq, sskv, pm0, 0};
                    pg8::gemm_phase<EpiIn, pg8::StaticOrder, true, true>(lds, g, S, E);
                }
                SEAMG(pb + PO_IN);
                if (IN(pb + PO_UP)) {
                    PH_LOCALS; LAYER_LOCALS; MIX_LOCALS;
                    {
                    { pg8::Gemm g{cq + (size_t)pm0 * 256 * QRANK, (const bf16_t*)(wt + WT_UQ), gMp, 1536, QRANK}; pg8::StaticOrder S; S.init(gMp, 1536, Gp, bxp);
                      EpiUq E{ssq, cosT, sinT, Qb, pm0, 0};
                      pg8::gemm_phase<EpiUq, pg8::StaticOrder, true, true>(lds, g, S, E); }
                    { pg8::Gemm g{ckv + (size_t)pm0 * 256 * KVRANK, (const bf16_t*)(wt + WT_UKV), gMp, 2048, KVRANK}; pg8::StaticOrder S; S.init(gMp, 2048, Gp, bxp);
                      EpiUkv E{sskv, Kb, Vb, pm0, 0};
                      pg8::gemm_phase<EpiUkv, pg8::StaticOrder, true, true>(lds, g, S, E); }
                    ret::inc_phase(lds, kr, vr, (float*)(ws + WS_INC), Gp, bxp, b0, nbp);
                    }
                }
                SEAMG(pb + PO_UP);
                if (IN(pb + PO_SCAN)) {
                    PH_LOCALS; LAYER_LOCALS; MIX_LOCALS;
                    ret::scan_phase((const float*)(ws + WS_INC), (bf16_t*)(ws + WS_PREVT), Gp, bxp, b0, nbp);
                }
                SEAMG(pb + PO_SCAN);
                if (IN(pb + PO_ATT)) {
                    PH_LOCALS; LAYER_LOCALS; MIX_LOCALS;
                    att::attn_phase(lds, Qb, Kb, Vb, yb, Gp, bxp, b0, nbp, 0);
                    ret::out_phase(lds, qr, kr, vr, gr, (const bf16_t*)(ws + WS_PREVT), P.ret_norm_g + (size_t)l * RETW, yb, Gp, bxp, b0, nbp);
                }
                SEAMG(pb + PO_ATT);
                if (IN(pb + PO_OUT)) {
                    PH_LOCALS; LAYER_LOCALS; MIX_LOCALS;
                    pg8::Gemm g{yb + (size_t)pm0 * 256 * MIXW, (const bf16_t*)(wt + WT_OUT), gMp, D, MIXW}; pg8::StaticOrder S; S.init(gMp, D, Gp, bxp);
                    EpiRes<false> E{nullptr, xres, xres, xg, ssx + (size_t)(3 * l + 2) * M, gatef + (size_t)(3 * l + 1) * NB * D, gmt + (size_t)(3 * l + 2) * NB * D, 1, pm0};
                    pg8::gemm_phase<EpiRes<false>, pg8::StaticOrder, true, true>(lds, g, S, E);
                }
                SEAML(pb + PO_OUT);
            }
        }
    }
    if (IN(PH_FINAL)) {
        PH_LOCALS;
        const float* ssf = ssx + (size_t)6 * M;
        for (int row = pm0 * 256 + bxp * NWAVES + wave; row < pm0 * 256 + gMp; row += Gp * NWAVES) { const float rs = rsqrtf(ssf[row] * (1.f / D) + EPS);
            f16x8 hv[4];
#pragma unroll
            for (int j = 0; j < 4; ++j) hv[j] = *(const f16x8*)(xres + (size_t)row * D + 8 * (lane + 64 * j));
#pragma unroll
            for (int j = 0; j < 4; ++j) { const int c = 8 * (lane + 64 * j); const f16x8 h = hv[j];
                const f32x4 g0 = *(const f32x4*)(P.final_norm + c), g1 = *(const f32x4*)(P.final_norm + c + 4);
                *(f32x4*)(P.out + (size_t)row * D + c) = (f32x4){(float)h[0], (float)h[1], (float)h[2], (float)h[3]} * rs * g0;
                *(f32x4*)(P.out + (size_t)row * D + c + 4) = (f32x4){(float)h[4], (float)h[5], (float)h[6], (float)h[7]} * rs * g1; } }
    }
#undef IN
#undef SEAM
#undef PH_LOCALS
#undef LAYER_LOCALS
#undef MIX_LOCALS
}

static int g_grid = 0;
static void mk(hipStream_t st, const Ptrs& P, int lo, int hi) {
    MkArgs a{}; a.P = P; a.ph_lo = lo; a.ph_hi = hi;
    hipLaunchKernelGGL(mk_fwd, dim3(g_grid), dim3(NWAVES * 64), LDS_BYTES, st, a);
}

extern "C" void kernel_launch(void* const* d_in, const int* in_sizes, int n_in, void* d_out, int out_size, void* d_ws, size_t ws_size, hipStream_t stream) {
    if (n_in != 20 || ws_size < WS_END) { fprintf(stderr, "kernel_launch: bad args n_in %d ws %zu need %zu\n", n_in, ws_size, (size_t)WS_END); return; }
    if (g_grid == 0) {
        int dev = 0, cus = 0;
        if (hipGetDevice(&dev) != hipSuccess || hipDeviceGetAttribute(&cus, hipDeviceAttributeMultiprocessorCount, dev) != hipSuccess || cus <= 0) { g_grid = -1; return; }
        if (hipFuncSetAttribute((const void*)mk_fwd, hipFuncAttributeMaxDynamicSharedMemorySize, LDS_BYTES) != hipSuccess) { fprintf(stderr, "hipFuncSetAttribute failed\n"); g_grid = -1; return; }
        g_grid = cus;
    }
    if (g_grid < 0) return;
    Ptrs P{};
    P.x = (const float*)d_in[0]; P.c = (const float*)d_in[1]; P.pos = (const int*)d_in[2]; P.w_ada = (const float*)d_in[3]; P.b_ada = (const float*)d_in[4];
    P.norm_ffn1 = (const float*)d_in[5]; P.ffn1_w_gu = (const float*)d_in[6]; P.ffn1_w_down = (const float*)d_in[7]; P.norm_mix = (const float*)d_in[8];
    P.w_in = (const float*)d_in[9]; P.ret_norm_g = (const float*)d_in[10]; P.q_norm_g = (const float*)d_in[11]; P.w_uq = (const float*)d_in[12];
    P.kv_norm_g = (const float*)d_in[13]; P.w_ukv = (const float*)d_in[14]; P.w_out = (const float*)d_in[15]; P.norm_ffn2 = (const float*)d_in[16];
    P.ffn2_w_gu = (const float*)d_in[17]; P.ffn2_w_down = (const float*)d_in[18]; P.final_norm = (const float*)d_in[19];
    P.out = (float*)d_out; P.ws = (unsigned char*)d_ws;
    unsigned char* ws = P.ws;
    (void)hipMemsetAsync(ws + WS_CTL, 0, CTL_BYTES, stream);
    mk(stream, P, 0, PH_COUNT);
}
```

```cpp
#include <hip/hip_runtime.h>
#include <cstdio>
#include <cstdint>
#include <cmath>

constexpr int D = 2048, NB = 4, SEQ = 4096, DEPTH = 2, M = NB * SEQ;
constexpr int RH = 8, RDK = 64, RDV = 128, RCH = 128;
constexpr int MH = 8, QRANK = 512, KVRANK = 256, NOPE = 128, ROPE = 64, MDV = 128, DQK = NOPE + ROPE;
constexpr int RETW = RH * RDV, MLAW = MH * MDV, MIXW = RETW + MLAW;
constexpr int INCOLS = 2 * RH * RDK + 2 * RETW + QRANK + KVRANK + ROPE;
constexpr int FF = 5632, NGU = 2 * FF;
constexpr int NMOD = 9;
constexpr float EPS = 1e-6f;
constexpr int C_QR = 0, C_KR = 512, C_VR = 1024, C_GR = 2048, C_CQ = 3072, C_CKV = 3584, C_KPE = 3840;

typedef unsigned short bf16_t;
typedef short bf16x8 __attribute__((ext_vector_type(8)));
typedef float f32x4 __attribute__((ext_vector_type(4)));

constexpr size_t MiB = 1u << 20;
constexpr size_t WS_CTL = 0, CTL_BYTES = 4 * MiB;
constexpr size_t CT_SS = 64 * 1024;
constexpr size_t CT_SSQ = CT_SS + 7 * (size_t)M * 4;
constexpr size_t CT_SSKV = CT_SSQ + 2 * (size_t)M * 4;
constexpr size_t CT_MOD = CT_SSKV + 2 * (size_t)M * 4;
constexpr size_t CT_END = CT_MOD + (size_t)DEPTH * NB * NMOD * D * 4;
static_assert(CT_END <= CTL_BYTES, "ctl");
constexpr size_t WS_COS = 4 * MiB, WS_SIN = 6 * MiB;
constexpr size_t WS_XRES = 8 * MiB;
constexpr size_t WS_XG = WS_XRES + (size_t)M * D * 4;
constexpr size_t WS_Y = WS_XG + (size_t)M * D * 2;
constexpr size_t WS_H = WS_Y;
constexpr size_t WS_INC = WS_Y + (size_t)M * MIXW * 2;
constexpr size_t WS_PREVT = WS_INC + (size_t)NB * RH * 32 * 64 * 128 * 4;
constexpr size_t WS_CQF = WS_INC;
constexpr size_t WS_CKVF = WS_PREVT;
constexpr size_t WS_MIX = WS_PREVT + (size_t)NB * RH * 32 * 64 * 128 * 2;
constexpr size_t WS_QR = WS_MIX;
constexpr size_t WS_KR = WS_QR + (size_t)M * 512 * 2;
constexpr size_t WS_VR = WS_KR + (size_t)M * 512 * 2;
constexpr size_t WS_GR = WS_VR + (size_t)M * 1024 * 2;
constexpr size_t WS_CQ = WS_GR + (size_t)M * 1024 * 2;
constexpr size_t WS_CKV = WS_CQ + (size_t)M * 512 * 2;
constexpr size_t WS_Q = WS_CKV + (size_t)M * 256 * 2;
constexpr size_t WS_K = WS_Q + (size_t)M * MH * DQK * 2;
constexpr size_t WS_V = WS_K + (size_t)M * MH * DQK * 2;
constexpr size_t WS_MIX_END = WS_V + (size_t)M * MH * MDV * 2;
constexpr size_t WS_WT = WS_MIX_END;
constexpr size_t WS_ACT = WS_WT + 340 * MiB;
constexpr size_t WS_END = WS_ACT + (size_t)M * FF * 2;

__device__ __forceinline__ bf16_t f2bf(float f) { unsigned u = __float_as_uint(f); u += 0x7fffu + ((u >> 16) & 1u); return (bf16_t)(u >> 16); }
__device__ __forceinline__ float bf2f(bf16_t b) { return __uint_as_float(((unsigned)b) << 16); }
__device__ __forceinline__ float siluf(float x) { return x / (1.f + __expf(-x)); }
__device__ __forceinline__ float wave_sum(float v) {
#pragma unroll
    for (int o = 1; o < 64; o <<= 1) v += __shfl_xor(v, o);
    return v;
}

struct Ptrs {
    const float *x, *c; const int* pos; const float *w_ada, *b_ada, *norm_ffn1, *ffn1_w_gu, *ffn1_w_down, *norm_mix, *w_in, *ret_norm_g, *q_norm_g, *w_uq,
        *kv_norm_g, *w_ukv, *w_out, *norm_ffn2, *ffn2_w_gu, *ffn2_w_down, *final_norm;
    float* out; unsigned char* ws;
};

namespace pg8 {
#define PG8_LAS __attribute__((address_space(3)))
typedef unsigned short bf16_t;
typedef short bf16x8 __attribute__((ext_vector_type(8)));
typedef float f32x4 __attribute__((ext_vector_type(4)));
typedef unsigned u32x4 __attribute__((ext_vector_type(4)));
constexpr int BM = 256, BK = 64, HALF = 128, HTB = HALF * BK * 2  , STAGE_BYTES = 8 * HTB, NXCD = 8, WGM = 8;

__host__ __device__ __forceinline__ int lds_byte(int r, int c) { const int st = (r >> 4) * 2 + (c >> 5), rr = r & 15, cc = c & 31, ob = rr * 64 + cc * 2; return st * 1024 + (ob ^ (((ob >> 9) & 1) << 5)); }
__host__ __device__ __forceinline__ void stage_rc(int b, int& R, int& C) { const int st = b / 1024, sb = b % 1024, swz = sb ^ (((sb >> 9) & 1) << 5); R = (st >> 1) * 16 + swz / 64; C = (st & 1) * 32 + (swz % 64) / 2; }
__host__ __device__ __forceinline__ int perm32(int rho) { const int n = rho >> 4, i = rho & 15; return 8 * (i >> 2) + 4 * n + (i & 3); }

struct Unit { int pm, pn; };
struct Gemm { const bf16_t* A; const bf16_t* Bt; int M, N, K; };

struct StaticOrder {
    int nM, nN, nwg, G, c;
    __host__ __device__ void init(int M, int N, int G_, int c_) { nM = M / BM; nN = N / BM; nwg = nM * nN; G = G_; c = c_; }
    __host__ __device__ bool next(int i, Unit& u) const {
        const long L = (long)i * G + c; if (L >= nwg) return false;
        int wgid = (int)L; { const int q = nwg / NXCD, r = nwg % NXCD, xcd = wgid % NXCD, off = wgid / NXCD; wgid = (xcd < r ? xcd * (q + 1) : r * (q + 1) + (xcd - r) * q) + off; }
        const int nig = WGM * nN, gid = wgid / nig, fm = gid * WGM, gsz = (nM - fm) < WGM ? (nM - fm) : WGM;
        u.pm = fm + ((wgid % nig) % gsz); u.pn = (wgid % nig) / gsz; return true;
    }
    __device__ __forceinline__ void a_ready(const Unit&) const {}
    __device__ __forceinline__ void done(const Unit&) const {}
};

template <class Epi, class Sched, bool ALIGN_EPI = false, bool SP2 = false>
__device__ __forceinline__ void gemm_phase(PG8_LAS unsigned char* lds, const Gemm g, const Sched& S, const Epi& E) {
    int tid_ = threadIdx.x; asm volatile("" : "+v"(tid_));
    const int tid = tid_, wid = __builtin_amdgcn_readfirstlane(tid >> 6), lane = tid & 63, wr = wid >> 2, wc = wid & 3, fr = lane & 15, fq = lane >> 4;
    const int K = g.K, nt = K / BK;
    unsigned voffA[2], voffB[2];
#pragma unroll
    for (int i = 0; i < 2; ++i) { int R, C; stage_rc(tid * 16 + i * 8192, R, C); const int Rb = Epi::PERM ? ((R & ~31) + perm32(R & 31)) : R;
        voffA[i] = (unsigned)(R * K + C) * 2u; voffB[i] = (unsigned)(Rb * K + C) * 2u; }
    const unsigned kstep = (unsigned)(BK * 2);
    const unsigned hstep = (unsigned)HALF * K * 2;
    const unsigned tstep = 2 * hstep;
    const __amdgpu_buffer_rsrc_t rsA = __builtin_amdgcn_make_buffer_rsrc((void*)g.A, (short)0, (int)((size_t)g.M * K * 2), 0x00020000), rsB = __builtin_amdgcn_make_buffer_rsrc((void*)g.Bt, (short)0, (int)((size_t)g.N * K * 2), 0x00020000);
    const unsigned ldsw = (unsigned)wid * 1024u;
    const int aoff = lds_byte(wr * 64 + fr, fq * 8), boff = lds_byte(wc * 32 + fr, fq * 8);
#define PG8_SA(b, h) (((b) * 2 + (h)) * HTB)
#define PG8_SB(b, h) ((4 + (b) * 2 + (h)) * HTB)
#define PG8_STAGE_(rs, bufoff, gbase, voff) do { _Pragma("unroll") for (int _i = 0; _i < 2; ++_i) \
        __builtin_amdgcn_raw_ptr_buffer_load_lds(rs, (PG8_LAS void*)(lds + (bufoff) + ldsw + _i * 8192), 16, (int)(voff)[_i], (int)(gbase), 0, 0); } while (0)
#define PG8_STAGE(bufoff, gbase, voff) PG8_STAGE_##voff(bufoff, gbase)
#define PG8_STAGE_voffA(bufoff, gbase) PG8_STAGE_(rsA, bufoff, gbase, voffA)
#define PG8_STAGE_voffB(bufoff, gbase) PG8_STAGE_(rsB, bufoff, gbase, voffB)
#define PG8_LDA(dst, b, h) do { _Pragma("unroll") for (int m = 0; m < 4; ++m) _Pragma("unroll") for (int k = 0; k < 2; ++k) dst[m][k] = *(const PG8_LAS bf16x8*)(lds + PG8_SA(b, h) + aoff + m * 2048 + k * 1024); } while (0)
#define PG8_LDB(dst, b, h) do { _Pragma("unroll") for (int n = 0; n < 2; ++n) _Pragma("unroll") for (int k = 0; k < 2; ++k) dst[n][k] = *(const PG8_LAS bf16x8*)(lds + PG8_SB(b, h) + boff + n * 2048 + k * 1024); } while (0)
#define PG8_MMA(ai, bj, At, Bt) do { __builtin_amdgcn_s_setprio(1); _Pragma("unroll") for (int m = 0; m < 4; ++m) _Pragma("unroll") for (int n = 0; n < 2; ++n) _Pragma("unroll") for (int k = 0; k < 2; ++k) \
        acc[ai][bj][m][n] = __builtin_amdgcn_mfma_f32_16x16x32_bf16(Bt[n][k], At[m][k], acc[ai][bj][m][n], 0, 0, 0); __builtin_amdgcn_s_setprio(0); } while (0)
#define PG8_WAIT_V(n) asm volatile("s_waitcnt vmcnt(" #n ")" ::: "memory")
#define PG8_WAIT_L(n) asm volatile("s_waitcnt lgkmcnt(" #n ")" ::: "memory")
#define PG8_BAR __builtin_amdgcn_s_barrier()
#define PG8_SCHED __builtin_amdgcn_sched_barrier(0)
    Unit cur, nxt; int ui = 0;
    if (!S.next(0, cur)) return;
    f32x4 acc[2][2][4][2];
#pragma unroll
    for (int a = 0; a < 2; ++a)
#pragma unroll
        for (int b = 0; b < 2; ++b)
#pragma unroll
            for (int m = 0; m < 4; ++m)
#pragma unroll
                for (int n = 0; n < 2; ++n) acc[a][b][m][n] = (f32x4){0.f, 0.f, 0.f, 0.f};
    bf16x8 At[4][2], B0[2][2], B1[2][2];
    unsigned cA = (unsigned)cur.pm * tstep, cB = (unsigned)cur.pn * tstep;
    S.a_ready(cur);
    if constexpr (SP2) {
        PG8_STAGE(PG8_SB(0, 0), cB, voffB); PG8_STAGE(PG8_SB(0, 1), cB + hstep, voffB); PG8_STAGE(PG8_SA(0, 0), cA, voffA); PG8_STAGE(PG8_SA(0, 1), cA + hstep, voffA);
        if (wr == 1) PG8_BAR;
        PG8_WAIT_V(2); PG8_BAR;
        PG8_STAGE(PG8_SB(1, 0), cB + kstep, voffB); PG8_STAGE(PG8_SA(1, 0), cA + kstep, voffA); PG8_STAGE(PG8_SB(1, 1), cB + hstep + kstep, voffB);
        PG8_WAIT_V(6); PG8_BAR;
    } else {
        PG8_STAGE(PG8_SB(0, 0), cB, voffB); PG8_STAGE(PG8_SA(0, 0), cA, voffA); PG8_STAGE(PG8_SB(0, 1), cB + hstep, voffB); PG8_STAGE(PG8_SA(0, 1), cA + hstep, voffA);
        if (wr == 1) PG8_BAR;
        PG8_WAIT_V(4); PG8_BAR;
        PG8_STAGE(PG8_SB(1, 0), cB + kstep, voffB); PG8_STAGE(PG8_SA(1, 0), cA + kstep, voffA); PG8_STAGE(PG8_SB(1, 1), cB + hstep + kstep, voffB);
        PG8_WAIT_V(6); PG8_BAR;
    }
    for (;;) {
        const bool has_next = S.next(ui + 1, nxt);
        const unsigned nA = has_next ? (unsigned)nxt.pm * tstep : cA, nB = has_next ? (unsigned)nxt.pn * tstep : cB;
        for (int t = 0; t < nt; t += 2) {
            const bool last = (t == nt - 2);
            const unsigned a1 = cA + (unsigned)(t + 1) * kstep;
            const unsigned a2 = last ? nA : cA + (unsigned)(t + 2) * kstep, b2 = last ? nB : cB + (unsigned)(t + 2) * kstep;
            const unsigned a3 = a2 + kstep, b3 = b2 + kstep;
            if (last && has_next) S.a_ready(nxt);
            if constexpr (SP2) {
            PG8_LDB(B0, 0, 0); PG8_LDB(B1, 0, 1); PG8_SCHED; PG8_LDA(At, 0, 0); PG8_STAGE(PG8_SA(1, 1), a1 + hstep, voffA);
            PG8_WAIT_V(8); PG8_WAIT_L(0); PG8_BAR; PG8_MMA(0, 0, At, B0); PG8_MMA(0, 1, At, B1); PG8_BAR; PG8_SCHED;
            PG8_LDA(At, 0, 1); PG8_STAGE(PG8_SB(0, 0), b2, voffB); PG8_STAGE(PG8_SB(0, 1), b2 + hstep, voffB); PG8_STAGE(PG8_SA(0, 0), a2, voffA);
            PG8_WAIT_V(8); PG8_WAIT_L(0); PG8_BAR; PG8_MMA(1, 0, At, B0); PG8_MMA(1, 1, At, B1); PG8_BAR; PG8_SCHED;
            PG8_LDB(B0, 1, 0); PG8_LDB(B1, 1, 1); PG8_SCHED; PG8_LDA(At, 1, 0); PG8_STAGE(PG8_SA(0, 1), a2 + hstep, voffA);
            PG8_WAIT_V(8); PG8_WAIT_L(0); PG8_BAR; PG8_MMA(0, 0, At, B0); PG8_MMA(0, 1, At, B1); PG8_BAR; PG8_SCHED;
            PG8_LDA(At, 1, 1); PG8_STAGE(PG8_SB(1, 0), b3, voffB); PG8_STAGE(PG8_SB(1, 1), b3 + hstep, voffB); PG8_STAGE(PG8_SA(1, 0), a3, voffA);
            PG8_WAIT_V(8); PG8_WAIT_L(0); PG8_BAR; PG8_MMA(1, 0, At, B0); PG8_MMA(1, 1, At, B1); PG8_BAR; PG8_SCHED;
            } else {
            PG8_LDB(B0, 0, 0); PG8_SCHED; PG8_LDA(At, 0, 0); PG8_STAGE(PG8_SA(1, 1), a1 + hstep, voffA);
            PG8_WAIT_L(8); PG8_BAR; PG8_WAIT_L(0); PG8_MMA(0, 0, At, B0); PG8_BAR; PG8_SCHED;
            PG8_LDB(B1, 0, 1); PG8_STAGE(PG8_SB(0, 0), b2, voffB);
            PG8_BAR; PG8_WAIT_L(0); PG8_MMA(0, 1, At, B1); PG8_BAR;
            PG8_LDA(At, 0, 1); PG8_STAGE(PG8_SA(0, 0), a2, voffA);
            PG8_BAR; PG8_WAIT_L(0); PG8_MMA(1, 0, At, B0); PG8_BAR; PG8_SCHED;
            PG8_STAGE(PG8_SB(0, 1), b2 + hstep, voffB);
            PG8_WAIT_V(6); PG8_BAR; PG8_MMA(1, 1, At, B1); PG8_BAR;
            PG8_LDB(B0, 1, 0); PG8_SCHED; PG8_LDA(At, 1, 0); PG8_STAGE(PG8_SA(0, 1), a2 + hstep, voffA);
            PG8_WAIT_L(8); PG8_BAR; PG8_WAIT_L(0); PG8_MMA(0, 0, At, B0); PG8_BAR; PG8_SCHED;
            PG8_LDB(B1, 1, 1); PG8_STAGE(PG8_SB(1, 0), b3, voffB);
            PG8_BAR; PG8_WAIT_L(0); PG8_MMA(0, 1, At, B1); PG8_BAR;
            PG8_LDA(At, 1, 1); PG8_STAGE(PG8_SA(1, 0), a3, voffA);
            PG8_BAR; PG8_WAIT_L(0); PG8_MMA(1, 0, At, B0); PG8_BAR; PG8_SCHED;
            PG8_STAGE(PG8_SB(1, 1), b3 + hstep, voffB);
            PG8_WAIT_V(6); PG8_BAR; PG8_MMA(1, 1, At, B1); PG8_BAR;
            }
        }
        if constexpr (ALIGN_EPI) { if (wr == 0) PG8_BAR; }
        if constexpr (!Epi::AFTER_DRAIN) { E(acc, cur, wr, wc, fr, fq); S.done(cur); }
        if (!has_next) break;
#pragma unroll
        for (int a = 0; a < 2; ++a)
#pragma unroll
            for (int b = 0; b < 2; ++b)
#pragma unroll
                for (int m = 0; m < 4; ++m)
#pragma unroll
                    for (int n = 0; n < 2; ++n) acc[a][b][m][n] = (f32x4){0.f, 0.f, 0.f, 0.f};
        cur = nxt; cA = nA; cB = nB; ++ui;
        if constexpr (ALIGN_EPI) { if (wr == 1) PG8_BAR; }
    }
    PG8_WAIT_V(0);
    if constexpr (!ALIGN_EPI) { if (wr == 0) PG8_BAR; }
    PG8_BAR;
    if constexpr (Epi::AFTER_DRAIN) { E.fused(acc, cur, wr, wc, fr, fq, lds, wid, lane); S.done(cur); }
#undef PG8_SA
#undef PG8_SB
#undef PG8_STAGE
#undef PG8_STAGE_
#undef PG8_STAGE_voffA
#undef PG8_STAGE_voffB
#undef PG8_LDA
#undef PG8_LDB
#undef PG8_MMA
#undef PG8_WAIT_V
#undef PG8_WAIT_L
#undef PG8_BAR
#undef PG8_SCHED
}
}

#define GAS __attribute__((address_space(1)))
#define LAS __attribute__((address_space(3)))
#define XB_TMO      128
#define XB_XCNT(j)  (256  + 64 * (j))
#define XB_XSUB(j)  (1280 + 64 * (j))
#define XB_XGEN(j)  (2304 + 64 * (j))
#define XB_TOP      3328
#define XB_TOPGEN   3392
#define XCD_BAR_WORDS 3456
#define XB_SPIN_CAP (1u << 18)

__device__ __forceinline__ unsigned xb_ld(unsigned* p)              { return __hip_atomic_load(p, __ATOMIC_RELAXED, __HIP_MEMORY_SCOPE_AGENT); }
__device__ __forceinline__ unsigned xb_add(unsigned* p, unsigned v) { return __hip_atomic_fetch_add(p, v, __ATOMIC_RELAXED, __HIP_MEMORY_SCOPE_AGENT); }
__device__ __forceinline__ unsigned xb_xcc_id() { return (unsigned)__builtin_amdgcn_s_getreg((3 << 11) | 20) & 0xFu; }
#define XB_SPIN(cond, bar) do { unsigned _sp = 0; while (cond) { __builtin_amdgcn_s_sleep(1); \
    if ((++_sp & 255u) == 0u) { if (xb_ld(&(bar)[XB_TMO])) break; if (_sp > XB_SPIN_CAP) { atomicAdd(&(bar)[XB_TMO], 1u); break; } } } } while (0)

struct XcdBarrier {
    unsigned n;
    unsigned* bar; unsigned x;
    volatile LAS unsigned* st;
};

__device__ __forceinline__ XcdBarrier xcd_barrier_post(unsigned* bar, volatile LAS unsigned* st, unsigned n) {
    XcdBarrier b; b.n = n; b.bar = bar; b.x = xb_xcc_id(); b.st = st;
    if (threadIdx.x == 0) (void)xb_add(&bar[XB_XCNT(b.x)], 1u);
    return b;
}
__device__ __forceinline__ void xcd_barrier_complete(unsigned* bar, unsigned x, unsigned G, unsigned& nloc, unsigned& nx) {
    unsigned sum, cnt, mine, sp = 0u;
    for (;;) {
        sum = 0u; cnt = 0u; mine = 0u;
#pragma unroll
        for (unsigned j = 0; j < 16; ++j) { const unsigned c = xb_ld(&bar[XB_XCNT(j)]); sum += c; cnt += (c > 0u) ? 1u : 0u; mine = (j == x) ? c : mine; }
        if (sum == G) break;
        __builtin_amdgcn_s_sleep(1);
        if ((++sp & 255u) == 0u) { if (xb_ld(&bar[XB_TMO])) break; if (sp > XB_SPIN_CAP) { atomicAdd(&bar[XB_TMO], 1u); break; } }
    }
    nloc = mine > 0u ? mine : 1u; nx = cnt > 0u ? cnt : 1u;
}

__device__ __forceinline__ void xcd_barrier(const XcdBarrier& b) {
    asm volatile("s_waitcnt vmcnt(0)" ::: "memory");
    __syncthreads();
    if (threadIdx.x == 0) {
        unsigned* bar = b.bar;
        __builtin_amdgcn_s_waitcnt(0);
        unsigned nloc = b.st[0], nx = b.st[1];
        if (nloc == 0u) { xcd_barrier_complete(bar, b.x, b.n, nloc, nx); b.st[0] = nloc; b.st[1] = nx; }
        const unsigned old = xb_add(&bar[XB_XSUB(b.x)], 1u);
        const unsigned gen = old / nloc;
        if (old + 1u == (gen + 1u) * nloc) {
            __builtin_amdgcn_fence(__ATOMIC_RELEASE, "agent");
            asm volatile("s_waitcnt vmcnt(0)" ::: "memory");
            const unsigned og = xb_add(&bar[XB_TOP], 1u);
            const unsigned tg = og / nx;
            if (og + 1u == (tg + 1u) * nx) xb_add(&bar[XB_TOPGEN], 1u);
            else XB_SPIN(xb_ld(&bar[XB_TOPGEN]) == tg, bar);
            __builtin_amdgcn_fence(__ATOMIC_ACQUIRE, "agent");
            xb_add(&bar[XB_XGEN(b.x)], 1u);
            asm volatile("s_waitcnt vmcnt(0)" ::: "memory");
        } else {
            XB_SPIN(xb_ld(&bar[XB_XGEN(b.x)]) == gen, bar);
            __builtin_amdgcn_fence(__ATOMIC_ACQUIRE, "agent");
            asm volatile("s_waitcnt vmcnt(0)" ::: "memory");
        }
    }
    __syncthreads();
}

#define LDS_WAIT() asm volatile("s_waitcnt lgkmcnt(0)" ::: "memory")
#define VM_WAIT() asm volatile("s_waitcnt vmcnt(0)" ::: "memory")
typedef unsigned v4u __attribute__((ext_vector_type(4)));
typedef unsigned v2u __attribute__((ext_vector_type(2)));
constexpr int NWAVES = 8;
constexpr int RING_BYTES = 131072, LDSCTL_OFF = RING_BYTES, MISC_OFF = LDSCTL_OFF + 320, LDS_BYTES = 147456;
constexpr int CW_GBAR = 835584;
constexpr int NGROUPS = 4;
constexpr int CW_SGBAR = CW_GBAR + 8 * XCD_BAR_WORDS;
static_assert((CW_SGBAR + 8 * XCD_BAR_WORDS) * 4 <= CTL_BYTES, "control region");
constexpr int CW_TMO = 0, CW_BAR = 1024;
constexpr size_t CT_BIAS = 1572864;
constexpr size_t CT_GATE = CT_BIAS + (size_t)DEPTH * 3 * NB * NGU * 4;
constexpr size_t CT_GM = CT_GATE + (size_t)DEPTH * 3 * NB * D * 4;
static_assert(CT_END <= CT_BIAS && CT_GM + (size_t)DEPTH * 3 * NB * D * 4 <= (size_t)CW_GBAR * 4 && ((size_t)CW_GBAR + 8 * 3456) * 4 <= CTL_BYTES, "ctl map");
constexpr size_t WT_GU1 = 0, WT_DN1 = WT_GU1 + (size_t)NGU * D * 2, WT_IN = WT_DN1 + (size_t)D * FF * 2, WT_UQ = WT_IN + (size_t)4096 * D * 2,
                 WT_UKV = WT_UQ + (size_t)1536 * 512 * 2, WT_OUT = WT_UKV + (size_t)2048 * 256 * 2, WT_GU2 = WT_OUT + (size_t)D * D * 2, WT_DN2 = WT_GU2 + (size_t)NGU * D * 2,
                 WT_LAYER = WT_DN2 + (size_t)D * FF * 2;
static_assert(2 * WT_LAYER <= 340 * MiB, "wt");
constexpr int NPIN = 4096;

__device__ __forceinline__ unsigned pk2(float lo, float hi) { return (unsigned)f2bf(lo) | ((unsigned)f2bf(hi) << 16); }
__device__ __forceinline__ unsigned cvtpk(float lo, float hi) { unsigned r; asm volatile("v_cvt_pk_bf16_f32 %0, %1, %2" : "=v"(r) : "v"(lo), "v"(hi)); return r; }
__device__ __forceinline__ float fsilu(float x) { return x * __builtin_amdgcn_rcpf(1.f + __expf(-x)); }

__device__ __forceinline__ int src_block(int kind, int nb) {
    const int pn = nb >> 3, jb = nb & 7;
    if (kind == 0) return 32 * nb;
    if (kind == 1) return (jb < 4) ? 128 * pn + 32 * jb : FF + 128 * pn + 32 * (jb - 4);
    if (kind == 2) {
        if (pn < 4) { const int rb = pn < 2 ? C_QR : C_KR; return rb + (4 * (pn & 1) + (jb & 3)) * 64 + 32 * (jb >> 2); }
        if (pn < 15) return 256 * pn + 32 * jb;
        return jb == 0 ? C_KPE : (jb == 4 ? C_KPE + 32 : -1);
    }
    if (pn < 4) return (2 * pn + (jb >> 2)) * DQK + 32 * (jb & 3);
    return (4 * (pn - 4) + (jb & 3)) * DQK + NOPE + 32 * (jb >> 2);
}
struct CvtDesc { const float* W; const float* scale; bf16_t* WT; const float* sh; float* bias; int ldw, K, k0, src0, dst0; };
__device__ __forceinline__ void cvt_load(const CvtDesc& d, f32x4 (&v)[8], int lane) {
    if (d.src0 >= 0) {
#pragma unroll
        for (int i = 0; i < 8; ++i) { const int row = i * 8 + (lane >> 3); v[i] = *(const f32x4*)(d.W + (size_t)(d.k0 + row) * d.ldw + d.src0 + 4 * (lane & 7)); }
    } else {
#pragma unroll
        for (int i = 0; i < 8; ++i) v[i] = (f32x4){0.f, 0.f, 0.f, 0.f};
    }
}
__device__ __forceinline__ void cvt_process(const CvtDesc& d, f32x4 (&v)[8], LAS float* scr, LAS float* shs, int lane) {
    if (d.scale) {
#pragma unroll
        for (int i = 0; i < 8; ++i) v[i] *= d.scale[d.k0 + i * 8 + (lane >> 3)]; }
#pragma unroll
    for (int i = 0; i < 8; ++i) { LAS float* q = scr + (i * 8 + (lane >> 3)) * 33 + 4 * (lane & 7); q[0] = v[i][0]; q[1] = v[i][1]; q[2] = v[i][2]; q[3] = v[i][3]; }
    const bool wb = d.sh && d.src0 >= 0;
    if (wb) {
#pragma unroll
        for (int j = 0; j < 4; ++j) shs[lane * 4 + j] = d.sh[(size_t)j * NMOD * D + d.k0 + lane];
    }
    LDS_WAIT(); asm volatile("" ::: "memory");
    const int c = lane & 7;
#pragma unroll
    for (int j = 0; j < 4; ++j) { const int n = (lane >> 3) + 8 * j; const LAS float* s = scr + (8 * c) * 33 + n;
        v4u o; o.x = pk2(s[0 * 33], s[1 * 33]); o.y = pk2(s[2 * 33], s[3 * 33]); o.z = pk2(s[4 * 33], s[5 * 33]); o.w = pk2(s[6 * 33], s[7 * 33]);
        *(v4u*)(d.WT + (size_t)(d.dst0 + n) * d.K + d.k0 + 8 * c) = o; }
    if (wb) {
        const int n = lane & 31, kh = lane >> 5; f32x4 a = {0.f, 0.f, 0.f, 0.f};
#pragma unroll 8
        for (int kk = 0; kk < 32; ++kk) { const int kq = kh * 32 + kk; a += *(const LAS f32x4*)(shs + kq * 4) * scr[kq * 33 + n]; }
#pragma unroll
        for (int j = 0; j < 4; ++j) { float t = a[j]; t += __shfl_xor(t, 32); if (lane < 32) __hip_atomic_fetch_add(d.bias + (size_t)j * NGU + d.dst0 + n, t, __ATOMIC_RELAXED, __HIP_MEMORY_SCOPE_AGENT); }
    }
    LDS_WAIT(); asm volatile("" ::: "memory");
}

struct EpiGU {
    static constexpr bool PERM = true, AFTER_DRAIN = false;
    bf16_t* act; const float* ss; const float* bias; int pm0, pad_;
    __device__ __forceinline__ void operator()(const f32x4 (&acc)[2][2][4][2], const pg8::Unit& u, int wr, int wc, int fr, int fq) const {
        const int pm = u.pm + pm0, row0 = pm * 256 + wr * 64 + fr, b = pm >> 4, cb = u.pn * 256 + wc * 32 + 8 * fq, oc = u.pn * 128 + wc * 32 + 8 * fq;
        const float* bp = bias + (size_t)b * NGU + cb;
        const f32x4 bg0 = *(const f32x4*)bp, bg1 = *(const f32x4*)(bp + 4), bu0 = *(const f32x4*)(bp + 128), bu1 = *(const f32x4*)(bp + 132);
        float rsv[2][4];
#pragma unroll
        for (int ai = 0; ai < 2; ++ai)
#pragma unroll
            for (int m = 0; m < 4; ++m) rsv[ai][m] = ss[row0 + ai * 128 + m * 16];
        constexpr float NL2E = -1.4426950408889634f;
        const f32x4 cg0 = bg0 * NL2E, cg1 = bg1 * NL2E;
#pragma unroll
        for (int ai = 0; ai < 2; ++ai)
#pragma unroll
            for (int m = 0; m < 4; ++m) { const int row = row0 + ai * 128 + m * 16; const float rs = rsqrtf(rsv[ai][m] * (1.f / D) + EPS), rsn = rs * NL2E;
                const f32x4 g0 = acc[ai][0][m][0] * rs + bg0, g1 = acc[ai][0][m][1] * rs + bg1, u0 = acc[ai][1][m][0] * rs + bu0, u1 = acc[ai][1][m][1] * rs + bu1;
                f32x4 e0 = acc[ai][0][m][0] * rsn + cg0, e1 = acc[ai][0][m][1] * rsn + cg1;
#pragma unroll
                for (int i = 0; i < 4; ++i) { e0[i] = __builtin_amdgcn_exp2f(e0[i]); e1[i] = __builtin_amdgcn_exp2f(e1[i]); }
                e0 = e0 + 1.f; e1 = e1 + 1.f;
#pragma unroll
                for (int i = 0; i < 4; ++i) { e0[i] = __builtin_amdgcn_rcpf(e0[i]); e1[i] = __builtin_amdgcn_rcpf(e1[i]); }
                const f32x4 o0 = (g0 * u0) * e0, o1 = (g1 * u1) * e1;
                v4u w; w.x = cvtpk(o0[0], o0[1]); w.y = cvtpk(o0[2], o0[3]); w.z = cvtpk(o1[0], o1[1]); w.w = cvtpk(o1[2], o1[3]);
                *(v4u*)(act + (size_t)row * FF + oc) = w; }
    }
};
typedef _Float16 f16_t;
typedef _Float16 f16x8 __attribute__((ext_vector_type(8)));
template <bool XF32> struct EpiRes {
    static constexpr bool PERM = true, AFTER_DRAIN = false;
    const float* xin32; const f16_t* xin16; f16_t* xout; bf16_t* xg; float* ssn; const float* gatef; const float* gmn; int has_next, pm0;
    __device__ __forceinline__ void operator()(const f32x4 (&acc)[2][2][4][2], const pg8::Unit& u, int wr, int wc, int fr, int fq) const {
        const int pm = u.pm + pm0, row0 = pm * 256 + wr * 64 + fr, b = pm >> 4, c0 = u.pn * 256 + wc * 32 + 8 * fq;
        const float* gp = gatef + (size_t)b * D + c0; const float* mp = gmn + (size_t)b * D + c0;
        f32x4 gt[2][2], gm[2][2];
#pragma unroll
        for (int bj = 0; bj < 2; ++bj)
#pragma unroll
            for (int n = 0; n < 2; ++n) { gt[bj][n] = *(const f32x4*)(gp + bj * 128 + 4 * n); gm[bj][n] = has_next ? *(const f32x4*)(mp + bj * 128 + 4 * n) : (f32x4){0.f, 0.f, 0.f, 0.f}; }
        f32x4 xv[2][2][2][2]; f16x8 xh[2][2][2];
#define ER_LOAD(q) do { _Pragma("unroll") for (int mm = 0; mm < 2; ++mm) _Pragma("unroll") for (int bj = 0; bj < 2; ++bj) { \
            const size_t off_ = (size_t)(row0 + ((q) >> 1) * 128 + (2 * ((q) & 1) + mm) * 16) * D + c0 + bj * 128; \
            if constexpr (XF32) { xv[(q) & 1][mm][bj][0] = *(const f32x4*)(xin32 + off_); xv[(q) & 1][mm][bj][1] = *(const f32x4*)(xin32 + off_ + 4); } \
            else { xh[(q) & 1][mm][bj] = *(const f16x8*)(xin16 + off_); } } } while (0)
        if constexpr (!XF32) ER_LOAD(0);
        float sqa[4];
#pragma unroll
        for (int q = 0; q < 4; ++q) { const int ai = q >> 1;
            if constexpr (XF32) ER_LOAD(q); else if (q + 1 < 4) ER_LOAD(q + 1);
#pragma unroll
            for (int mm = 0; mm < 2; ++mm) { const int m = 2 * (q & 1) + mm, row = row0 + ai * 128 + m * 16; float sq = 0.f;
#pragma unroll
                for (int bj = 0; bj < 2; ++bj) { const size_t off = (size_t)row * D + c0 + bj * 128;
                    f32x4 x0, x1;
                    if constexpr (XF32) { x0 = xv[q & 1][mm][bj][0]; x1 = xv[q & 1][mm][bj][1]; }
                    else { const f16x8 h = xh[q & 1][mm][bj]; x0 = (f32x4){(float)h[0], (float)h[1], (float)h[2], (float)h[3]}; x1 = (f32x4){(float)h[4], (float)h[5], (float)h[6], (float)h[7]}; }
                    const f32x4 n0 = x0 + gt[bj][0] * acc[ai][bj][m][0], n1 = x1 + gt[bj][1] * acc[ai][bj][m][1];
                    { f16x8 o; o[0] = (f16_t)n0[0]; o[1] = (f16_t)n0[1]; o[2] = (f16_t)n0[2]; o[3] = (f16_t)n0[3]; o[4] = (f16_t)n1[0]; o[5] = (f16_t)n1[1]; o[6] = (f16_t)n1[2]; o[7] = (f16_t)n1[3];
                      *(f16x8*)(xout + off) = o; }
                    sq += (n0[0] * n0[0] + n0[1] * n0[1]) + (n0[2] * n0[2] + n0[3] * n0[3]) + (n1[0] * n1[0] + n1[1] * n1[1]) + (n1[2] * n1[2] + n1[3] * n1[3]);
                    if (has_next) { const f32x4 a = n0 * gm[bj][0], c2 = n1 * gm[bj][1];
                        v4u w; w.x = cvtpk(a[0], a[1]); w.y = cvtpk(a[2], a[3]); w.z = cvtpk(c2[0], c2[1]); w.w = cvtpk(c2[2], c2[3]);
                        *(v4u*)(xg + off) = w; } }
                sq += __shfl_xor(sq, 16); sq += __shfl_xor(sq, 32); sqa[m] = sq; }
            if (q & 1) { const float sv = fq == 0 ? sqa[0] : fq == 1 ? sqa[1] : fq == 2 ? sqa[2] : sqa[3];
                __hip_atomic_fetch_add(ssn + (pm * 256 + wr * 64 + ai * 128 + fq * 16 + fr), sv, __ATOMIC_RELAXED, __HIP_MEMORY_SCOPE_AGENT); }
            asm volatile("" ::: "memory"); }
#undef ER_LOAD
    }
};
struct EpiIn {
    static constexpr bool PERM = true, AFTER_DRAIN = false;
    const float* ss; const float* bias; const float* cosT; const float* sinT;
    bf16_t *qr, *kr, *vr, *gr, *cq, *ckv, *Kb; float *ssq, *sskv; int pm0, pad_;
    __device__ __forceinline__ void operator()(const f32x4 (&acc)[2][2][4][2], const pg8::Unit& u, int wr, int wc, int fr, int fq) const {
        const int pm = u.pm + pm0, row0 = pm * 256 + wr * 64 + fr, b = pm >> 4, pn = u.pn, cb = pn * 256 + wc * 32 + 8 * fq;
        const float* bp = bias + (size_t)b * NGU + cb;
        const f32x4 b00 = *(const f32x4*)bp, b01 = *(const f32x4*)(bp + 4), b10 = *(const f32x4*)(bp + 128), b11 = *(const f32x4*)(bp + 132);
        float rsv[2][4];
#pragma unroll
        for (int ai = 0; ai < 2; ++ai)
#pragma unroll
            for (int m = 0; m < 4; ++m) rsv[ai][m] = ss[row0 + ai * 128 + m * 16];
        asm volatile("" :: "v"(b00), "v"(b01), "v"(b10), "v"(b11), "v"(rsv[0][0]), "v"(rsv[0][1]), "v"(rsv[0][2]), "v"(rsv[0][3]), "v"(rsv[1][0]), "v"(rsv[1][1]), "v"(rsv[1][2]), "v"(rsv[1][3]));
        if (pn == 15 && wc != 0) return;
        if (pn < 4 || pn == 15) {
            const float scale = (pn == 2 || pn == 3) ? 0.125f : 1.0f;
#pragma unroll
            for (int ai = 0; ai < 2; ++ai)
#pragma unroll
                for (int m = 0; m < 4; ++m) { const int row = row0 + ai * 128 + m * 16; const float rs = rsqrtf(rsv[ai][m] * (1.f / D) + EPS);
                    const f32x4 x10 = acc[ai][0][m][0] * rs + b00, x11 = acc[ai][0][m][1] * rs + b01, x20 = acc[ai][1][m][0] * rs + b10, x21 = acc[ai][1][m][1] * rs + b11;
                    const f32x4 c0 = *(const f32x4*)(cosT + (size_t)row * 32 + 8 * fq), c1 = *(const f32x4*)(cosT + (size_t)row * 32 + 8 * fq + 4);
                    const f32x4 s0 = *(const f32x4*)(sinT + (size_t)row * 32 + 8 * fq), s1 = *(const f32x4*)(sinT + (size_t)row * 32 + 8 * fq + 4);
                    const f32x4 o10 = (x10 * c0 - x20 * s0) * scale, o11 = (x11 * c1 - x21 * s1) * scale, o20 = (x10 * s0 + x20 * c0) * scale, o21 = (x11 * s1 + x21 * c1) * scale;
                    v4u w1, w2; w1.x = cvtpk(o10[0], o10[1]); w1.y = cvtpk(o10[2], o10[3]); w1.z = cvtpk(o11[0], o11[1]); w1.w = cvtpk(o11[2], o11[3]);
                    w2.x = cvtpk(o20[0], o20[1]); w2.y = cvtpk(o20[2], o20[3]); w2.z = cvtpk(o21[0], o21[1]); w2.w = cvtpk(o21[2], o21[3]);
                    if (pn < 4) { bf16_t* dst = (pn < 2 ? qr : kr) + (size_t)row * 512 + (4 * (pn & 1) + wc) * 64 + 8 * fq; *(v4u*)dst = w1; *(v4u*)(dst + 32) = w2; }
                    else {
#pragma unroll
                        for (int h = 0; h < MH; ++h) { bf16_t* dst = Kb + (size_t)row * MH * DQK + h * DQK + NOPE + 8 * fq; *(v4u*)dst = w1; *(v4u*)(dst + 32) = w2; } }
                    asm volatile("" ::: "memory"); }
        } else {
            bf16_t* dbase; int ld; float* ssp = nullptr;
            if (pn < 8) { dbase = vr + (pn - 4) * 256; ld = 1024; } else if (pn < 12) { dbase = gr + (pn - 8) * 256; ld = 1024; }
            else if (pn < 14) { dbase = cq + (pn - 12) * 256; ld = 512; ssp = ssq; } else { dbase = ckv; ld = 256; ssp = sskv; }
            const bool gate = (pn >= 8 && pn < 12);
#pragma unroll
            for (int ai = 0; ai < 2; ++ai)
#pragma unroll
                for (int m = 0; m < 4; ++m) { const int row = row0 + ai * 128 + m * 16; const float rs = rsqrtf(rsv[ai][m] * (1.f / D) + EPS); float q = 0.f;
#pragma unroll
                    for (int bj = 0; bj < 2; ++bj) { f32x4 v0 = acc[ai][bj][m][0] * rs + (bj ? b10 : b00), v1 = acc[ai][bj][m][1] * rs + (bj ? b11 : b01);
                        q += (v0[0] * v0[0] + v0[1] * v0[1]) + (v0[2] * v0[2] + v0[3] * v0[3]) + (v1[0] * v1[0] + v1[1] * v1[1]) + (v1[2] * v1[2] + v1[3] * v1[3]);
                        if (gate) {
#pragma unroll
                            for (int i = 0; i < 4; ++i) { v0[i] = fsilu(v0[i]); v1[i] = fsilu(v1[i]); } }
                        v4u w; w.x = cvtpk(v0[0], v0[1]); w.y = cvtpk(v0[2], v0[3]); w.z = cvtpk(v1[0], v1[1]); w.w = cvtpk(v1[2], v1[3]);
                        *(v4u*)(dbase + (size_t)row * ld + bj * 128 + wc * 32 + 8 * fq) = w; }
                    if (ssp) { q += __shfl_xor(q, 16); q += __shfl_xor(q, 32); if (fq == 0) __hip_atomic_fetch_add(ssp + row, q, __ATOMIC_RELAXED, __HIP_MEMORY_SCOPE_AGENT); }
                    asm volatile("" ::: "memory"); }
        }
    }
};
struct EpiUq {
    static constexpr bool PERM = true, AFTER_DRAIN = false;
    const float* ssq; const float* cosT; const float* sinT; bf16_t* Qb; int pm0, pad_;
    __device__ __forceinline__ void operator()(const f32x4 (&acc)[2][2][4][2], const pg8::Unit& u, int wr, int wc, int fr, int fq) const {
        const int row0 = (u.pm + pm0) * 256 + wr * 64 + fr, pn = u.pn;
        float rsv[2][4];
#pragma unroll
        for (int ai = 0; ai < 2; ++ai)
#pragma unroll
            for (int m = 0; m < 4; ++m) rsv[ai][m] = ssq[row0 + ai * 128 + m * 16];
#pragma unroll
        for (int ai = 0; ai < 2; ++ai)
#pragma unroll
            for (int m = 0; m < 4; ++m) { const int row = row0 + ai * 128 + m * 16; const float rs = rsqrtf(rsv[ai][m] * (1.f / QRANK) + EPS);
                if (pn < 4) {
#pragma unroll
                    for (int bj = 0; bj < 2; ++bj) { const f32x4 v0 = acc[ai][bj][m][0] * rs, v1 = acc[ai][bj][m][1] * rs;
                        v4u w; w.x = cvtpk(v0[0], v0[1]); w.y = cvtpk(v0[2], v0[3]); w.z = cvtpk(v1[0], v1[1]); w.w = cvtpk(v1[2], v1[3]);
                        *(v4u*)(Qb + (size_t)row * MH * DQK + (2 * pn + bj) * DQK + wc * 32 + 8 * fq) = w; }
                } else {
                    const f32x4 x10 = acc[ai][0][m][0] * rs, x11 = acc[ai][0][m][1] * rs, x20 = acc[ai][1][m][0] * rs, x21 = acc[ai][1][m][1] * rs;
                    const f32x4 c0 = *(const f32x4*)(cosT + (size_t)row * 32 + 8 * fq), c1 = *(const f32x4*)(cosT + (size_t)row * 32 + 8 * fq + 4);
                    const f32x4 s0 = *(const f32x4*)(sinT + (size_t)row * 32 + 8 * fq), s1 = *(const f32x4*)(sinT + (size_t)row * 32 + 8 * fq + 4);
                    const f32x4 o10 = x10 * c0 - x20 * s0, o11 = x11 * c1 - x21 * s1, o20 = x10 * s0 + x20 * c0, o21 = x11 * s1 + x21 * c1;
                    v4u w1, w2; w1.x = cvtpk(o10[0], o10[1]); w1.y = cvtpk(o10[2], o10[3]); w1.z = cvtpk(o11[0], o11[1]); w1.w = cvtpk(o11[2], o11[3]);
                    w2.x = cvtpk(o20[0], o20[1]); w2.y = cvtpk(o20[2], o20[3]); w2.z = cvtpk(o21[0], o21[1]); w2.w = cvtpk(o21[2], o21[3]);
                    bf16_t* dst = Qb + (size_t)row * MH * DQK + (4 * (pn - 4) + wc) * DQK + NOPE + 8 * fq; *(v4u*)dst = w1; *(v4u*)(dst + 32) = w2;
                }
                asm volatile("" ::: "memory"); }
    }
};
struct EpiUkv {
    static constexpr bool PERM = true, AFTER_DRAIN = false;
    const float* sskv; bf16_t* Kb; bf16_t* Vb; int pm0, pad_;
    __device__ __forceinline__ void operator()(const f32x4 (&acc)[2][2][4][2], const pg8::Unit& u, int wr, int wc, int fr, int fq) const {
        const int row0 = (u.pm + pm0) * 256 + wr * 64 + fr, pn = u.pn;
        float rsv[2][4];
#pragma unroll
        for (int ai = 0; ai < 2; ++ai)
#pragma unroll
            for (int m = 0; m < 4; ++m) rsv[ai][m] = sskv[row0 + ai * 128 + m * 16];
#pragma unroll
        for (int ai = 0; ai < 2; ++ai)
#pragma unroll
            for (int m = 0; m < 4; ++m) { const int row = row0 + ai * 128 + m * 16; const float rs = rsqrtf(rsv[ai][m] * (1.f / KVRANK) + EPS);
#pragma unroll
                for (int bj = 0; bj < 2; ++bj) { const f32x4 v0 = acc[ai][bj][m][0] * rs, v1 = acc[ai][bj][m][1] * rs;
                    v4u w; w.x = cvtpk(v0[0], v0[1]); w.y = cvtpk(v0[2], v0[3]); w.z = cvtpk(v1[0], v1[1]); w.w = cvtpk(v1[2], v1[3]);
                    bf16_t* dst = bj ? Vb + (size_t)row * MH * MDV + pn * MDV + wc * 32 + 8 * fq : Kb + (size_t)row * MH * DQK + pn * DQK + wc * 32 + 8 * fq;
                    *(v4u*)dst = w; }
                asm volatile("" ::: "memory"); }
    }
};

namespace att {
typedef short s16x4 __attribute__((ext_vector_type(4)));
typedef float f32x16 __attribute__((ext_vector_type(16)));
constexpr int SHM_V = 64 * 128 * 2, SHM_K = 64 * DQK * 2;
constexpr int V_OFF = 0, K_OFF = 2 * SHM_V, WS_OFF = K_OFF + 2 * SHM_K;
constexpr float SCALE = 0.07216878364870323f;
constexpr float THR = 8.f;
#define ATT_SBAR() __builtin_amdgcn_sched_barrier(0)
__device__ __forceinline__ int v_st(int k, int c) { const int kk = (k & ~0xC) | ((k & 4) << 1) | ((k & 8) >> 1); return ((kk >> 3) * 4 + (c >> 5)) * 512 + ((kk & 7) * 32 + (c & 31)) * 2; }
__device__ __forceinline__ int v_rd_base(int lane) { return ((lane & 3) << 3) | (((lane >> 2) & 3) << 6) | (((lane >> 4) & 1) << 5) | (((lane >> 5) & 1) << 8); }
constexpr int v_rd_off(int d0, int ks, int half) { return d0 * 512 + ks * 4096 + half * 2048; }
__device__ __forceinline__ int crow(int r, int hi) { return (r & 3) + 8 * (r >> 2) + 4 * hi; }
__device__ __forceinline__ int k_off(int r, int ch) { return r * 384 + (((ch & ~7) | ((ch ^ (r >> 1)) & 7)) << 4); }
__device__ __forceinline__ void mask_tile(f32x16& p0, f32x16& p1, int dq) {
    const float NEG = -__builtin_inff();
#pragma unroll
    for (int r = 0; r < 16; ++r) { const int c = (r & 3) + 8 * (r >> 2); if (dq - c < 0) p0[r] = NEG; if (dq - c - 32 < 0) p1[r] = NEG; }
}
__device__ __forceinline__ void partialSM(f32x16& p0, f32x16& p1, float& m_reg, float& mn, float& alpha) {
    float pmax = p0[0];
#pragma unroll
    for (int r = 1; r < 16; ++r) pmax = fmaxf(pmax, p0[r]);
#pragma unroll
    for (int r = 0; r < 16; ++r) pmax = fmaxf(pmax, p1[r]);
    { auto rr = __builtin_amdgcn_permlane32_swap(__float_as_uint(pmax), __float_as_uint(pmax), false, false);
      pmax = fmaxf(__uint_as_float(rr[0]), __uint_as_float(rr[1])); }
    constexpr float C2 = 1.4426950408889634f * SCALE;
    if (__builtin_expect(__all((pmax - m_reg) * SCALE <= THR), 1)) { mn = m_reg; alpha = 1.f; }
    else { mn = fmaxf(m_reg, pmax); alpha = __builtin_amdgcn_exp2f((m_reg - mn) * C2); m_reg = mn; }
    const float mnL = -mn * C2;
#pragma unroll
    for (int r = 0; r < 16; ++r) p0[r] = fmaf(p0[r], C2, mnL);
#pragma unroll
    for (int r = 0; r < 16; ++r) p1[r] = fmaf(p1[r], C2, mnL);
#pragma unroll
    for (int r = 0; r < 16; ++r) p0[r] = __builtin_amdgcn_exp2f(p0[r]);
}
#define ATT_PK4(P, B_, OUT) do { unsigned a0 = cvtpk(P[B_+0], P[B_+1]), a1 = cvtpk(P[B_+2], P[B_+3]); unsigned b0 = cvtpk(P[B_+4], P[B_+5]), b1 = cvtpk(P[B_+6], P[B_+7]); \
        auto r0 = __builtin_amdgcn_permlane32_swap(a0, b0, false, false); auto r1 = __builtin_amdgcn_permlane32_swap(a1, b1, false, false); \
        v4u w = {r0[0], r1[0], r0[1], r1[1]}; OUT = *reinterpret_cast<bf16x8*>(&w); } while (0)
__device__ __forceinline__ void pack_p(const f32x16& p0, const f32x16& p1, bf16x8& pa0, bf16x8& pa1, bf16x8& pa2, bf16x8& pa3) {
    ATT_PK4(p0, 0, pa0); ATT_PK4(p0, 8, pa1); ATT_PK4(p1, 0, pa2); ATT_PK4(p1, 8, pa3);
}
__device__ __forceinline__ void finishSM(f32x16& p0, f32x16& p1, float alpha, float& l_reg, bf16x8& pa0, bf16x8& pa1, bf16x8& pa2, bf16x8& pa3) {
#pragma unroll
    for (int r = 0; r < 16; ++r) p1[r] = __builtin_amdgcn_exp2f(p1[r]);
    float ps = 0;
#pragma unroll
    for (int r = 0; r < 16; ++r) ps += p0[r];
#pragma unroll
    for (int r = 0; r < 16; ++r) ps += p1[r];
    { auto rr = __builtin_amdgcn_permlane32_swap(__float_as_uint(ps), __float_as_uint(ps), false, false);
      ps = __uint_as_float(rr[0]) + __uint_as_float(rr[1]); }
    l_reg = l_reg * alpha + ps;
    pack_p(p0, p1, pa0, pa1, pa2, pa3);
}
template <int ND, int KROW>
__device__ __forceinline__ void qkt(f32x16& p0, f32x16& p1, const LAS unsigned char* kbuf, int r32, int hi, const bf16x8* qf) {
    p0 = f32x16{}; p1 = f32x16{};
    int ka[4];
#pragma unroll
    for (int dd = 0; dd < 4; ++dd) ka[dd] = (int)(uintptr_t)kbuf + r32 * KROW + ((((2 * dd + hi) ^ (r32 >> 1)) & 7) << 4);
    bf16x8 f0[2], f1[2];
#define ATT_KRD(dst, addr, off) asm volatile("ds_read_b128 %0, %1 offset:%2" : "=&v"(dst) : "v"(addr), "i"(off) : "memory")
    __builtin_amdgcn_sched_barrier(0);
    ATT_KRD(f0[0], ka[0], 0); ATT_KRD(f1[0], ka[0], 32 * KROW);
#pragma unroll
    for (int d0 = 0; d0 < ND; ++d0) {
        if (d0 + 1 < ND) { ATT_KRD(f0[(d0 + 1) & 1], ka[(d0 + 1) & 3], ((d0 + 1) >> 2) * 128); ATT_KRD(f1[(d0 + 1) & 1], ka[(d0 + 1) & 3], ((d0 + 1) >> 2) * 128 + 32 * KROW); }
        if (d0 + 1 < ND) asm volatile("s_waitcnt lgkmcnt(2)" ::: "memory"); else asm volatile("s_waitcnt lgkmcnt(0)" ::: "memory");
        __builtin_amdgcn_sched_barrier(0);
        p0 = __builtin_amdgcn_mfma_f32_32x32x16_bf16(f0[d0 & 1], qf[d0], p0, 0, 0, 0);
        p1 = __builtin_amdgcn_mfma_f32_32x32x16_bf16(f1[d0 & 1], qf[d0], p1, 0, 0, 0);
        __builtin_amdgcn_sched_barrier(0);
    }
#undef ATT_KRD
}
template <int VB>
__device__ __forceinline__ void pv_tile(f32x16* o, int vb0, bf16x8 pa0, bf16x8 pa1, bf16x8 pa2, bf16x8 pa3) {
#define ATT_TRRD(dst, off) asm volatile("ds_read_b64_tr_b16 %0, %1 offset:%2" : "=&v"(dst) : "v"(vb0), "i"(off) : "memory")
#define ATT_PV_D0(d0) do { s16x4 l0, l1, l2, l3, h0, h1, h2, h3; constexpr int b_ = VB * SHM_V + v_rd_off(d0, 0, 0); \
        ATT_TRRD(l0, b_); ATT_TRRD(h0, b_ + 2048); ATT_TRRD(l1, b_ + 4096); ATT_TRRD(h1, b_ + 6144); ATT_TRRD(l2, b_ + 8192); ATT_TRRD(h2, b_ + 10240); ATT_TRRD(l3, b_ + 12288); ATT_TRRD(h3, b_ + 14336); \
        asm volatile("s_waitcnt lgkmcnt(0)" ::: "memory"); ATT_SBAR(); \
        o[d0] = __builtin_amdgcn_mfma_f32_32x32x16_bf16(pa0, (bf16x8){l0[0], l0[1], l0[2], l0[3], h0[0], h0[1], h0[2], h0[3]}, o[d0], 0, 0, 0); \
        o[d0] = __builtin_amdgcn_mfma_f32_32x32x16_bf16(pa1, (bf16x8){l1[0], l1[1], l1[2], l1[3], h1[0], h1[1], h1[2], h1[3]}, o[d0], 0, 0, 0); \
        o[d0] = __builtin_amdgcn_mfma_f32_32x32x16_bf16(pa2, (bf16x8){l2[0], l2[1], l2[2], l2[3], h2[0], h2[1], h2[2], h2[3]}, o[d0], 0, 0, 0); \
        o[d0] = __builtin_amdgcn_mfma_f32_32x32x16_bf16(pa3, (bf16x8){l3[0], l3[1], l3[2], l3[3], h3[0], h3[1], h3[2], h3[3]}, o[d0], 0, 0, 0); } while (0)
    ATT_PV_D0(0); ATT_PV_D0(1); ATT_PV_D0(2); ATT_PV_D0(3);
#undef ATT_PV_D0
#undef ATT_TRRD
}
__device__ __forceinline__ void store_o_bf16(const f32x16* o, const float* rsc, bf16_t* dst, int ld, int r32, int hi) {
#pragma unroll
    for (int r = 0; r < 16; ++r) { const int orow = crow(r, hi);
#pragma unroll
        for (int d0 = 0; d0 < 4; ++d0) { const float v = o[d0][r] * rsc[r]; const float vn = __shfl_xor(v, 1);
            if ((r32 & 1) == 0) *(unsigned*)(dst + (size_t)orow * ld + d0 * 32 + r32) = cvtpk(v, vn); } }
}

__device__ __forceinline__ bf16x8 bload8(__amdgpu_buffer_rsrc_t rs, int voff, int soff) { const v4u w = __builtin_amdgcn_raw_buffer_load_b128(rs, voff, soff, 0); return *reinterpret_cast<const bf16x8*>(&w); }
__device__ __forceinline__ void attn_phase(LAS unsigned char* lds, const bf16_t* Qb, const bf16_t* Kb, const bf16_t* Vb, bf16_t* y, int GS, int rk, int b0, int nbg, int mode = 0) {
    int tid_ = threadIdx.x; asm volatile("" : "+v"(tid_));
    const int tid = tid_, wid = __builtin_amdgcn_readfirstlane(tid >> 6), lane = tid & 63, r32 = lane & 31, hi = lane >> 5;
    const int late = wid >> 2;
    LAS unsigned char* V_lds = lds + V_OFF; LAS unsigned char* K_lds = lds + K_OFF;
    LAS float* wsr = (LAS float*)(lds + WS_OFF) + wid * 64; LAS float* li_l = wsr; LAS float* al_l = wsr + 32;
    const __amdgpu_buffer_rsrc_t rsQ = __builtin_amdgcn_make_buffer_rsrc((void*)Qb, (short)0, (int)((size_t)M * MH * DQK * 2), 0x00020000),
        rsK = __builtin_amdgcn_make_buffer_rsrc((void*)Kb, (short)0, (int)((size_t)M * MH * DQK * 2), 0x00020000), rsV = __builtin_amdgcn_make_buffer_rsrc((void*)Vb, (short)0, (int)((size_t)M * MH * MDV * 2), 0x00020000);
    int kgo[3], kld[3];
#pragma unroll
    for (int i = 0; i < 3; ++i) { const int id = tid + 512 * i, row = id / 24, ch = id % 24; kgo[i] = (row * MH * DQK + ch * 8) * 2; kld[i] = k_off(row, ch); }
    const int sr = tid >> 4, sc = (tid & 15) * 8, vst0 = v_st(sr, sc), vst1 = v_st(32 + sr, sc), vgo0 = (sr * MH * MDV + sc) * 2, vgo1 = ((32 + sr) * MH * MDV + sc) * 2;
    const int vb0 = (int)(uintptr_t)V_lds + v_rd_base(lane);
    const int qgo = ((wid * 32 + r32) * MH * DQK + hi * 8) * 2;
    for (int item = rk; item < nbg * MH * 8; item += GS) {
        const int h = item & 7, slot = item >> 3, b = b0 + (slot >> 3), x = slot & 7;
        const int ksb = (b * SEQ * MH + h) * DQK * 2, vsb = (b * SEQ * MH + h) * MDV * 2;
        for (int pass = 0; pass < 2; ++pass) {
            const int qb = pass ? 15 - x : x, q0 = qb * 256, NT = 4 * qb + 4;
            bf16x8 qf[12];
#pragma unroll
            for (int d0 = 0; d0 < 12; ++d0) qf[d0] = bload8(rsQ, qgo + d0 * 32, ksb + q0 * MH * DQK * 2);
            const int qm = q0 + wid * 32 + r32 - 4 * hi;
            float m_reg = -1e30f, l_reg = 0.f; f32x16 o[4] = {};
            f32x16 p0, p1; bf16x8 pa0, pa1, pa2, pa3;
            bf16x8 sk0, sk1, sk2, sv0, sv1;
#define ATT_LOADK(kb_) do { const int ks_ = ksb + (kb_) * MH * DQK * 2; sk0 = bload8(rsK, kgo[0], ks_); sk1 = bload8(rsK, kgo[1], ks_); sk2 = bload8(rsK, kgo[2], ks_); } while (0)
#define ATT_LOADV(kb_) do { const int vs_ = vsb + (kb_) * MH * MDV * 2; sv0 = bload8(rsV, vgo0, vs_); sv1 = bload8(rsV, vgo1, vs_); } while (0)
#define ATT_WRITEK(bf) do { *(LAS bf16x8*)(K_lds + (bf) * SHM_K + kld[0]) = sk0; *(LAS bf16x8*)(K_lds + (bf) * SHM_K + kld[1]) = sk1; *(LAS bf16x8*)(K_lds + (bf) * SHM_K + kld[2]) = sk2; } while (0)
#define ATT_WRITEV(bf) do { *(LAS bf16x8*)(V_lds + (bf) * SHM_V + vst0) = sv0; *(LAS bf16x8*)(V_lds + (bf) * SHM_V + vst1) = sv1; } while (0)
#define ATT_RESC(a) do { if (__any((a) < 1.f)) { if (hi == 0) al_l[r32] = (a); asm volatile("s_waitcnt lgkmcnt(0)" ::: "memory"); \
        _Pragma("unroll") for (int d_ = 0; d_ < 4; ++d_) _Pragma("unroll") for (int r = 0; r < 16; ++r) o[d_][r] *= al_l[crow(r, hi)]; } } while (0)
#define ATT_BAR() do { asm volatile("s_waitcnt lgkmcnt(0)" ::: "memory"); __builtin_amdgcn_s_barrier(); asm volatile("" ::: "memory"); } while (0)
            ATT_LOADK(0); ATT_WRITEK(0); ATT_LOADK(64); ATT_LOADV(0);
            ATT_BAR();
#define ATT_QK(t) do { if (!(mode & 1)) qkt<12, 384>(p0, p1, K_lds + ((t) & 1) * SHM_K, r32, hi, qf); } while (0)
#define ATT_PV(t) do { if (!(mode & 2)) pv_tile<0>(o, vb0 + ((t) & 1) * SHM_V, pa0, pa1, pa2, pa3); } while (0)
#define ATT_SM(t) do { if (!(mode & 4)) { float mn, alpha; if ((t) >= NT - 4) mask_tile(p0, p1, qm - (t) * 64); \
        partialSM(p0, p1, m_reg, mn, alpha); ATT_RESC(alpha); finishSM(p0, p1, alpha, l_reg, pa0, pa1, pa2, pa3); } } while (0)
#define ATT_STAGE(t) do { if (!(mode & 8)) { if ((t) + 1 < NT) ATT_WRITEK(((t) + 1) & 1); ATT_WRITEV((t) & 1); if ((t) + 2 < NT) ATT_LOADK(((t) + 2) * 64); if ((t) + 1 < NT) ATT_LOADV(((t) + 1) * 64); } } while (0)
            if (late == 0) {
                ATT_QK(0); ATT_BAR();
                ATT_SM(0); ATT_STAGE(0); ATT_BAR();
                for (int t = 1; t < NT; ++t) {
                    ATT_PV(t - 1); ATT_QK(t); ATT_BAR();
                    ATT_SM(t); ATT_STAGE(t); ATT_BAR();
                }
                ATT_PV(NT - 1); ATT_BAR();
                ATT_BAR();
            } else {
                ATT_BAR();
                ATT_QK(0); ATT_STAGE(0); ATT_BAR();
                for (int t = 1; t < NT; ++t) {
                    ATT_SM(t - 1); ATT_BAR();
                    ATT_PV(t - 1); ATT_QK(t); ATT_STAGE(t); ATT_BAR();
                }
                ATT_SM(NT - 1); ATT_BAR();
                ATT_PV(NT - 1); ATT_BAR();
            }
#undef ATT_BAR
#undef ATT_QK
#undef ATT_PV
#undef ATT_SM
#undef ATT_STAGE
            if (hi == 0) li_l[r32] = l_reg; asm volatile("s_waitcnt lgkmcnt(0)" ::: "memory");
            float rli[16];
#pragma unroll
            for (int r = 0; r < 16; ++r) rli[r] = __builtin_amdgcn_rcpf(li_l[crow(r, hi)]);
            store_o_bf16(o, rli, y + ((size_t)b * SEQ + q0 + wid * 32) * MIXW + RETW + h * MDV, MIXW, r32, hi);
        }
    }
    __syncthreads();
#undef ATT_LOADK
#undef ATT_LOADV
#undef ATT_WRITEK
#undef ATT_WRITEV
#undef ATT_RESC
}
}

namespace ret {
using att::f32x16; using att::s16x4; using att::crow; using att::v_st; using att::v_rd_base; using att::bload8;
constexpr int TILE_V = 16384, TILE_K = 8192;
__device__ __forceinline__ float log2_gamma(int h) {
    return h == 0 ? -4.580368847e-02f : h == 1 ? -2.272007614e-02f : h == 2 ? -1.131531317e-02f : h == 3 ? -5.646563135e-03f : h == 4 ? -2.820519032e-03f : h == 5 ? -1.409570221e-03f : h == 6 ? -7.046129904e-04f : -3.522634797e-04f; }
#define RET_TRRD(dst, vb, off) asm volatile("ds_read_b64_tr_b16 %0, %1 offset:%2" : "=&v"(dst) : "v"(vb), "i"(off) : "memory")
__device__ __forceinline__ void inc_phase(LAS unsigned char* lds, const bf16_t* kr, const bf16_t* vr, float* incT, int GS, int rk, int b0, int nbg) {
    const __amdgpu_buffer_rsrc_t rsK = __builtin_amdgcn_make_buffer_rsrc((void*)kr, (short)0, (int)((size_t)M * 512 * 2), 0x00020000), rsV = __builtin_amdgcn_make_buffer_rsrc((void*)vr, (short)0, (int)((size_t)M * 1024 * 2), 0x00020000);
    LAS unsigned char* V_lds = lds; LAS unsigned char* K_lds = lds + 2 * TILE_V;
    for (int uq_ = rk; uq_ < nbg * RH * 32; uq_ += GS) {
        const int unit = (uq_ & 7) | ((b0 + (uq_ >> 3) % nbg) << 3) | (((uq_ >> 3) / nbg) << 5);
        int tid_ = threadIdx.x; asm volatile("" : "+v"(tid_));
        const int tid = tid_, wid = __builtin_amdgcn_readfirstlane(tid >> 6), lane = tid & 63, r32 = lane & 31, hi = lane >> 5;
        const int eblk = wid & 3, dblk = wid >> 2;
        const int vbV = (int)(uintptr_t)V_lds + v_rd_base(lane) + eblk * 512, vbK = (int)(uintptr_t)K_lds + v_rd_base(lane) + dblk * 512;
        const int h = unit & 7, b = (unit >> 3) & 3, n = unit >> 5;
        const float l2g = log2_gamma(h);
        const int tok0 = b * SEQ + n * RCH;
        { bf16x8 kv[2], vv[4];
#pragma unroll
          for (int i = 0; i < 2; ++i) { const int id = tid + 512 * i, tok = id >> 3, ch = id & 7; kv[i] = bload8(rsK, (tok * 512 + ch * 8) * 2, (tok0 * 512 + h * 64) * 2); }
#pragma unroll
          for (int i = 0; i < 4; ++i) { const int id = tid + 512 * i, tok = id >> 4, c16 = id & 15; vv[i] = bload8(rsV, (tok * 1024 + c16 * 8) * 2, (tok0 * 1024 + h * 128) * 2); }
#pragma unroll
          for (int i = 0; i < 2; ++i) { const int id = tid + 512 * i, tok = id >> 3, ch = id & 7; const float dec = __builtin_amdgcn_exp2f(l2g * (float)(RCH - 1 - tok));
            v4u w; w.x = cvtpk(bf2f((bf16_t)kv[i][0]) * dec, bf2f((bf16_t)kv[i][1]) * dec); w.y = cvtpk(bf2f((bf16_t)kv[i][2]) * dec, bf2f((bf16_t)kv[i][3]) * dec);
            w.z = cvtpk(bf2f((bf16_t)kv[i][4]) * dec, bf2f((bf16_t)kv[i][5]) * dec); w.w = cvtpk(bf2f((bf16_t)kv[i][6]) * dec, bf2f((bf16_t)kv[i][7]) * dec);
            *(LAS v4u*)(K_lds + (tok >> 6) * TILE_V + v_st(tok & 63, ch * 8)) = w; }
#pragma unroll
          for (int i = 0; i < 4; ++i) { const int id = tid + 512 * i, tok = id >> 4, c16 = id & 15; *(LAS bf16x8*)(V_lds + (tok >> 6) * TILE_V + v_st(tok & 63, c16 * 8)) = vv[i]; } }
        __syncthreads();
        f32x16 acc = {};
#define RET_INC_STEP(KT, KS) do { s16x4 al, ah, bl, bh_; constexpr int o_ = (KT) * TILE_V + (KS) * 4096; \
        RET_TRRD(al, vbV, o_); RET_TRRD(ah, vbV, o_ + 2048); RET_TRRD(bl, vbK, o_); RET_TRRD(bh_, vbK, o_ + 2048); \
        asm volatile("s_waitcnt lgkmcnt(0)" ::: "memory"); __builtin_amdgcn_sched_barrier(0); \
        acc = __builtin_amdgcn_mfma_f32_32x32x16_bf16((bf16x8){al[0], al[1], al[2], al[3], ah[0], ah[1], ah[2], ah[3]}, (bf16x8){bl[0], bl[1], bl[2], bl[3], bh_[0], bh_[1], bh_[2], bh_[3]}, acc, 0, 0, 0); } while (0)
        RET_INC_STEP(0, 0); RET_INC_STEP(0, 1); RET_INC_STEP(0, 2); RET_INC_STEP(0, 3); RET_INC_STEP(1, 0); RET_INC_STEP(1, 1); RET_INC_STEP(1, 2); RET_INC_STEP(1, 3);
#undef RET_INC_STEP
        float* op = incT + ((size_t)((b * RH + h) * 32 + n)) * (RDV * RDK) + (size_t)(32 * eblk) * RDK + 32 * dblk + r32;
#pragma unroll
        for (int r = 0; r < 16; ++r) op[(size_t)crow(r, hi) * RDK] = acc[r];
        __syncthreads();
    }
}
__device__ __forceinline__ void scan_phase(const float* incT, bf16_t* prevT, int GS, int rk, int b0, int nbg) {
    typedef float f32x2 __attribute__((ext_vector_type(2)));
    int tid_ = threadIdx.x; asm volatile("" : "+v"(tid_));
    for (int p = rk * NWAVES * 64 + tid_; p < nbg * RH * RDV * RDK / 2; p += GS * NWAVES * 64) {
        const int bh = b0 * RH + (p >> 12), off = (p & 4095) * 2; const float cd = exp2f(log2_gamma(bh & 7) * (float)RCH);
        const float* ip = incT + (size_t)bh * 32 * (RDV * RDK) + off; bf16_t* pp = prevT + (size_t)bh * 32 * (RDV * RDK) + off;
        f32x2 st = {0.f, 0.f};
#pragma unroll
        for (int n0 = 0; n0 < 32; n0 += 16) { f32x2 iv[16];
#pragma unroll
            for (int j = 0; j < 16; ++j) iv[j] = *(const f32x2*)(ip + (size_t)(n0 + j) * (RDV * RDK));
#pragma unroll
            for (int j = 0; j < 16; ++j) { *(unsigned*)(pp + (size_t)(n0 + j) * (RDV * RDK)) = cvtpk(st[0], st[1]); st = st * cd + iv[j]; } }
    }
}
constexpr int OST_ROW = 272;
__device__ __forceinline__ void out_phase(LAS unsigned char* lds, const bf16_t* qr, const bf16_t* kr, const bf16_t* vr, const bf16_t* gr, const bf16_t* prevT, const float* rgain, bf16_t* y, int GS, int rk, int b0, int nbg) {
    const __amdgpu_buffer_rsrc_t rsQ = __builtin_amdgcn_make_buffer_rsrc((void*)qr, (short)0, (int)((size_t)M * 512 * 2), 0x00020000), rsK = __builtin_amdgcn_make_buffer_rsrc((void*)kr, (short)0, (int)((size_t)M * 512 * 2), 0x00020000),
        rsV = __builtin_amdgcn_make_buffer_rsrc((void*)vr, (short)0, (int)((size_t)M * 1024 * 2), 0x00020000), rsP = __builtin_amdgcn_make_buffer_rsrc((void*)prevT, (short)0, (int)((size_t)NB * RH * 32 * RDV * RDK * 2), 0x00020000),
        rsG = __builtin_amdgcn_make_buffer_rsrc((void*)gr, (short)0, (int)((size_t)M * 1024 * 2), 0x00020000);
    LAS unsigned char* V_lds = lds; LAS unsigned char* K_lds = lds + 4 * TILE_V;
    for (int uq_ = rk; uq_ < nbg * RH * 16; uq_ += GS) {
        int tid_ = threadIdx.x; asm volatile("" : "+v"(tid_));
        const int tid = tid_, wid = __builtin_amdgcn_readfirstlane(tid >> 6), lane = tid & 63, r32 = lane & 31, hi = lane >> 5;
        const int c = wid >> 2, s = wid & 3;
        const int vb0 = (int)(uintptr_t)V_lds + v_rd_base(lane) + c * 2 * TILE_V;
        const int h = uq_ & 7, b = b0 + (uq_ >> 3) % nbg, cb = (uq_ >> 3) / nbg;
        const float l2g = log2_gamma(h);
        const int tok0 = b * SEQ + cb * 256;
        bf16x8 qf[4];
        { bf16x8 kv[4], vv[8];
#pragma unroll
          for (int i = 0; i < 4; ++i) { const int id = tid + 512 * i, tok = id >> 3, ch = id & 7; kv[i] = bload8(rsK, (tok * 512 + ch * 8) * 2, (tok0 * 512 + h * 64) * 2); }
#pragma unroll
          for (int i = 0; i < 8; ++i) { const int id = tid + 512 * i, tok = id >> 4, c16 = id & 15; vv[i] = bload8(rsV, (tok * 1024 + c16 * 8) * 2, (tok0 * 1024 + h * 128) * 2); }
#pragma unroll
          for (int d0 = 0; d0 < 4; ++d0) qf[d0] = bload8(rsQ, ((c * 128 + s * 32 + r32) * 512 + hi * 8) * 2 + d0 * 32, (tok0 * 512 + h * 64) * 2);
#pragma unroll
          for (int i = 0; i < 4; ++i) { const int id = tid + 512 * i, tok = id >> 3, ch = id & 7, row = tok & 63; *(LAS bf16x8*)(K_lds + (tok >> 6) * TILE_K + row * 128 + (((ch ^ (row >> 1)) & 7) << 4)) = kv[i]; }
#pragma unroll
          for (int i = 0; i < 8; ++i) { const int id = tid + 512 * i, tok = id >> 4, c16 = id & 15; *(LAS bf16x8*)(V_lds + (tok >> 6) * TILE_V + v_st(tok & 63, c16 * 8)) = vv[i]; } }
        f32x16 o[4] = {};
        const int psb = (((b * RH + h) * 32 + 2 * cb + c) * (RDV * RDK)) * 2;
#pragma unroll
        for (int hp = 0; hp < 2; ++hp) { bf16x8 pf[2][4];
#pragma unroll
            for (int dd = 0; dd < 2; ++dd)
#pragma unroll
                for (int ks = 0; ks < 4; ++ks) pf[dd][ks] = bload8(rsP, (((2 * hp + dd) * 32 + r32) * RDK + hi * 8) * 2 + ks * 32, psb);
#pragma unroll
            for (int dd = 0; dd < 2; ++dd)
#pragma unroll
                for (int ks = 0; ks < 4; ++ks) o[2 * hp + dd] = __builtin_amdgcn_mfma_f32_32x32x16_bf16(qf[ks], pf[dd][ks], o[2 * hp + dd], 0, 0, 0);
            asm volatile("" ::: "memory"); }
#pragma unroll
        for (int r = 0; r < 16; ++r) { const float qd = __builtin_amdgcn_exp2f(l2g * (float)(s * 32 + crow(r, hi) + 1));
#pragma unroll
            for (int d0e = 0; d0e < 4; ++d0e) o[d0e][r] *= qd; }
        __syncthreads();
#define RET_INTRA(KT) do { if ((KT) * 64 <= s * 32 + 31) { f32x16 p0, p1; bf16x8 pa0, pa1, pa2, pa3; \
        att::qkt<4, 128>(p0, p1, K_lds + (2 * c + (KT)) * TILE_K, r32, hi, qf); \
        const int di = s * 32 + r32 - (KT) * 64 - 4 * hi;            \
        _Pragma("unroll") for (int r = 0; r < 16; ++r) { const int d0_ = di - ((r & 3) + 8 * (r >> 2)), d1_ = d0_ - 32; \
            p0[r] = d0_ >= 0 ? p0[r] * __builtin_amdgcn_exp2f(l2g * (float)d0_) : 0.f; p1[r] = d1_ >= 0 ? p1[r] * __builtin_amdgcn_exp2f(l2g * (float)d1_) : 0.f; } \
        att::pack_p(p0, p1, pa0, pa1, pa2, pa3); __builtin_amdgcn_sched_barrier(0); \
        att::pv_tile<(KT)>(o, vb0, pa0, pa1, pa2, pa3); } } while (0)
        RET_INTRA(0); RET_INTRA(1);
#undef RET_INTRA
#pragma unroll
        for (int r = 0; r < 16; ++r) { float q = (o[0][r] * o[0][r] + o[1][r] * o[1][r]) + (o[2][r] * o[2][r] + o[3][r] * o[3][r]);
            q += __shfl_xor(q, 1); q += __shfl_xor(q, 2); q += __shfl_xor(q, 4); q += __shfl_xor(q, 8); q += __shfl_xor(q, 16);
            const float rs = rsqrtf(q * (1.f / RDV) + EPS);
#pragma unroll
            for (int d0e = 0; d0e < 4; ++d0e) o[d0e][r] *= rs; }
        __syncthreads();
        LAS unsigned char* OST = lds;
#pragma unroll
        for (int r = 0; r < 16; ++r) { const int lrow = c * 128 + s * 32 + crow(r, hi);
#pragma unroll
            for (int d0e = 0; d0e < 4; ++d0e) { const float v = o[d0e][r]; const float vn = __shfl_xor(v, 1);
                if ((r32 & 1) == 0) *(LAS unsigned*)(OST + lrow * OST_ROW + (d0e * 32 + r32) * 2) = cvtpk(v, vn); } }
        __syncthreads();
        { const int c16 = tid & 15; const f32x4 g0 = *(const f32x4*)(rgain + h * RDV + c16 * 8), g1 = *(const f32x4*)(rgain + h * RDV + c16 * 8 + 4);
          bf16x8 gv[8];
#pragma unroll
          for (int i = 0; i < 8; ++i) gv[i] = bload8(rsG, (((tid >> 4) + 32 * i) * 1024 + c16 * 8) * 2, (tok0 * 1024 + h * 128) * 2);
#pragma unroll
          for (int i = 0; i < 8; ++i) { const int row = (tid >> 4) + 32 * i;
              const bf16x8 ov = *(const LAS bf16x8*)(OST + row * OST_ROW + c16 * 16);
              v4u w; w.x = cvtpk(bf2f((bf16_t)ov[0]) * g0[0] * bf2f((bf16_t)gv[i][0]), bf2f((bf16_t)ov[1]) * g0[1] * bf2f((bf16_t)gv[i][1]));
              w.y = cvtpk(bf2f((bf16_t)ov[2]) * g0[2] * bf2f((bf16_t)gv[i][2]), bf2f((bf16_t)ov[3]) * g0[3] * bf2f((bf16_t)gv[i][3]));
              w.z = cvtpk(bf2f((bf16_t)ov[4]) * g1[0] * bf2f((bf16_t)gv[i][4]), bf2f((bf16_t)ov[5]) * g1[1] * bf2f((bf16_t)gv[i][5]));
              w.w = cvtpk(bf2f((bf16_t)ov[6]) * g1[2] * bf2f((bf16_t)gv[i][6]), bf2f((bf16_t)ov[7]) * g1[3] * bf2f((bf16_t)gv[i][7]));
              *(v4u*)(y + ((size_t)tok0 + row) * MIXW + h * RDV + c16 * 8) = w; } }
        __syncthreads();
    }
}
#undef RET_TRRD
}

struct MkArgs { Ptrs P; int ph_lo, ph_hi; };
constexpr int PH_P0A = 0, PH_P0B = 1, PH_L0 = 2, PH_PER_LAYER = 9, PH_FINAL = PH_L0 + DEPTH * PH_PER_LAYER, PH_COUNT = PH_FINAL + 1;
constexpr int PO_GU1 = 0, PO_DN1 = 1, PO_IN = 2, PO_UP = 3, PO_SCAN = 4, PO_ATT = 5, PO_OUT = 6, PO_GU2 = 7, PO_DN2 = 8;

typedef const __attribute__((address_space(4))) MkArgs* KArgP;
typedef const __attribute__((address_space(4))) Ptrs& PtrsRef;
__global__ void __launch_bounds__(NWAVES * 64, 2) mk_fwd(MkArgs args) {
    extern __shared__ __attribute__((aligned(16))) unsigned char lds_raw[];
    LAS unsigned char* lds = (LAS unsigned char*)lds_raw;
    const int G = gridDim.x, bx = blockIdx.x;
    const int vcu = (G % 8 == 0) ? (bx % 8) * (G / 8) + bx / 8 : bx;
    const int NGW = G * NWAVES;
    const KArgP kargs = (KArgP)__builtin_amdgcn_kernarg_segment_ptr();
    const int lo = args.ph_lo, hi = args.ph_hi;
    for (int u = threadIdx.x; u < (LDS_BYTES - LDSCTL_OFF) / 4; u += NWAVES * 64) ((LAS unsigned*)(lds + LDSCTL_OFF))[u] = 0u;
    __syncthreads();
    const bool dual = (G == 256);
    constexpr int NG = NGROUPS, XG = 8 / NG;
    const int NGRP = dual ? NG : 1, grp = dual ? (bx & 7) / XG : 0, GS = dual ? G / NG : G;
    const int rk = dual ? ((bx >> 3) / NG) * 8 + ((bx & 7) % XG) * NG + ((bx >> 3) % NG) : bx;
    const int nbg = dual ? NB / NG : NB, b0g = grp * nbg, gM = dual ? M / NG : M, pm0g = grp * (gM / 256);
    (void)xcd_barrier_post((unsigned*)(kargs->P.ws + WS_CTL) + CW_BAR, (volatile LAS unsigned*)(lds + MISC_OFF) + 8, (unsigned)G);
    if (dual) (void)xcd_barrier_post((unsigned*)(kargs->P.ws + WS_CTL) + CW_GBAR + grp * XCD_BAR_WORDS, (volatile LAS unsigned*)(lds + MISC_OFF) + 10, (unsigned)GS);
    if (dual) (void)xcd_barrier_post((unsigned*)(kargs->P.ws + WS_CTL) + CW_SGBAR + (bx & 7) * XCD_BAR_WORDS, (volatile LAS unsigned*)(lds + MISC_OFF) + 12, (unsigned)(GS / (8 / NGROUPS)));
#define IN(k) (lo <= (k) && (k) < hi)
#define SEAM_(k, group) do { if (IN(k) && IN((k) + 1)) { KArgP ap_ = kargs; asm volatile("" : "+s"(ap_)); XcdBarrier bar_; bar_.x = xb_xcc_id(); \
        if ((group) && dual) { bar_.n = (unsigned)GS; bar_.bar = (unsigned*)(ap_->P.ws + WS_CTL) + CW_GBAR + grp * XCD_BAR_WORDS; bar_.st = (volatile LAS unsigned*)(lds + MISC_OFF) + 10; } \
        else { bar_.n = (unsigned)G; bar_.bar = (unsigned*)(ap_->P.ws + WS_CTL) + CW_BAR; bar_.st = (volatile LAS unsigned*)(lds + MISC_OFF) + 8; } \
        xcd_barrier(bar_); } } while (0)
#define SEAM(k) SEAM_(k, false)
#define SEAMG(k) SEAM_(k, true)
#define SEAML(k) do { if (IN(k) && IN((k) + 1)) { if (!dual) { SEAM_(k, false); } else { KArgP ap_ = kargs; asm volatile("" : "+s"(ap_)); XcdBarrier bar_; bar_.x = xb_xcc_id(); \
        bar_.n = (unsigned)(GS / (8 / NGROUPS)); bar_.bar = (unsigned*)(ap_->P.ws + WS_CTL) + CW_SGBAR + (bx & 7) * XCD_BAR_WORDS; bar_.st = (volatile LAS unsigned*)(lds + MISC_OFF) + 12; \
        xcd_barrier(bar_); } } } while (0)
#define PH_LOCALS \
    int tid = threadIdx.x; asm volatile("" : "+v"(tid)); \
    const int lane = tid & 63, wave = __builtin_amdgcn_readfirstlane(tid >> 6), gw = vcu * NWAVES + wave; (void)lane; (void)gw; \
    KArgP ap = kargs; asm volatile("" : "+s"(ap)); int Gp = GS, bxp = rk; asm volatile("" : "+s"(Gp), "+s"(bxp)); (void)Gp; (void)bxp;     \
    int gMp = gM, pm0 = pm0g, b0 = b0g, nbp = nbg; asm volatile("" : "+s"(gMp), "+s"(pm0), "+s"(b0), "+s"(nbp)); (void)gMp; (void)pm0; (void)b0; (void)nbp; \
    PtrsRef P = ap->P; unsigned char* ws = P.ws; \
    float* mod = (float*)(ws + CT_MOD); float* ssx = (float*)(ws + CT_SS); float* biasb = (float*)(ws + CT_BIAS); \
    float* gatef = (float*)(ws + CT_GATE); float* gmt = (float*)(ws + CT_GM); \
    float* cosT = (float*)(ws + WS_COS); float* sinT = (float*)(ws + WS_SIN); \
    f16_t* xres = (f16_t*)(ws + WS_XRES); bf16_t* xg = (bf16_t*)(ws + WS_XG); bf16_t* act = (bf16_t*)(ws + WS_ACT); \
    (void)mod; (void)ssx; (void)biasb; (void)gatef; (void)gmt; (void)cosT; (void)sinT; (void)xres; (void)xg; (void)act
#define MIX_LOCALS \
    bf16_t *qr = (bf16_t*)(ws + WS_QR), *kr = (bf16_t*)(ws + WS_KR), *vr = (bf16_t*)(ws + WS_VR), *gr = (bf16_t*)(ws + WS_GR), *cq = (bf16_t*)(ws + WS_CQ), *ckv = (bf16_t*)(ws + WS_CKV); \
    bf16_t *Qb = (bf16_t*)(ws + WS_Q), *Kb = (bf16_t*)(ws + WS_K), *Vb = (bf16_t*)(ws + WS_V), *yb = (bf16_t*)(ws + WS_Y); \
    float* ssq = (float*)(ws + CT_SSQ) + (size_t)l * M; float* sskv = (float*)(ws + CT_SSKV) + (size_t)l * M; \
    (void)qr; (void)kr; (void)vr; (void)gr; (void)cq; (void)ckv; (void)Qb; (void)Kb; (void)Vb; (void)yb; (void)ssq; (void)sskv
#define LAYER_LOCALS \
    const float* mod_l = mod + (size_t)l * NB * NMOD * D; unsigned char* wt = ws + WS_WT + (size_t)l * WT_LAYER; (void)mod_l; (void)wt

    if (IN(PH_P0A)) {
        PH_LOCALS;
        LAS float* CA = (LAS float*)lds;
        LAS float* RED = (LAS float*)(lds + 32768);
        for (int i = tid; i < NB * D; i += NWAVES * 64) CA[i] = siluf(P.c[i]);
        __syncthreads();
        for (int u = vcu; u < 2 * 72 * 8; u += G) {
            const int l = u / 576, r = u % 576, strip = r >> 3, kc = r & 7;
            f32x4 a0 = {0, 0, 0, 0}, a1 = a0, a2 = a0, a3 = a0;
            const float* wp = P.w_ada + ((size_t)l * D + kc * 256 + wave * 32) * (NMOD * D) + strip * 256 + 4 * lane;
            const LAS float* cp = CA + kc * 256 + wave * 32;
#pragma unroll 16
            for (int i = 0; i < 32; ++i) { const f32x4 wv = *(const f32x4*)(wp + (size_t)i * (NMOD * D));
                a0 += wv * cp[i]; a1 += wv * cp[D + i]; a2 += wv * cp[2 * D + i]; a3 += wv * cp[3 * D + i]; }
            *(LAS f32x4*)(RED + (wave * 4 + 0) * 256 + 4 * lane) = a0; *(LAS f32x4*)(RED + (wave * 4 + 1) * 256 + 4 * lane) = a1;
            *(LAS f32x4*)(RED + (wave * 4 + 2) * 256 + 4 * lane) = a2; *(LAS f32x4*)(RED + (wave * 4 + 3) * 256 + 4 * lane) = a3;
            __syncthreads();
            for (int o = tid; o < 1024; o += NWAVES * 64) { const int b = o >> 8, j = o & 255; float s = 0.f;
#pragma unroll
                for (int w = 0; w < 8; ++w) s += RED[(w * 4 + b) * 256 + j];
                const int col = strip * 256 + j; if (kc == 0) s += P.b_ada[l * NMOD * D + col];
                __hip_atomic_fetch_add(mod + ((size_t)l * NB + b) * NMOD * D + col, s, __ATOMIC_RELAXED, __HIP_MEMORY_SCOPE_AGENT); }
            __syncthreads();
        }
        for (int i = vcu * NWAVES * 64 + tid; i < M * 32; i += G * NWAVES * 64) { const int m = i >> 5, f = i & 31;
            const float inv = (float)pow(10000.0, -(double)f / 32.0); const float ang = (float)P.pos[m] * inv;
            cosT[i] = (float)cos((double)ang); sinT[i] = (float)sin((double)ang); }
    }
    SEAM(PH_P0A);
    if (IN(PH_P0B)) {
        PH_LOCALS;
        for (int row = gw; row < M; row += NGW) { const int b = row / SEQ;
            const float* xr = P.x + (size_t)row * D; const float* gn = P.norm_ffn1; const float* scp = mod + (size_t)b * NMOD * D + D;
            float s = 0.f; f32x4 xv[8], gv[8];
#pragma unroll
            for (int j = 0; j < 8; ++j) { const int c = 4 * (lane + 64 * j); xv[j] = *(const f32x4*)(xr + c); gv[j] = *(const f32x4*)(gn + c) * (*(const f32x4*)(scp + c) + 1.f); }
#pragma unroll
            for (int j = 0; j < 8; ++j) { const int c = 4 * (lane + 64 * j); const f32x4 v = xv[j], o = v * gv[j];
                s += (v[0] * v[0] + v[1] * v[1]) + (v[2] * v[2] + v[3] * v[3]);
                v2u w; w.x = cvtpk(o[0], o[1]); w.y = cvtpk(o[2], o[3]); *(v2u*)(xg + (size_t)row * D + c) = w; }
            s = wave_sum(s); if (lane == 0) ssx[row] = s; }
        for (int i = vcu * NWAVES * 64 + tid; i < DEPTH * 3 * NB * D; i += G * NWAVES * 64) { const int c = i & 2047, b = (i >> 11) & 3, q = i >> 13, l = q / 3, s = q % 3;
            const float* ml = mod + ((size_t)l * NB + b) * NMOD * D; const float* gn = (s == 0 ? P.norm_ffn1 : s == 1 ? P.norm_mix : P.norm_ffn2) + (size_t)l * D;
            gatef[i] = (s == 1 ? 1.0f : 0.5f) * ml[(3 * s + 2) * D + c]; gmt[i] = gn[c] * (1.f + ml[(3 * s + 1) * D + c]); }
        LAS float* scr = (LAS float*)(lds + wave * 8448); LAS float* shs = (LAS float*)(lds + 8 * 8448 + wave * 1024);
        constexpr int IT_GU = (D / 64) * (NGU / 32), IT_DN = (FF / 64) * (D / 32), IT_IN = (D / 64) * (NPIN / 32), IT_UQ = (QRANK / 64) * (1536 / 32),
                      IT_UKV = (KVRANK / 64) * (2048 / 32), IT_OUT = (D / 64) * (D / 32), IT_LAYER = 2 * IT_GU + 2 * IT_DN + IT_IN + IT_UQ + IT_UKV + IT_OUT;
        auto decode = [&](int it) -> CvtDesc {
            const int l = it / IT_LAYER; int r = it % IT_LAYER;
            unsigned char* wt = ws + WS_WT + (size_t)l * WT_LAYER;
            const float* W; const float* sc = nullptr; bf16_t* WT; int K, ldw, NP, kind, sb = -1;
            if (r < IT_GU) { W = P.ffn1_w_gu + (size_t)l * D * NGU; WT = (bf16_t*)(wt + WT_GU1); K = D; ldw = NGU; NP = NGU; kind = 1; sb = 0; }
            else if ((r -= IT_GU) < IT_DN) { W = P.ffn1_w_down + (size_t)l * FF * D; WT = (bf16_t*)(wt + WT_DN1); K = FF; ldw = D; NP = D; kind = 0; }
            else if ((r -= IT_DN) < IT_IN) { W = P.w_in + (size_t)l * D * INCOLS; WT = (bf16_t*)(wt + WT_IN); K = D; ldw = INCOLS; NP = NPIN; kind = 2; sb = 1; }
            else if ((r -= IT_IN) < IT_UQ) { W = P.w_uq + (size_t)l * QRANK * MH * DQK; sc = P.q_norm_g + (size_t)l * QRANK; WT = (bf16_t*)(wt + WT_UQ); K = QRANK; ldw = MH * DQK; NP = 1536; kind = 3; }
            else if ((r -= IT_UQ) < IT_UKV) { W = P.w_ukv + (size_t)l * KVRANK * 2048; sc = P.kv_norm_g + (size_t)l * KVRANK; WT = (bf16_t*)(wt + WT_UKV); K = KVRANK; ldw = 2048; NP = 2048; kind = 0; }
            else if ((r -= IT_UKV) < IT_OUT) { W = P.w_out + (size_t)l * MIXW * D; WT = (bf16_t*)(wt + WT_OUT); K = MIXW; ldw = D; NP = D; kind = 0; }
            else if ((r -= IT_OUT) < IT_GU) { W = P.ffn2_w_gu + (size_t)l * D * NGU; WT = (bf16_t*)(wt + WT_GU2); K = D; ldw = NGU; NP = NGU; kind = 1; sb = 2; }
            else { r -= IT_GU; W = P.ffn2_w_down + (size_t)l * FF * D; WT = (bf16_t*)(wt + WT_DN2); K = FF; ldw = D; NP = D; kind = 0; }
            const int nblk = NP / 32, kb = r / nblk, nb = r % nblk;
            CvtDesc d; d.W = W; d.scale = sc; d.WT = WT; d.sh = sb >= 0 ? mod + (size_t)l * NB * NMOD * D + (size_t)(3 * sb) * D : nullptr;
            d.bias = biasb + (size_t)(3 * l + (sb < 0 ? 0 : sb)) * NB * NGU; d.ldw = ldw; d.K = K; d.k0 = 64 * kb; d.src0 = src_block(kind, nb); d.dst0 = 32 * nb; return d; };
        {
            int it = gw;
            if (it < DEPTH * IT_LAYER) {
                CvtDesc cur = decode(it); f32x4 v[8]; cvt_load(cur, v, lane);
                for (;;) {
                    const int itn = it + NGW; const bool more = itn < DEPTH * IT_LAYER;
                    CvtDesc nxt = cur; f32x4 vn[8];
                    if (more) { nxt = decode(itn); cvt_load(nxt, vn, lane); }
                    cvt_process(cur, v, scr, shs, lane);
                    if (!more) break;
                    cur = nxt; it = itn;
#pragma unroll
                    for (int i = 0; i < 8; ++i) v[i] = vn[i];
                }
            }
        }
    }
    SEAM(PH_P0B);
    for (int l = 0; l < DEPTH; ++l) {
        const int pb = PH_L0 + l * PH_PER_LAYER;
        for (int s = 0; s < 3; s += 2) {
            const int p_gu = pb + (s == 0 ? PO_GU1 : PO_GU2), p_dn = p_gu + 1;
            if (IN(p_gu)) {
                PH_LOCALS; LAYER_LOCALS;
                pg8::Gemm g{xg + (size_t)pm0 * 256 * D, (const bf16_t*)(wt + (s == 0 ? WT_GU1 : WT_GU2)), gMp, NGU, D}; pg8::StaticOrder S; S.init(gMp, NGU, Gp, bxp);
                EpiGU E{act, ssx + (size_t)(3 * l + s) * M, biasb + (size_t)(3 * l + s) * NB * NGU, pm0, 0};
                pg8::gemm_phase<EpiGU, pg8::StaticOrder, true, true>(lds, g, S, E);
            }
            SEAML(p_gu);
            if (IN(p_dn)) {
                PH_LOCALS; LAYER_LOCALS;
                pg8::Gemm g{act + (size_t)pm0 * 256 * FF, (const bf16_t*)(wt + (s == 0 ? WT_DN1 : WT_DN2)), gMp, D, FF}; pg8::StaticOrder S; S.init(gMp, D, Gp, bxp);
                const int last = (l == DEPTH - 1 && s == 2);
                const int qn = 3 * l + s + 1;
                if (l == 0 && s == 0) { EpiRes<true> E{P.x, nullptr, xres, xg, ssx + (size_t)qn * M, gatef + (size_t)(3 * l + s) * NB * D, gmt + (size_t)qn * NB * D, 1, pm0};
                    pg8::gemm_phase<EpiRes<true>, pg8::StaticOrder, true, true>(lds, g, S, E); }
                else { EpiRes<false> E{nullptr, xres, xres, xg, ssx + (size_t)qn * M, gatef + (size_t)(3 * l + s) * NB * D, gmt + (size_t)(last ? 0 : qn) * NB * D, last ? 0 : 1, pm0};
                    pg8::gemm_phase<EpiRes<false>, pg8::StaticOrder, true, true>(lds, g, S, E); }
            }
            if (l == DEPTH - 1 && s == 2) SEAMG(p_dn); else SEAML(p_dn);
            if (s == 0) {
                if (IN(pb + PO_IN)) {
                    PH_LOCALS; LAYER_LOCALS; MIX_LOCALS;
                    pg8::Gemm g{xg + (size_t)pm0 * 256 * D, (const bf16_t*)(wt + WT_IN), gMp, NPIN, D}; pg8::StaticOrder S; S.init(gMp, NPIN, Gp, bxp);
                    EpiIn E{ssx + (size_t)(3 * l + 1) * M, biasb + (size_t)(3 * l + 1) * NB * NGU, cosT, sinT, qr, kr, vr, gr, cq, ckv, Kb, ssq, sskv, pm0, 0};
                    pg8::gemm_phase<EpiIn, pg8::StaticOrder, true, true>(lds, g, S, E);
                }
                SEAMG(pb + PO_IN);
                if (IN(pb + PO_UP)) {
                    PH_LOCALS; LAYER_LOCALS; MIX_LOCALS;
                    {
                    { pg8::Gemm g{cq + (size_t)pm0 * 256 * QRANK, (const bf16_t*)(wt + WT_UQ), gMp, 1536, QRANK}; pg8::StaticOrder S; S.init(gMp, 1536, Gp, bxp);
                      EpiUq E{ssq, cosT, sinT, Qb, pm0, 0};
                      pg8::gemm_phase<EpiUq, pg8::StaticOrder, true, true>(lds, g, S, E); }
                    { pg8::Gemm g{ckv + (size_t)pm0 * 256 * KVRANK, (const bf16_t*)(wt + WT_UKV), gMp, 2048, KVRANK}; pg8::StaticOrder S; S.init(gMp, 2048, Gp, bxp);
                      EpiUkv E{sskv, Kb, Vb, pm0, 0};
                      pg8::gemm_phase<EpiUkv, pg8::StaticOrder, true, true>(lds, g, S, E); }
                    ret::inc_phase(lds, kr, vr, (float*)(ws + WS_INC), Gp, bxp, b0, nbp);
                    }
                }
                SEAMG(pb + PO_UP);
                if (IN(pb + PO_SCAN)) {
                    PH_LOCALS; LAYER_LOCALS; MIX_LOCALS;
                    ret::scan_phase((const float*)(ws + WS_INC), (bf16_t*)(ws + WS_PREVT), Gp, bxp, b0, nbp);
                }
                SEAMG(pb + PO_SCAN);
                if (IN(pb + PO_ATT)) {
                    PH_LOCALS; LAYER_LOCALS; MIX_LOCALS;
                    att::attn_phase(lds, Qb, Kb, Vb, yb, Gp, bxp, b0, nbp, 0);
                    ret::out_phase(lds, qr, kr, vr, gr, (const bf16_t*)(ws + WS_PREVT), P.ret_norm_g + (size_t)l * RETW, yb, Gp, bxp, b0, nbp);
                }
                SEAMG(pb + PO_ATT);
                if (IN(pb + PO_OUT)) {
                    PH_LOCALS; LAYER_LOCALS; MIX_LOCALS;
                    pg8::Gemm g{yb + (size_t)pm0 * 256 * MIXW, (const bf16_t*)(wt + WT_OUT), gMp, D, MIXW}; pg8::StaticOrder S; S.init(gMp, D, Gp, bxp);
                    EpiRes<false> E{nullptr, xres, xres, xg, ssx + (size_t)(3 * l + 2) * M, gatef + (size_t)(3 * l + 1) * NB * D, gmt + (size_t)(3 * l + 2) * NB * D, 1, pm0};
                    pg8::gemm_phase<EpiRes<false>, pg8::StaticOrder, true, true>(lds, g, S, E);
                }
                SEAML(pb + PO_OUT);
            }
        }
    }
    if (IN(PH_FINAL)) {
        PH_LOCALS;
        const float* ssf = ssx + (size_t)6 * M;
        for (int row = pm0 * 256 + bxp * NWAVES + wave; row < pm0 * 256 + gMp; row += Gp * NWAVES) { const float rs = rsqrtf(ssf[row] * (1.f / D) + EPS);
            f16x8 hv[4];
#pragma unroll
            for (int j = 0; j < 4; ++j) hv[j] = *(const f16x8*)(xres + (size_t)row * D + 8 * (lane + 64 * j));
#pragma unroll
            for (int j = 0; j < 4; ++j) { const int c = 8 * (lane + 64 * j); const f16x8 h = hv[j];
                const f32x4 g0 = *(const f32x4*)(P.final_norm + c), g1 = *(const f32x4*)(P.final_norm + c + 4);
                *(f32x4*)(P.out + (size_t)row * D + c) = (f32x4){(float)h[0], (float)h[1], (float)h[2], (float)h[3]} * rs * g0;
                *(f32x4*)(P.out + (size_t)row * D + c + 4) = (f32x4){(float)h[4], (float)h[5], (float)h[6], (float)h[7]} * rs * g1; } }
    }
#undef IN
#undef SEAM
#undef PH_LOCALS
#undef LAYER_LOCALS
#undef MIX_LOCALS
}

static int g_grid = 0;
static void mk(hipStream_t st, const Ptrs& P, int lo, int hi) {
    MkArgs a{}; a.P = P; a.ph_lo = lo; a.ph_hi = hi;
    hipLaunchKernelGGL(mk_fwd, dim3(g_grid), dim3(NWAVES * 64), LDS_BYTES, st, a);
}

extern "C" void kernel_launch(void* const* d_in, const int* in_sizes, int n_in, void* d_out, int out_size, void* d_ws, size_t ws_size, hipStream_t stream) {
    if (n_in != 20 || ws_size < WS_END) { fprintf(stderr, "kernel_launch: bad args n_in %d ws %zu need %zu\n", n_in, ws_size, (size_t)WS_END); return; }
    if (g_grid == 0) {
        int dev = 0, cus = 0;
        if (hipGetDevice(&dev) != hipSuccess || hipDeviceGetAttribute(&cus, hipDeviceAttributeMultiprocessorCount, dev) != hipSuccess || cus <= 0) { g_grid = -1; return; }
        if (hipFuncSetAttribute((const void*)mk_fwd, hipFuncAttributeMaxDynamicSharedMemorySize, LDS_BYTES) != hipSuccess) { fprintf(stderr, "hipFuncSetAttribute failed\n"); g_grid = -1; return; }
        g_grid = cus;
    }
    if (g_grid < 0) return;
    Ptrs P{};
    P.x = (const float*)d_in[0]; P.c = (const float*)d_in[1]; P.pos = (const int*)d_in[2]; P.w_ada = (const float*)d_in[3]; P.b_ada = (const float*)d_in[4];
    P.norm_ffn1 = (const float*)d_in[5]; P.ffn1_w_gu = (const float*)d_in[6]; P.ffn1_w_down = (const float*)d_in[7]; P.norm_mix = (const float*)d_in[8];
    P.w_in = (const float*)d_in[9]; P.ret_norm_g = (const float*)d_in[10]; P.q_norm_g = (const float*)d_in[11]; P.w_uq = (const float*)d_in[12];
    P.kv_norm_g = (const float*)d_in[13]; P.w_ukv = (const float*)d_in[14]; P.w_out = (const float*)d_in[15]; P.norm_ffn2 = (const float*)d_in[16];
    P.ffn2_w_gu = (const float*)d_in[17]; P.ffn2_w_down = (const float*)d_in[18]; P.final_norm = (const float*)d_in[19];
    P.out = (float*)d_out; P.ws = (unsigned char*)d_ws;
    unsigned char* ws = P.ws;
    (void)hipMemsetAsync(ws + WS_CTL, 0, CTL_BYTES, stream);
    mk(stream, P, 0, PH_COUNT);
}
```
